# Optimizing an MI355X kernel written in HIP

```python
import jax, jax.numpy as jnp
from jax import lax
import numpy as np

D_MODEL = 2048
BATCH = 1
SEQ = 8192
DEPTH = 1

GRID_W = 64
CTX_LEN = 256
HG_HEADS = 8
HG_DK = 128
HG_DV = 128
HG_QK = HG_HEADS * HG_DK
HG_WIDTH = HG_HEADS * HG_DV
RET_HEADS = 4
RET_DK = 128
RET_DV = 256
RET_QK = RET_HEADS * RET_DK
RET_WIDTH = RET_HEADS * RET_DV
MIX_WIDTH = HG_WIDTH + RET_WIDTH
CHUNK = 64
PROJ_SIZES = (HG_QK, HG_QK, HG_QK, HG_WIDTH, HG_WIDTH, RET_QK, RET_QK, RET_WIDTH, RET_WIDTH)
PROJ_WIDTH = 3 * HG_QK + 2 * HG_WIDTH + 2 * RET_QK + 2 * RET_WIDTH
N_GROUPS = 4
EXPERTS_PER_GROUP = 8
N_EXPERTS = N_GROUPS * EXPERTS_PER_GROUP
EXPERT_TOPK = 2
D_EXPERT = 1024
MOE_BLOCK = 128
RMS_EPS = 1e-6
ROPE_BASE = 10000.0

kernel_name = "hybrid_hgrn2_retention_hmoe_dit"


def rms_norm(x, w):
    xf = x.astype(jnp.float32)
    y = xf * lax.rsqrt(jnp.mean(xf * xf, axis=-1, keepdims=True) + RMS_EPS)
    return (y * w.astype(jnp.float32)).astype(x.dtype)


def head_rms_norm(o, w, n_heads):
    B, N, _ = o.shape
    of = o.reshape(B, N, n_heads, -1)
    of = of * lax.rsqrt(jnp.mean(of * of, axis=-1, keepdims=True) + RMS_EPS)
    return of.reshape(B, N, -1) * w.astype(jnp.float32)


def axial_rope(n_tokens):
    rows = n_tokens // GRID_W
    r = jnp.broadcast_to(jnp.arange(rows)[:, None], (rows, GRID_W)).reshape(-1).astype(jnp.float32)
    cidx = jnp.broadcast_to(jnp.arange(GRID_W)[None, :], (rows, GRID_W)).reshape(-1).astype(jnp.float32)
    n_freq = RET_DK // 4
    inv = ROPE_BASE ** (-jnp.arange(n_freq, dtype=jnp.float32) / n_freq)
    ang = jnp.concatenate([r[:, None] * inv, cidx[:, None] * inv], axis=-1)
    return jnp.cos(ang), jnp.sin(ang)


def apply_rope(x, cos, sin):
    half = x.shape[-1] // 2
    x1, x2 = x[..., :half], x[..., half:]
    return jnp.concatenate([x1 * cos - x2 * sin, x1 * sin + x2 * cos], axis=-1)


def _to_chunks(a):
    B, H, N, d = a.shape
    return a.reshape(B, H, N // CHUNK, CHUNK, d).transpose(2, 0, 1, 3, 4)


def _from_chunks(a):
    n, B, H, C, d = a.shape
    return a.transpose(1, 2, 0, 3, 4).reshape(B, H, n * C, d)


def gated_state_scan(q, k, v, log_f, s0):
    causal = jnp.tril(jnp.ones((CHUNK, CHUNK), dtype=bool))[:, :, None]

    def step(s, blk):
        qc, kc, vc, gc = blk
        b = jnp.cumsum(gc, axis=2)
        rel = jnp.where(causal, b[:, :, :, None, :] - b[:, :, None, :, :], -jnp.inf)
        att = jnp.einsum('bhtk,bhtsk,bhsk->bhts', qc, jnp.exp(rel), kc)
        o = jnp.einsum('bhts,bhsv->bhtv', att, vc) + jnp.einsum('bhtk,bhkv->bhtv', qc * jnp.exp(b), s)
        b_end = b[:, :, -1:, :]
        s_new = jnp.exp(b_end[:, :, 0, :])[..., None] * s + jnp.einsum('bhsk,bhsv->bhkv', kc * jnp.exp(b_end - b), vc)
        return s_new, o

    s_fin, o = lax.scan(step, s0, (_to_chunks(q), _to_chunks(k), _to_chunks(v), _to_chunks(log_f)))
    return _from_chunks(o), s_fin


def retention_scan(q, k, v, log_gamma, s0):
    idx = jnp.arange(CHUNK, dtype=jnp.float32)
    diff = idx[:, None] - idx[None, :]
    lg = log_gamma[:, None, None]
    decay_mask = jnp.where(diff >= 0, jnp.exp(lg * jnp.maximum(diff, 0.0)), 0.0)
    q_decay = jnp.exp(log_gamma[:, None] * (idx + 1.0))[:, :, None]
    k_decay = jnp.exp(log_gamma[:, None] * (CHUNK - 1.0 - idx))[:, :, None]
    chunk_decay = jnp.exp(log_gamma * CHUNK)[:, None, None]

    def step(s, blk):
        qc, kc, vc = blk
        inner = jnp.einsum('bhts,bhsv->bhtv', jnp.einsum('bhtk,bhsk->bhts', qc, kc) * decay_mask, vc)
        cross = jnp.einsum('bhtk,bhkv->bhtv', qc * q_decay, s)
        s_new = chunk_decay * s + jnp.einsum('bhsk,bhsv->bhkv', kc * k_decay, vc)
        return s_new, inner + cross

    s_fin, o = lax.scan(step, s0, (_to_chunks(q), _to_chunks(k), _to_chunks(v)))
    return _from_chunks(o), s_fin


def mixer_stream(h, w_in, w_out, lb, ret_log_gamma, hg_norm_w, ret_norm_w, init_states, rope):
    B, N, _ = h.shape
    split_at = np.cumsum(PROJ_SIZES)[:-1].tolist()
    hq, hf_fwd, hf_bwd, hi, hgate, rq, rk, rv, rgate = jnp.split(h @ w_in, split_at, axis=-1)

    def heads(a, n):
        return a.reshape(B, N, n, -1).transpose(0, 2, 1, 3).astype(jnp.float32)

    def merge(o):
        return o.transpose(0, 2, 1, 3).reshape(B, N, -1)

    def flip(a):
        return jnp.flip(a, axis=2)

    q = heads(jax.nn.silu(hq), HG_HEADS)
    v = heads(hi, HG_HEADS)
    f_fwd = lb[0] + (1.0 - lb[0]) * jax.nn.sigmoid(heads(hf_fwd, HG_HEADS))
    f_bwd = lb[1] + (1.0 - lb[1]) * jax.nn.sigmoid(heads(hf_bwd, HG_HEADS))
    o_f, s_hf = gated_state_scan(q, 1.0 - f_fwd, v, jnp.log(f_fwd), init_states[0])
    o_b, s_hb = gated_state_scan(flip(q), flip(1.0 - f_bwd), flip(v), flip(jnp.log(f_bwd)), init_states[1])
    o_hg = head_rms_norm(merge(o_f + flip(o_b)), hg_norm_w, HG_HEADS) * jax.nn.silu(hgate.astype(jnp.float32))

    q_r = heads(rq, RET_HEADS)
    k_r = heads(rk, RET_HEADS) * (RET_DK ** -0.5)
    if rope is not None:
        q_r = apply_rope(q_r, rope[0], rope[1])
        k_r = apply_rope(k_r, rope[0], rope[1])
    v_r = heads(rv, RET_HEADS)
    r_f, s_rf = retention_scan(q_r, k_r, v_r, ret_log_gamma[0], init_states[2])
    r_b, s_rb = retention_scan(flip(q_r), flip(k_r), flip(v_r), ret_log_gamma[1], init_states[3])
    o_ret = head_rms_norm(merge(r_f + flip(r_b)), ret_norm_w, RET_HEADS) * jax.nn.silu(rgate.astype(jnp.float32))

    out = jnp.concatenate([o_hg, o_ret], axis=-1).astype(h.dtype) @ w_out
    return out, (s_hf, s_hb, s_rf, s_rb)


def moe_ffn(h, wg, bg, we, be, w_gate, w_up, w_down):
    T, D = h.shape
    logits_g = (h @ wg).astype(jnp.float32) + bg.astype(jnp.float32)
    p_g = jax.nn.softmax(logits_g, axis=-1)
    grp = jnp.argmax(logits_g, axis=-1)
    p_sel = jnp.take_along_axis(p_g, grp[:, None], axis=-1)
    logits_e = ((h @ we).astype(jnp.float32) + be.astype(jnp.float32)).reshape(T, N_GROUPS, EXPERTS_PER_GROUP)
    logits_in = jnp.take_along_axis(logits_e, grp[:, None, None], axis=1)[:, 0]
    top_v, top_i = lax.top_k(logits_in, EXPERT_TOPK)
    gates = p_sel * jax.nn.softmax(top_v, axis=-1)
    expert_id = grp[:, None] * EXPERTS_PER_GROUP + top_i

    n_assign = T * EXPERT_TOPK
    flat_e = expert_id.reshape(-1).astype(jnp.int32)
    flat_tok = jnp.repeat(jnp.arange(T, dtype=jnp.int32), EXPERT_TOPK)
    flat_gate = gates.reshape(-1)
    order = jnp.argsort(flat_e)
    sorted_e = flat_e[order]
    counts = jnp.bincount(flat_e, length=N_EXPERTS)
    padded = (counts + MOE_BLOCK - 1) // MOE_BLOCK * MOE_BLOCK
    padded_end = jnp.cumsum(padded)
    start = jnp.cumsum(counts) - counts
    dest = (padded_end - padded)[sorted_e] + jnp.arange(n_assign, dtype=jnp.int32) - start[sorted_e]
    n_blocks = (n_assign + N_EXPERTS * (MOE_BLOCK - 1) + MOE_BLOCK - 1) // MOE_BLOCK
    slots = n_blocks * MOE_BLOCK
    slot_tok = jnp.full((slots,), T, dtype=jnp.int32).at[dest].set(flat_tok[order])
    slot_gate = jnp.zeros((slots,), jnp.float32).at[dest].set(flat_gate[order])
    block_e = jnp.minimum(jnp.searchsorted(padded_end, jnp.arange(n_blocks, dtype=jnp.int32) * MOE_BLOCK, side='right'), N_EXPERTS - 1)

    h_pad = jnp.concatenate([h, jnp.zeros((1, D), h.dtype)], axis=0)
    xb = h_pad[slot_tok].reshape(n_blocks, MOE_BLOCK, D)

    def expert_block(args):
        xblk, e = args
        return (jax.nn.silu(xblk @ w_gate[e]) * (xblk @ w_up[e])) @ w_down[e]

    yb = lax.map(expert_block, (xb, block_e)).reshape(slots, D)
    y = jax.ops.segment_sum(yb * slot_gate[:, None].astype(yb.dtype), slot_tok, num_segments=T + 1)
    return y[:T]


def setup_inputs(seed: int = 0) -> dict:
    key = jax.random.key(seed)
    ks = jax.random.split(key, 24)
    f32 = jnp.float32
    nrm = lambda k, shape, s: jax.random.normal(k, shape, f32) * s
    h_idx = jnp.arange(RET_HEADS, dtype=f32)
    ret_init = jnp.log(2.0 ** (5.0 + h_idx) - 1.0)
    return {
        "x": nrm(ks[0], (BATCH, SEQ, D_MODEL), 1.0),
        "c": nrm(ks[1], (BATCH, D_MODEL), 1.0),
        "ctx": nrm(ks[2], (BATCH, CTX_LEN, D_MODEL), 1.0),
        "c_ctx": nrm(ks[3], (D_MODEL,), 1.0),
        "w_mod": nrm(ks[4], (DEPTH, D_MODEL, 6 * D_MODEL), 0.01),
        "b_mod": nrm(ks[5], (DEPTH, 6 * D_MODEL), 0.01),
        "norm_w": 1.0 + nrm(ks[6], (DEPTH, 4, D_MODEL), 0.02),
        "w_in": nrm(ks[7], (DEPTH, D_MODEL, PROJ_WIDTH), D_MODEL ** -0.5),
        "hg_lb_logits": nrm(ks[8], (DEPTH + 1, 2, HG_QK), 0.1),
        "hg_norm_w": 1.0 + nrm(ks[9], (DEPTH, HG_WIDTH), 0.02),
        "ret_decay_logits": ret_init + nrm(ks[10], (DEPTH, 2, RET_HEADS), 0.01),
        "ret_norm_w": 1.0 + nrm(ks[11], (DEPTH, RET_WIDTH), 0.02),
        "w_out": nrm(ks[12], (DEPTH, MIX_WIDTH, D_MODEL), MIX_WIDTH ** -0.5),
        "router_group_w": nrm(ks[13], (DEPTH, D_MODEL, N_GROUPS), D_MODEL ** -0.5),
        "router_group_b": nrm(ks[14], (DEPTH, N_GROUPS), 0.01),
        "router_expert_w": nrm(ks[15], (DEPTH, D_MODEL, N_EXPERTS), D_MODEL ** -0.5),
        "router_expert_b": nrm(ks[16], (DEPTH, N_EXPERTS), 0.01),
        "w_gate": nrm(ks[17], (DEPTH, N_EXPERTS, D_MODEL, D_EXPERT), D_MODEL ** -0.5),
        "w_up": nrm(ks[18], (DEPTH, N_EXPERTS, D_MODEL, D_EXPERT), D_MODEL ** -0.5),
        "w_down": nrm(ks[19], (DEPTH, N_EXPERTS, D_EXPERT, D_MODEL), D_EXPERT ** -0.5),
    }


def reference(x, c, ctx, c_ctx, w_mod, b_mod, norm_w, w_in, hg_lb_logits, hg_norm_w, ret_decay_logits, ret_norm_w, w_out, router_group_w, router_group_b, router_expert_w, router_expert_b, w_gate, w_up, w_down):
    B, N, D = x.shape
    Bc, L, _ = ctx.shape
    rope = axial_rope(N)
    lb_all = jnp.cumsum(jax.nn.softmax(hg_lb_logits.astype(jnp.float32), axis=0), axis=0)
    zero_states = (
        jnp.zeros((B, HG_HEADS, HG_DK, HG_DV), jnp.float32),
        jnp.zeros((B, HG_HEADS, HG_DK, HG_DV), jnp.float32),
        jnp.zeros((B, RET_HEADS, RET_DK, RET_DV), jnp.float32),
        jnp.zeros((B, RET_HEADS, RET_DK, RET_DV), jnp.float32),
    )
    for l in range(DEPTH):
        mod_x = jax.nn.silu(c) @ w_mod[l] + b_mod[l]
        mod_c = jax.nn.silu(c_ctx) @ w_mod[l] + b_mod[l]
        sh1, sc1, g1, sh2, sc2, g2 = jnp.split(mod_x[:, None, :], 6, axis=-1)
        csh1, csc1, cg1, csh2, csc2, cg2 = jnp.split(mod_c, 6, axis=-1)
        lb = lb_all[l].reshape(2, HG_HEADS, 1, HG_DK)
        ret_lg = jax.nn.log_sigmoid(ret_decay_logits[l].astype(jnp.float32))

        hc = rms_norm(ctx, norm_w[l, 0]) * (1.0 + csc1) + csh1
        hx = rms_norm(x, norm_w[l, 0]) * (1.0 + sc1) + sh1
        out_c, ctx_states = mixer_stream(hc, w_in[l], w_out[l], lb, ret_lg, hg_norm_w[l], ret_norm_w[l], zero_states, None)
        out_x, _ = mixer_stream(hx, w_in[l], w_out[l], lb, ret_lg, hg_norm_w[l], ret_norm_w[l], ctx_states, rope)
        x = x + g1 * rms_norm(out_x, norm_w[l, 1])

        hx = rms_norm(x, norm_w[l, 2]) * (1.0 + sc2) + sh2
        ffn_x = moe_ffn(hx.reshape(B * N, D), router_group_w[l], router_group_b[l], router_expert_w[l], router_expert_b[l], w_gate[l], w_up[l], w_down[l]).reshape(B, N, D)
        x = x + g2 * rms_norm(ffn_x, norm_w[l, 3])

        if l < DEPTH - 1:
            ctx = ctx + cg1 * rms_norm(out_c, norm_w[l, 1])
            hc = rms_norm(ctx, norm_w[l, 2]) * (1.0 + csc2) + csh2
            ffn_c = moe_ffn(hc.reshape(Bc * L, D), router_group_w[l], router_group_b[l], router_expert_w[l], router_expert_b[l], w_gate[l], w_up[l], w_down[l]).reshape(Bc, L, D)
            ctx = ctx + cg2 * rms_norm(ffn_c, norm_w[l, 3])
    return x
```

```cpp
#include <hip/hip_runtime.h>
#include <hip/hip_cooperative_groups.h>
#include <cstdio>
#include <cstdint>
namespace cg = cooperative_groups;

namespace pg8 {
#define PG8_LAS __attribute__((address_space(3)))
typedef unsigned short bf16_t;
typedef short bf16x8 __attribute__((ext_vector_type(8)));
typedef float f32x4 __attribute__((ext_vector_type(4)));
typedef unsigned u32x4 __attribute__((ext_vector_type(4)));
constexpr int BM = 256, BK = 64, HALF = 128, HTB = HALF * BK * 2  , STAGE_BYTES = 8 * HTB, NXCD = 8, WGM = 8;

__host__ __device__ __forceinline__ int lds_byte(int r, int c) { const int st = (r >> 4) * 2 + (c >> 5), rr = r & 15, cc = c & 31, ob = rr * 64 + cc * 2; return st * 1024 + (ob ^ (((ob >> 9) & 1) << 5)); }
__host__ __device__ __forceinline__ void stage_rc(int b, int& R, int& C) { const int st = b / 1024, sb = b % 1024, swz = sb ^ (((sb >> 9) & 1) << 5); R = (st >> 1) * 16 + swz / 64; C = (st & 1) * 32 + (swz % 64) / 2; }
__host__ __device__ __forceinline__ int perm32(int rho) { const int n = rho >> 4, i = rho & 15; return 8 * (i >> 2) + 4 * n + (i & 3); }

struct Unit { int pm, pn, pb; };
struct Gemm { const bf16_t* A; const bf16_t* Bt; int M, N, K; };

struct StaticOrder {
    int nM, nN, nwg, G, c;
    __host__ __device__ void init(int M, int N, int G_, int c_) { nM = M / BM; nN = N / BM; nwg = nM * nN; G = G_; c = c_; }
    __host__ __device__ bool next(int i, Unit& u) const {
        const long L = (long)i * G + c; if (L >= nwg) return false;
        int wgid = (int)L; { const int q = nwg / NXCD, r = nwg % NXCD, xcd = wgid % NXCD, off = wgid / NXCD; wgid = (xcd < r ? xcd * (q + 1) : r * (q + 1) + (xcd - r) * q) + off; }
        const int nig = WGM * nN, gid = wgid / nig, fm = gid * WGM, gsz = (nM - fm) < WGM ? (nM - fm) : WGM;
        u.pm = fm + ((wgid % nig) % gsz); u.pn = (wgid % nig) / gsz; u.pb = u.pn; return true;
    }
    __device__ __forceinline__ void a_ready(const Unit&) const {}
    __device__ __forceinline__ void done(const Unit&) const {}
};

__device__ __forceinline__ unsigned cvt_pk_bf16(float lo, float hi) { unsigned r; asm volatile("v_cvt_pk_bf16_f32 %0, %1, %2" : "=v"(r) : "v"(lo), "v"(hi)); return r; }
template <class Epi, class Sched, bool ALIGN_EPI = false, bool SP2 = false>
__device__ __forceinline__ void gemm_phase(PG8_LAS unsigned char* lds, const Gemm g, const Sched& S, const Epi& E) {
    const int tid = threadIdx.x, wid = __builtin_amdgcn_readfirstlane(tid >> 6), lane = tid & 63, wr = wid >> 2, wc = wid & 3, fr = lane & 15, fq = lane >> 4;
    const int K = g.K, nt = K / BK;
    unsigned voffA[2], voffB[2];
#pragma unroll
    for (int i = 0; i < 2; ++i) { int R, C; stage_rc(tid * 16 + i * 8192, R, C); const int Rb = Epi::PERM ? ((R & ~31) + perm32(R & 31)) : R;
        voffA[i] = (unsigned)(R * K + C) * 2u; voffB[i] = (unsigned)(Rb * K + C) * 2u; }
    const size_t kstep = (size_t)(BK * 2);
    const size_t hstep = (size_t)HALF * K * 2;
    const size_t tstep = 2 * hstep;
    const unsigned ldsw = (unsigned)wid * 1024u;
    const int aoff = lds_byte(wr * 64 + fr, fq * 8), boff = lds_byte(wc * 32 + fr, fq * 8);
#define PG8_SA(b, h) (((b) * 2 + (h)) * HTB)
#define PG8_SB(b, h) ((4 + (b) * 2 + (h)) * HTB)
#define PG8_STAGE(bufoff, gbase, voff) do { _Pragma("unroll") for (int _i = 0; _i < 2; ++_i) \
        __builtin_amdgcn_global_load_lds((const unsigned*)((const char*)(gbase) + (voff)[_i]), (PG8_LAS unsigned*)(lds + (bufoff) + ldsw + _i * 8192), 16, 0, 0); } while (0)
#define PG8_LDA(dst, b, h) do { _Pragma("unroll") for (int m = 0; m < 4; ++m) _Pragma("unroll") for (int k = 0; k < 2; ++k) dst[m][k] = *(const PG8_LAS bf16x8*)(lds + PG8_SA(b, h) + aoff + m * 2048 + k * 1024); } while (0)
#define PG8_LDB(dst, b, h) do { _Pragma("unroll") for (int n = 0; n < 2; ++n) _Pragma("unroll") for (int k = 0; k < 2; ++k) dst[n][k] = *(const PG8_LAS bf16x8*)(lds + PG8_SB(b, h) + boff + n * 2048 + k * 1024); } while (0)
#define PG8_MMA(ai, bj, At, Bt) do { __builtin_amdgcn_s_setprio(1); _Pragma("unroll") for (int m = 0; m < 4; ++m) _Pragma("unroll") for (int n = 0; n < 2; ++n) _Pragma("unroll") for (int k = 0; k < 2; ++k) \
        acc[ai][bj][m][n] = __builtin_amdgcn_mfma_f32_16x16x32_bf16(Bt[n][k], At[m][k], acc[ai][bj][m][n], 0, 0, 0); __builtin_amdgcn_s_setprio(0); } while (0)
#define PG8_WAIT_V(n) asm volatile("s_waitcnt vmcnt(" #n ")" ::: "memory")
#define PG8_WAIT_L(n) asm volatile("s_waitcnt lgkmcnt(" #n ")" ::: "memory")
#define PG8_BAR __builtin_amdgcn_s_barrier()
#define PG8_SCHED __builtin_amdgcn_sched_barrier(0)
    Unit cur, nxt; int ui = 0;
    if (!S.next(0, cur)) return;
    f32x4 acc[2][2][4][2];
#pragma unroll
    for (int a = 0; a < 2; ++a)
#pragma unroll
        for (int b = 0; b < 2; ++b)
#pragma unroll
            for (int m = 0; m < 4; ++m)
#pragma unroll
                for (int n = 0; n < 2; ++n) acc[a][b][m][n] = (f32x4){0.f, 0.f, 0.f, 0.f};
    bf16x8 At[4][2], B0[2][2], B1[2][2];
    const char* cA = (const char*)g.A + (size_t)cur.pm * tstep; const char* cB = (const char*)g.Bt + (size_t)cur.pb * tstep;
    S.a_ready(cur);
    if constexpr (SP2) {
        PG8_STAGE(PG8_SB(0, 0), cB, voffB); PG8_STAGE(PG8_SB(0, 1), cB + hstep, voffB); PG8_STAGE(PG8_SA(0, 0), cA, voffA); PG8_STAGE(PG8_SA(0, 1), cA + hstep, voffA);
        if (wr == 1) PG8_BAR;
        PG8_WAIT_V(2); PG8_BAR;
        PG8_STAGE(PG8_SB(1, 0), cB + kstep, voffB); PG8_STAGE(PG8_SA(1, 0), cA + kstep, voffA); PG8_STAGE(PG8_SB(1, 1), cB + hstep + kstep, voffB);
        PG8_WAIT_V(6); PG8_BAR;
    } else {
        PG8_STAGE(PG8_SB(0, 0), cB, voffB); PG8_STAGE(PG8_SA(0, 0), cA, voffA); PG8_STAGE(PG8_SB(0, 1), cB + hstep, voffB); PG8_STAGE(PG8_SA(0, 1), cA + hstep, voffA);
        if (wr == 1) PG8_BAR;
        PG8_WAIT_V(4); PG8_BAR;
        PG8_STAGE(PG8_SB(1, 0), cB + kstep, voffB); PG8_STAGE(PG8_SA(1, 0), cA + kstep, voffA); PG8_STAGE(PG8_SB(1, 1), cB + hstep + kstep, voffB);
        PG8_WAIT_V(6); PG8_BAR;
    }
    for (;;) {
        const bool has_next = S.next(ui + 1, nxt);
        const char* nA = has_next ? (const char*)g.A + (size_t)nxt.pm * tstep : cA; const char* nB = has_next ? (const char*)g.Bt + (size_t)nxt.pb * tstep : cB;
        for (int t = 0; t < nt; t += 2) {
            const bool last = (t == nt - 2);
            const char* a1 = cA + (size_t)(t + 1) * kstep;
            const char* a2 = last ? nA : cA + (size_t)(t + 2) * kstep; const char* b2 = last ? nB : cB + (size_t)(t + 2) * kstep;
            const char* a3 = a2 + kstep; const char* b3 = b2 + kstep;
            if (last && has_next) S.a_ready(nxt);
            if constexpr (SP2) {
            PG8_LDB(B0, 0, 0); PG8_LDB(B1, 0, 1); PG8_SCHED; PG8_LDA(At, 0, 0); PG8_STAGE(PG8_SA(1, 1), a1 + hstep, voffA);
            PG8_WAIT_V(8); PG8_WAIT_L(0); PG8_BAR; PG8_MMA(0, 0, At, B0); PG8_MMA(0, 1, At, B1); PG8_BAR; PG8_SCHED;
            PG8_LDA(At, 0, 1); PG8_STAGE(PG8_SB(0, 0), b2, voffB); PG8_STAGE(PG8_SB(0, 1), b2 + hstep, voffB); PG8_STAGE(PG8_SA(0, 0), a2, voffA);
            PG8_WAIT_V(8); PG8_WAIT_L(0); PG8_BAR; PG8_MMA(1, 0, At, B0); PG8_MMA(1, 1, At, B1); PG8_BAR; PG8_SCHED;
            PG8_LDB(B0, 1, 0); PG8_LDB(B1, 1, 1); PG8_SCHED; PG8_LDA(At, 1, 0); PG8_STAGE(PG8_SA(0, 1), a2 + hstep, voffA);
            PG8_WAIT_V(8); PG8_WAIT_L(0); PG8_BAR; PG8_MMA(0, 0, At, B0); PG8_MMA(0, 1, At, B1); PG8_BAR; PG8_SCHED;
            PG8_LDA(At, 1, 1); PG8_STAGE(PG8_SB(1, 0), b3, voffB); PG8_STAGE(PG8_SB(1, 1), b3 + hstep, voffB); PG8_STAGE(PG8_SA(1, 0), a3, voffA);
            PG8_WAIT_V(8); PG8_WAIT_L(0); PG8_BAR; PG8_MMA(1, 0, At, B0); PG8_MMA(1, 1, At, B1); PG8_BAR; PG8_SCHED;
            } else {
            PG8_LDB(B0, 0, 0); PG8_SCHED; PG8_LDA(At, 0, 0); PG8_STAGE(PG8_SA(1, 1), a1 + hstep, voffA);
            PG8_WAIT_L(8); PG8_BAR; PG8_WAIT_L(0); PG8_MMA(0, 0, At, B0); PG8_BAR; PG8_SCHED;
            PG8_LDB(B1, 0, 1); PG8_STAGE(PG8_SB(0, 0), b2, voffB);
            PG8_BAR; PG8_WAIT_L(0); PG8_MMA(0, 1, At, B1); PG8_BAR;
            PG8_LDA(At, 0, 1); PG8_STAGE(PG8_SA(0, 0), a2, voffA);
            PG8_BAR; PG8_WAIT_L(0); PG8_MMA(1, 0, At, B0); PG8_BAR; PG8_SCHED;
            PG8_STAGE(PG8_SB(0, 1), b2 + hstep, voffB);
            PG8_WAIT_V(6); PG8_BAR; PG8_MMA(1, 1, At, B1); PG8_BAR;
            PG8_LDB(B0, 1, 0); PG8_SCHED; PG8_LDA(At, 1, 0); PG8_STAGE(PG8_SA(0, 1), a2 + hstep, voffA);
            PG8_WAIT_L(8); PG8_BAR; PG8_WAIT_L(0); PG8_MMA(0, 0, At, B0); PG8_BAR; PG8_SCHED;
            PG8_LDB(B1, 1, 1); PG8_STAGE(PG8_SB(1, 0), b3, voffB);
            PG8_BAR; PG8_WAIT_L(0); PG8_MMA(0, 1, At, B1); PG8_BAR;
            PG8_LDA(At, 1, 1); PG8_STAGE(PG8_SA(1, 0), a3, voffA);
            PG8_BAR; PG8_WAIT_L(0); PG8_MMA(1, 0, At, B0); PG8_BAR; PG8_SCHED;
            PG8_STAGE(PG8_SB(1, 1), b3 + hstep, voffB);
            PG8_WAIT_V(6); PG8_BAR; PG8_MMA(1, 1, At, B1); PG8_BAR;
            }
        }
        if constexpr (ALIGN_EPI) { if (wr == 0) PG8_BAR; }
        if constexpr (!Epi::AFTER_DRAIN) { E(acc, cur, wr, wc, fr, fq); S.done(cur); }
        if (!has_next) break;
#pragma unroll
        for (int a = 0; a < 2; ++a)
#pragma unroll
            for (int b = 0; b < 2; ++b)
#pragma unroll
                for (int m = 0; m < 4; ++m)
#pragma unroll
                    for (int n = 0; n < 2; ++n) acc[a][b][m][n] = (f32x4){0.f, 0.f, 0.f, 0.f};
        cur = nxt; cA = nA; cB = nB; ++ui;
        if constexpr (ALIGN_EPI) { if (wr == 1) PG8_BAR; }
    }
    PG8_WAIT_V(0);
    if constexpr (!ALIGN_EPI) { if (wr == 0) PG8_BAR; }
    PG8_BAR;
    if constexpr (Epi::AFTER_DRAIN) { E.fused(acc, cur, wr, wc, fr, fq, lds, wid, lane); S.done(cur); }
#undef PG8_SA
#undef PG8_SB
#undef PG8_STAGE
#undef PG8_LDA
#undef PG8_LDB
#undef PG8_MMA
#undef PG8_WAIT_V
#undef PG8_WAIT_L
#undef PG8_BAR
#undef PG8_SCHED
}
}
#define LAS __attribute__((address_space(3)))
typedef unsigned short bf16_t;
typedef short bf16x8 __attribute__((ext_vector_type(8)));
typedef float f32x4 __attribute__((ext_vector_type(4)));
typedef float f32x2 __attribute__((ext_vector_type(2)));
typedef unsigned u32x4 __attribute__((ext_vector_type(4)));
typedef unsigned u32x2 __attribute__((ext_vector_type(2)));

constexpr int DM = 2048, SEQ = 8192, CTXL = 256, MT = SEQ + CTXL, PW = 8192;
constexpr int NCH = MT / 64  , NXCH = SEQ / 64  , NCCH = CTXL / 64  ;
constexpr int NE = 32, DE = 1024, NGRP = 256  ;
constexpr float EPS = 1e-6f;
constexpr int NWAVES = 8, NTHREADS = 512;
constexpr int LDS_BYTES = 147456;

constexpr size_t MiB = 1u << 20;
constexpr size_t WS_WTGU = 0, WS_WTD = 256 * MiB, WS_CTL = 384 * MiB, WS_WTIN = 388 * MiB, WS_WTOUT = 420 * MiB;
constexpr size_t WS_H = 428 * MiB, WS_Q = 461 * MiB, WS_GF = 478 * MiB, WS_GB = 511 * MiB, WS_V = 544 * MiB, WS_HGATE = 561 * MiB;
constexpr size_t WS_RQ = 578 * MiB, WS_RK = 587 * MiB, WS_RV = 596 * MiB, WS_RGATE = 613 * MiB;
constexpr size_t WS_LOCAL = 630 * MiB, WS_DEC = 762 * MiB, WS_SST = 764 * MiB, WS_PREOUT = 892 * MiB, WS_END = 924 * MiB;
constexpr size_t WS_OUTX = 428 * MiB, WS_HX2 = 492 * MiB, WS_XS = 524 * MiB, WS_GACT = 620 * MiB, WS_YB = 668 * MiB;
constexpr size_t CTL_MODP = 0, CTL_LB = 256 * 1024, CTL_CNT = 272 * 1024, CTL_ROUTE = 304 * 1024, CTL_SLOT = 432 * 1024, CTL_TILES = 496 * 1024, CTL_WR = 512 * 1024;
constexpr size_t LOCAL_RET_OFF = (size_t)2 * 8 * NCH * 128 * 128 * 2;
constexpr size_t SST_RET_OFF = (size_t)2 * 8 * NXCH * 128 * 128 * 2;
constexpr int DEC_RET_ITEM0 = 2 * 8 * NCH;

struct Params {
    const float *x, *c, *ctx, *c_ctx, *w_mod, *b_mod, *norm_w, *w_in, *hg_lb, *hg_nw, *ret_dl, *ret_nw, *w_out, *rgw, *rgb, *rew, *reb, *w_gate, *w_up, *w_down;
    float* out; unsigned char* ws;
    int ph_lo, ph_hi;
};

#define LDS_WAIT() asm volatile("s_waitcnt lgkmcnt(0)" ::: "memory")
__device__ __forceinline__ unsigned f2bf(float f) { unsigned u = __builtin_bit_cast(unsigned, f); return (u + 0x7fffu + ((u >> 16) & 1u)) >> 16; }
__device__ __forceinline__ unsigned pk2(float lo, float hi) { return f2bf(lo) | (f2bf(hi) << 16); }
__device__ __forceinline__ float bflo(unsigned w) { return __builtin_bit_cast(float, w << 16); }
__device__ __forceinline__ float bfhi(unsigned w) { return __builtin_bit_cast(float, w & 0xffff0000u); }
__device__ __forceinline__ float silu_f(float z) { return z / (1.f + __expf(-z)); }
__device__ __forceinline__ float sigmoid_f(float z) { return 1.f / (1.f + __expf(-z)); }
__device__ __forceinline__ float wave_sum(float v) {
#pragma unroll
    for (int o = 1; o < 64; o <<= 1) v += __shfl_xor(v, o);
    return v;
}
__device__ __forceinline__ f32x4 mfma16(bf16x8 a, bf16x8 b, f32x4 c) { return __builtin_amdgcn_mfma_f32_16x16x32_bf16(a, b, c, 0, 0, 0); }
__device__ __forceinline__ float log_sigmoid_f(float z) { return fminf(z, 0.f) - log1pf(__expf(-fabsf(z))); }

__device__ __forceinline__ void p0_gemv(const Params& p, LAS unsigned char* lds) {
    const int tid = threadIdx.x, wave = tid >> 6, lane = tid & 63;
    float* modp = (float*)(p.ws + WS_CTL + CTL_MODP);
    LAS float* red = (LAS float*)lds;
    for (int it = blockIdx.x; it < 192; it += gridDim.x) {
        const int cb = it % 48, kq = it / 48;
        const int col = cb * 256 + lane * 4;
        const int r0 = kq * 512 + wave * 64;
        const bool hasc = cb < 16;
        f32x4 ax = {0.f, 0.f, 0.f, 0.f}, ac = {0.f, 0.f, 0.f, 0.f};
        for (int r = 0; r < 64; r += 16) {
            f32x4 w[16];
#pragma unroll
            for (int i = 0; i < 16; ++i) w[i] = *(const f32x4*)(p.w_mod + (size_t)(r0 + r + i) * 12288 + col);
#pragma unroll
            for (int i = 0; i < 16; ++i) {
                const float sx = silu_f(p.c[r0 + r + i]); ax += w[i] * sx;
                if (hasc) { const float sc = silu_f(p.c_ctx[r0 + r + i]); ac += w[i] * sc; }
            }
        }
        *(LAS f32x4*)(red + (wave * 2 + 0) * 256 + lane * 4) = ax;
        *(LAS f32x4*)(red + (wave * 2 + 1) * 256 + lane * 4) = ac;
        __syncthreads();
        const int vsel = tid >> 8, cc = tid & 255;
        float s = 0.f;
#pragma unroll
        for (int w8 = 0; w8 < 8; ++w8) s += red[(w8 * 2 + vsel) * 256 + cc];
        if (vsel == 0) modp[kq * 16384 + cb * 256 + cc] = s; else if (hasc) modp[kq * 16384 + 12288 + cb * 256 + cc] = s;
        __syncthreads();
    }
}
__device__ __forceinline__ void transpose_item(const float* W, int ldw, int K, int k0, int n0src, bf16_t* WT, size_t drow0, LAS float* scr, int lane) {
    f32x4 v[16];
    const int rr = lane >> 4, c4 = (lane & 15) * 4;
#pragma unroll
    for (int i = 0; i < 16; ++i) v[i] = *(const f32x4*)(W + (size_t)(k0 + rr + 4 * i) * ldw + n0src + c4);
#pragma unroll
    for (int i = 0; i < 16; ++i) { LAS float* d = scr + (rr + 4 * i) * 65 + c4; d[0] = v[i][0]; d[1] = v[i][1]; d[2] = v[i][2]; d[3] = v[i][3]; }
    LDS_WAIT(); asm volatile("" ::: "memory");
    const int c = lane & 7;
#pragma unroll
    for (int j = 0; j < 8; ++j) {
        const int n = (lane >> 3) + 8 * j; const LAS float* s = scr + (8 * c) * 65 + n;
        u32x4 o; o.x = pk2(s[0 * 65], s[1 * 65]); o.y = pk2(s[2 * 65], s[3 * 65]); o.z = pk2(s[4 * 65], s[5 * 65]); o.w = pk2(s[6 * 65], s[7 * 65]);
        *(u32x4*)(WT + (drow0 + n) * (size_t)K + k0 + 8 * c) = o;
    }
    LDS_WAIT(); asm volatile("" ::: "memory");
}
__device__ __forceinline__ void p0_prologue(const Params& p, LAS unsigned char* lds) {
    const int tid = threadIdx.x, wave = __builtin_amdgcn_readfirstlane(tid >> 6), lane = tid & 63;
    p0_gemv(p, lds);
    {
        float* LB = (float*)(p.ws + WS_CTL + CTL_LB); float* WR = (float*)(p.ws + WS_CTL + CTL_WR);
        const int gt = blockIdx.x * NTHREADS + tid, NT = gridDim.x * NTHREADS;
        for (int i = gt; i < 2048; i += NT) { const float l0 = p.hg_lb[i], l1 = p.hg_lb[2048 + i]; LB[i] = 1.f / (1.f + __expf(l1 - l0)); }
        for (int i = gt; i < 36 * 2048; i += NT) { const int o = i >> 11, k = i & 2047; WR[i] = (o < 4) ? p.rgw[k * 4 + o] : p.rew[k * 32 + (o - 4)]; }
    }
    LAS float* scr = (LAS float*)(lds + wave * 16640);
    const int gw = blockIdx.x * NWAVES + wave, NGW = gridDim.x * NWAVES;
    bf16_t* WTIN = (bf16_t*)(p.ws + WS_WTIN); bf16_t* WTOUT = (bf16_t*)(p.ws + WS_WTOUT); bf16_t* WTGU = (bf16_t*)(p.ws + WS_WTGU); bf16_t* WTD = (bf16_t*)(p.ws + WS_WTD);
    constexpr int I_IN = 32 * 128, I_OUT = 32 * 32, I_G = 32 * 32 * 16, I_D = 32 * 16 * 32;
    constexpr int NITEMS = I_IN + I_OUT + 2 * I_G + I_D;
    for (int it = gw; it < NITEMS; it += NGW) {
        int r = it;
        if (r < I_IN) {
            const int kb = r / 128, nb = r % 128; const int drow = nb * 64, pn = drow >> 8;
            int src = drow;
            if (pn >= 20 && pn < 24) { const int q4 = (drow & 255) >> 6, bj = q4 >> 1, hl = q4 & 1; const int pn0 = pn >= 22 ? 22 : 20; src = (pn >= 22 ? 5632 : 5120) + ((pn - pn0) * 2 + hl) * 128 + bj * 64; }
            transpose_item(p.w_in, PW, DM, kb * 64, src, WTIN, (size_t)drow, scr, lane); continue; }
        r -= I_IN;
        if (r < I_OUT) { const int kb = r / 32, nb = r % 32; transpose_item(p.w_out, DM, DM, kb * 64, nb * 64, WTOUT, (size_t)nb * 64, scr, lane); continue; }
        r -= I_OUT;
        if (r < 2 * I_G) {
            const int isup = r >= I_G; if (isup) r -= I_G;
            const int e = r / 512, rem = r % 512, kb = rem / 16, nb = rem % 16, n0 = nb * 64;
            const float* W = (isup ? p.w_up : p.w_gate) + (size_t)e * DM * DE;
            transpose_item(W, DE, DM, kb * 64, n0, WTGU, (size_t)e * 2048 + (n0 >> 7) * 256 + isup * 128 + (n0 & 127), scr, lane); continue; }
        r -= 2 * I_G;
        { const int e = r / 512, rem = r % 512, kb = rem / 32, nb = rem % 32;
          transpose_item(p.w_down + (size_t)e * DE * DM, DM, DE, kb * 64, nb * 64, WTD, (size_t)e * 2048 + nb * 64, scr, lane); }
    }
}

__device__ __forceinline__ void mod_reduce_to_lds(const Params& p, LAS float* dst, int j0, int n, bool ctxvec) {
    const float* modp = (const float*)(p.ws + WS_CTL + CTL_MODP);
    for (int i = threadIdx.x; i < n; i += NTHREADS) {
        const int j = j0 + i; const int jj = ctxvec ? 12288 + j : j;
        dst[i] = ((modp[jj] + modp[16384 + jj]) + (modp[2 * 16384 + jj] + modp[3 * 16384 + jj])) + p.b_mod[j];
    }
}
__device__ __forceinline__ void p1_hrows(const Params& p, LAS unsigned char* lds) {
    const int tid = threadIdx.x, wave = tid >> 6, lane = tid & 63;
    LAS float* SH = (LAS float*)lds; LAS float* SC = SH + 2048; LAS float* CSH = SC + 2048; LAS float* CSC = CSH + 2048;
    mod_reduce_to_lds(p, SH, 0, 2048, false); mod_reduce_to_lds(p, SC, 2048, 2048, false);
    mod_reduce_to_lds(p, CSH, 0, 2048, true); mod_reduce_to_lds(p, CSC, 2048, 2048, true);
    __syncthreads();
    bf16_t* H = (bf16_t*)(p.ws + WS_H);
    const int gw = blockIdx.x * NWAVES + wave, NGW = gridDim.x * NWAVES;
    for (int m = gw; m < MT; m += NGW) {
        const bool isc = m < CTXL;
        const float* xr = isc ? p.ctx + (size_t)m * DM : p.x + (size_t)(m - CTXL) * DM;
        const LAS float* sh = isc ? CSH : SH; const LAS float* sc = isc ? CSC : SC;
        f32x4 v[8]; float ss = 0.f;
#pragma unroll
        for (int j = 0; j < 8; ++j) { v[j] = *(const f32x4*)(xr + 4 * (lane + 64 * j)); ss += (v[j][0] * v[j][0] + v[j][1] * v[j][1]) + (v[j][2] * v[j][2] + v[j][3] * v[j][3]); }
        const float rstd = rsqrtf(wave_sum(ss) * (1.f / DM) + EPS);
#pragma unroll
        for (int j = 0; j < 8; ++j) {
            const int col = 4 * (lane + 64 * j);
            const f32x4 nw = *(const f32x4*)(p.norm_w + col); const f32x4 a = *(const LAS f32x4*)(sc + col); const f32x4 b = *(const LAS f32x4*)(sh + col);
            const f32x4 o = (v[j] * rstd * nw) * (a + 1.f) + b;
            u32x2 w; w.x = pk2(o[0], o[1]); w.y = pk2(o[2], o[3]);
            *(u32x2*)(H + (size_t)m * DM + col) = w;
        }
    }
}

struct EpiF32 {
    static constexpr bool PERM = false, AFTER_DRAIN = false;
    float* C; int ldc;
    __device__ __forceinline__ void operator()(const f32x4 (&acc)[2][2][4][2], const pg8::Unit& u, int wr, int wc, int fr, int fq) const {
        const int row0 = u.pm * 256 + wr * 64 + fr, col0 = u.pn * 256 + wc * 32 + 4 * fq;
#pragma unroll
        for (int ai = 0; ai < 2; ++ai)
#pragma unroll
            for (int m = 0; m < 4; ++m) { float* rowp = C + (size_t)(row0 + ai * 128 + m * 16) * ldc + col0;
#pragma unroll
                for (int bj = 0; bj < 2; ++bj)
#pragma unroll
                    for (int n = 0; n < 2; ++n) *(f32x4*)(rowp + bj * 128 + n * 16) = acc[ai][bj][m][n]; }
    }
};
struct EpiGateUp {
    static constexpr bool PERM = false, AFTER_DRAIN = false;
    bf16_t* G;
    __device__ __forceinline__ void operator()(const f32x4 (&acc)[2][2][4][2], const pg8::Unit& u, int wr, int wc, int fr, int fq) const {
        const int row0 = u.pm * 256 + wr * 64 + fr, col0 = u.pn * 128 + wc * 32 + 4 * fq;
#pragma unroll
        for (int ai = 0; ai < 2; ++ai)
#pragma unroll
            for (int m = 0; m < 4; ++m) { bf16_t* rowp = G + (size_t)(row0 + ai * 128 + m * 16) * DE + col0;
#pragma unroll
                for (int n = 0; n < 2; ++n) { const f32x4 g = acc[ai][0][m][n], up = acc[ai][1][m][n];
                    u32x2 w; w.x = pk2(silu_f(g[0]) * up[0], silu_f(g[1]) * up[1]); w.y = pk2(silu_f(g[2]) * up[2], silu_f(g[3]) * up[3]);
                    *(u32x2*)(rowp + n * 16) = w; } }
    }
};
struct EpiProj {
    static constexpr bool PERM = false, AFTER_DRAIN = false;
    unsigned char* ws;
    __device__ __forceinline__ void store_bf16(bf16_t* base, int ld, int colt, int mode, const f32x4 (&acc)[2][2][4][2], int row0, int wc, int fq) const {
#pragma unroll
        for (int ai = 0; ai < 2; ++ai)
#pragma unroll
            for (int m = 0; m < 4; ++m) { bf16_t* rowp = base + (size_t)(row0 + ai * 128 + m * 16) * ld + colt + wc * 32 + 4 * fq;
#pragma unroll
                for (int bj = 0; bj < 2; ++bj)
#pragma unroll
                    for (int n = 0; n < 2; ++n) { f32x4 v = acc[ai][bj][m][n];
                        if (mode == 1) { v[0] = silu_f(v[0]); v[1] = silu_f(v[1]); v[2] = silu_f(v[2]); v[3] = silu_f(v[3]); }
                        u32x2 w; w.x = pk2(v[0], v[1]); w.y = pk2(v[2], v[3]);
                        *(u32x2*)(rowp + bj * 128 + n * 16) = w; } }
    }
    __device__ __forceinline__ void operator()(const f32x4 (&acc)[2][2][4][2], const pg8::Unit& u, int wr, int wc, int fr, int fq) const {
        const int pn = u.pn, row0 = u.pm * 256 + wr * 64 + fr;
        if (pn < 4) { store_bf16((bf16_t*)(ws + WS_Q), 1024, pn * 256, 1, acc, row0, wc, fq); return; }
        if (pn < 12) {
            const int d = pn >= 8; float* Gp = (float*)(ws + (d ? WS_GB : WS_GF)); const float* LB = (const float*)(ws + WS_CTL + CTL_LB) + d * 1024;
            const int colt = (pn - (d ? 8 : 4)) * 256 + wc * 32 + 4 * fq;
#pragma unroll
            for (int bj = 0; bj < 2; ++bj)
#pragma unroll
                for (int n = 0; n < 2; ++n) { const int col = colt + bj * 128 + n * 16; const f32x4 lb = *(const f32x4*)(LB + col);
#pragma unroll
                    for (int ai = 0; ai < 2; ++ai)
#pragma unroll
                        for (int m = 0; m < 4; ++m) { const f32x4 z = acc[ai][bj][m][n]; f32x4 g;
#pragma unroll
                            for (int j = 0; j < 4; ++j) g[j] = __logf(lb[j] + (1.f - lb[j]) * sigmoid_f(z[j]));
                            *(f32x4*)(Gp + (size_t)(row0 + ai * 128 + m * 16) * 1024 + col) = g; } }
            return; }
        if (pn < 16) { store_bf16((bf16_t*)(ws + WS_V), 1024, (pn - 12) * 256, 0, acc, row0, wc, fq); return; }
        if (pn < 20) { store_bf16((bf16_t*)(ws + WS_HGATE), 1024, (pn - 16) * 256, 1, acc, row0, wc, fq); return; }
        if (pn < 24) {
            const bool isk = pn >= 22; bf16_t* O = (bf16_t*)(ws + (isk ? WS_RK : WS_RQ)); const float scl = isk ? 0.08838834764831845f : 1.f;
            const int head = (pn - (isk ? 22 : 20)) * 2 + (wc >> 1); const bool colang = (wc & 1) != 0; const bool ropeon = u.pm > 0;
#pragma unroll
            for (int ai = 0; ai < 2; ++ai)
#pragma unroll
                for (int m = 0; m < 4; ++m) { const int row = row0 + ai * 128 + m * 16; const int t = row - CTXL; const float pos = (float)(colang ? (t & 63) : (t >> 6));
#pragma unroll
                    for (int n = 0; n < 2; ++n) { const int i0 = 16 * n + 4 * fq; const f32x4 x1 = acc[ai][0][m][n], x2 = acc[ai][1][m][n]; f32x4 o1, o2;
#pragma unroll
                        for (int j = 0; j < 4; ++j) { float cs = 1.f, sn = 0.f;
                            if (ropeon) { const float ang = pos * exp2f(-(float)(i0 + j) * 0.41524101186092029f); cs = __cosf(ang); sn = __sinf(ang); }
                            o1[j] = (x1[j] * cs - x2[j] * sn) * scl; o2[j] = (x1[j] * sn + x2[j] * cs) * scl; }
                        bf16_t* dp = O + (size_t)row * 512 + head * 128 + 32 * (wc & 1) + i0;
                        u32x2 w; w.x = pk2(o1[0], o1[1]); w.y = pk2(o1[2], o1[3]); *(u32x2*)dp = w;
                        w.x = pk2(o2[0], o2[1]); w.y = pk2(o2[2], o2[3]); *(u32x2*)(dp + 64) = w; } }
            return; }
        if (pn < 28) { store_bf16((bf16_t*)(ws + WS_RV), 1024, (pn - 24) * 256, 0, acc, row0, wc, fq); return; }
        store_bf16((bf16_t*)(ws + WS_RGATE), 1024, (pn - 28) * 256, 1, acc, row0, wc, fq);
    }
};
struct MoeOrder {
    const int* tiles; int G, c;
    __device__ __forceinline__ bool next(int i, pg8::Unit& u) const {
        const int nt = tiles[0]; const int L = i * G + c; if (L >= nt * 8) return false;
        const int t = L >> 3, pn = L & 7; u.pm = t; u.pn = pn; u.pb = tiles[1 + t] * 8 + pn; return true;
    }
    __device__ __forceinline__ void a_ready(const pg8::Unit&) const {}
    __device__ __forceinline__ void done(const pg8::Unit&) const {}
};

template <bool RET>
__device__ __forceinline__ void s1_item(const Params& p, LAS unsigned char* lds, int dir, int h, int cc) {
    constexpr int DV = RET ? 256 : 128;
    const int tid = threadIdx.x, sg = __builtin_amdgcn_readfirstlane(tid >> 6), lane = tid & 63, kp = lane;
    LAS unsigned char* KT = lds;
    LAS unsigned char* VT = lds + 18432;
    LAS float* TOT = (LAS float*)(lds + 18432 + 36864);
    const size_t row0 = (size_t)cc * 64;
    const int item = RET ? (dir * 4 + h) * NCH + cc : (dir * 8 + h) * NCH + cc;
    float* DEC = (float*)(p.ws + WS_DEC) + (size_t)((RET ? DEC_RET_ITEM0 : 0) + item) * 128;
    float kx[8], ky[8]; float decx, decy;
    if (!RET) {
        const float* G = (const float*)(p.ws + (dir ? WS_GB : WS_GF)) + (row0 + 8 * sg) * 1024 + h * 128 + 2 * kp;
        f32x2 g[8], cs[8];
#pragma unroll
        for (int i = 0; i < 8; ++i) g[i] = *(const f32x2*)(G + (size_t)i * 1024);
        cs[0] = g[0];
#pragma unroll
        for (int i = 1; i < 8; ++i) cs[i] = cs[i - 1] + g[i];
        *(LAS f32x2*)(TOT + sg * 128 + 2 * kp) = cs[7];
        __syncthreads();
        f32x2 pre = {0.f, 0.f}, T = {0.f, 0.f};
#pragma unroll
        for (int s8 = 0; s8 < 8; ++s8) { const f32x2 t = *(const LAS f32x2*)(TOT + s8 * 128 + 2 * kp); if (s8 < sg) pre += t; T += t; }
#pragma unroll
        for (int i = 0; i < 8; ++i) { f32x2 b = pre + cs[i]; if (dir) b = T - b + g[i];
            kx[i] = (1.f - __expf(g[i].x)) * __expf(-b.x); ky[i] = (1.f - __expf(g[i].y)) * __expf(-b.y); }
        decx = __expf(T.x); decy = __expf(T.y);
    } else {
        const bf16_t* K = (const bf16_t*)(p.ws + WS_RK) + (row0 + 8 * sg) * 512 + h * 128 + 2 * kp;
        const float lg = log_sigmoid_f(p.ret_dl[dir * 4 + h]);
#pragma unroll
        for (int i = 0; i < 8; ++i) { const unsigned w = *(const unsigned*)(K + (size_t)i * 512); const int s = 8 * sg + i; const float e = dir ? (float)(64 - s) : (float)(s + 1);
            const float sc = __expf(-lg * e); kx[i] = bflo(w) * sc; ky[i] = bfhi(w) * sc; }
        decx = decy = __expf(64.f * lg);
    }
    { u32x4 a, b; a.x = pk2(kx[0], kx[1]); a.y = pk2(kx[2], kx[3]); a.z = pk2(kx[4], kx[5]); a.w = pk2(kx[6], kx[7]);
      b.x = pk2(ky[0], ky[1]); b.y = pk2(ky[2], ky[3]); b.z = pk2(ky[4], ky[5]); b.w = pk2(ky[6], ky[7]);
      *(LAS u32x4*)(KT + (2 * kp) * 144 + sg * 16) = a; *(LAS u32x4*)(KT + (2 * kp + 1) * 144 + sg * 16) = b; }
    if (sg == 0) { f32x2 d = {decx, decy}; *(f32x2*)(DEC + 2 * kp) = d; }
    if (!RET) {
        const bf16_t* V = (const bf16_t*)(p.ws + WS_V) + (row0 + 8 * sg) * 1024 + h * 128 + 2 * lane;
        unsigned w[8];
#pragma unroll
        for (int i = 0; i < 8; ++i) w[i] = *(const unsigned*)(V + (size_t)i * 1024);
        u32x4 a, b;
        a.x = (w[0] & 0xffffu) | (w[1] << 16); a.y = (w[2] & 0xffffu) | (w[3] << 16); a.z = (w[4] & 0xffffu) | (w[5] << 16); a.w = (w[6] & 0xffffu) | (w[7] << 16);
        b.x = (w[0] >> 16) | (w[1] & 0xffff0000u); b.y = (w[2] >> 16) | (w[3] & 0xffff0000u); b.z = (w[4] >> 16) | (w[5] & 0xffff0000u); b.w = (w[6] >> 16) | (w[7] & 0xffff0000u);
        *(LAS u32x4*)(VT + (2 * lane) * 144 + sg * 16) = a; *(LAS u32x4*)(VT + (2 * lane + 1) * 144 + sg * 16) = b;
    } else {
        const bf16_t* V = (const bf16_t*)(p.ws + WS_RV) + (row0 + 8 * sg) * 1024 + h * 256 + 4 * lane;
        u32x2 w[8];
#pragma unroll
        for (int i = 0; i < 8; ++i) w[i] = *(const u32x2*)(V + (size_t)i * 1024);
        u32x4 a, b, c, d;
        a.x = (w[0].x & 0xffffu) | (w[1].x << 16); a.y = (w[2].x & 0xffffu) | (w[3].x << 16); a.z = (w[4].x & 0xffffu) | (w[5].x << 16); a.w = (w[6].x & 0xffffu) | (w[7].x << 16);
        b.x = (w[0].x >> 16) | (w[1].x & 0xffff0000u); b.y = (w[2].x >> 16) | (w[3].x & 0xffff0000u); b.z = (w[4].x >> 16) | (w[5].x & 0xffff0000u); b.w = (w[6].x >> 16) | (w[7].x & 0xffff0000u);
        c.x = (w[0].y & 0xffffu) | (w[1].y << 16); c.y = (w[2].y & 0xffffu) | (w[3].y << 16); c.z = (w[4].y & 0xffffu) | (w[5].y << 16); c.w = (w[6].y & 0xffffu) | (w[7].y << 16);
        d.x = (w[0].y >> 16) | (w[1].y & 0xffff0000u); d.y = (w[2].y >> 16) | (w[3].y & 0xffff0000u); d.z = (w[4].y >> 16) | (w[5].y & 0xffff0000u); d.w = (w[6].y >> 16) | (w[7].y & 0xffff0000u);
        *(LAS u32x4*)(VT + (4 * lane) * 144 + sg * 16) = a; *(LAS u32x4*)(VT + (4 * lane + 1) * 144 + sg * 16) = b;
        *(LAS u32x4*)(VT + (4 * lane + 2) * 144 + sg * 16) = c; *(LAS u32x4*)(VT + (4 * lane + 3) * 144 + sg * 16) = d;
    }
    __syncthreads();
    const int fr = lane & 15, fq = lane >> 4;
    bf16x8 a0 = *(const LAS bf16x8*)(KT + (16 * sg + fr) * 144 + 16 * fq), a1 = *(const LAS bf16x8*)(KT + (16 * sg + fr) * 144 + 64 + 16 * fq);
    bf16_t* LOC = (bf16_t*)(p.ws + WS_LOCAL + (RET ? LOCAL_RET_OFF : 0)) + (size_t)item * DV * 128;
#pragma unroll
    for (int vt = 0; vt < DV / 16; ++vt) {
        const bf16x8 b0 = *(const LAS bf16x8*)(VT + (16 * vt + fr) * 144 + 16 * fq), b1 = *(const LAS bf16x8*)(VT + (16 * vt + fr) * 144 + 64 + 16 * fq);
        f32x4 acc = {0.f, 0.f, 0.f, 0.f};
        acc = mfma16(a0, b0, acc); acc = mfma16(a1, b1, acc);
        u32x2 w; w.x = pk2(acc[0], acc[1]); w.y = pk2(acc[2], acc[3]);
        *(u32x2*)(LOC + (size_t)(16 * vt + fr) * 128 + 16 * sg + 4 * fq) = w;
    }
    __syncthreads();
}
__device__ __forceinline__ void p3_local(const Params& p, LAS unsigned char* lds) {
    constexpr int NH = 2 * 8 * NCH, NR = 2 * 4 * NCH;
    for (int it = blockIdx.x; it < NH + NR; it += gridDim.x) {
        if (it < NH) { const int cc = it % NCH, dh = it / NCH; s1_item<false>(p, lds, dh >> 3, dh & 7, cc); }
        else { const int r = it - NH; const int cc = r % NCH, dh = r / NCH; s1_item<true>(p, lds, dh >> 2, dh & 3, cc); }
    }
}
__device__ __forceinline__ void p4_scan(const Params& p) {
    const int NTOT = 131072;
    for (int e = blockIdx.x * NTHREADS + threadIdx.x; e < NTOT; e += gridDim.x * NTHREADS) {
        const bool ret = e >= 65536; const int e2 = ret ? e - 65536 : e;
        const int dh = ret ? e2 >> 13 : e2 >> 12; const int rem = ret ? e2 & 8191 : e2 & 4095;
        const int v = rem >> 5, k = (rem & 31) * 4; const int DV = ret ? 256 : 128;
        const int dir = ret ? dh >> 2 : dh >> 3;
        const bf16_t* loc = (const bf16_t*)(p.ws + WS_LOCAL + (ret ? LOCAL_RET_OFF : 0)) + (size_t)dh * NCH * DV * 128 + (size_t)v * 128 + k;
        const float* dec = (const float*)(p.ws + WS_DEC) + (size_t)((ret ? DEC_RET_ITEM0 : 0) + dh * NCH) * 128 + k;
        bf16_t* sst = (bf16_t*)(p.ws + WS_SST + (ret ? SST_RET_OFF : 0)) + (size_t)dh * NXCH * DV * 128 + (size_t)v * 128 + k;
        const size_t cstride = (size_t)DV * 128;
        f32x4 S = {0.f, 0.f, 0.f, 0.f};
        for (int i0 = 0; i0 < NCH; i0 += 4) {
            u32x2 lw[4]; f32x4 dc[4]; int ccs[4];
#pragma unroll
            for (int j = 0; j < 4; ++j) { const int i = i0 + j; const int cc = dir ? (i < NCCH ? NCCH - 1 - i : NCH + NCCH - 1 - i) : i; ccs[j] = cc;
                lw[j] = *(const u32x2*)(loc + (size_t)cc * cstride); dc[j] = *(const f32x4*)(dec + (size_t)cc * 128); }
#pragma unroll
            for (int j = 0; j < 4; ++j) {
                if (ccs[j] >= NCCH) { u32x2 w; w.x = pk2(S[0], S[1]); w.y = pk2(S[2], S[3]); *(u32x2*)(sst + (size_t)(ccs[j] - NCCH) * cstride) = w; }
                const f32x4 l = {bflo(lw[j].x), bfhi(lw[j].x), bflo(lw[j].y), bfhi(lw[j].y)};
                S = (S + l) * dc[j];
            }
        }
    }
}
template <bool RET>
__device__ __forceinline__ void s3_item(const Params& p, LAS unsigned char* lds, int h, int xc) {
    constexpr int DV = RET ? 256 : 128;
    const int tid = threadIdx.x, sg = __builtin_amdgcn_readfirstlane(tid >> 6), lane = tid & 63, kp = lane;
    LAS unsigned char* QF = lds; LAS unsigned char* QB = lds + 17408; LAS unsigned char* KF = lds + 2 * 17408; LAS unsigned char* KB = lds + 3 * 17408;
    LAS unsigned char* VT = lds + 69632;
    LAS unsigned char* PP = lds + 106496;
    LAS float* TOT = (LAS float*)(lds + 115712);
    LAS float* RS = (LAS float*)(lds + 123904);
    const size_t row0 = (size_t)CTXL + (size_t)xc * 64;
    if (!RET) {
        const float* GFp = (const float*)(p.ws + WS_GF) + (row0 + 8 * sg) * 1024 + h * 128 + 2 * kp;
        const float* GBp = (const float*)(p.ws + WS_GB) + (row0 + 8 * sg) * 1024 + h * 128 + 2 * kp;
        const bf16_t* Qp = (const bf16_t*)(p.ws + WS_Q) + (row0 + 8 * sg) * 1024 + h * 128 + 2 * kp;
        f32x2 gf[8], gb[8], cf[8], cb[8]; unsigned qw[8];
#pragma unroll
        for (int i = 0; i < 8; ++i) { gf[i] = *(const f32x2*)(GFp + (size_t)i * 1024); gb[i] = *(const f32x2*)(GBp + (size_t)i * 1024); qw[i] = *(const unsigned*)(Qp + (size_t)i * 1024); }
        cf[0] = gf[0]; cb[0] = gb[0];
#pragma unroll
        for (int i = 1; i < 8; ++i) { cf[i] = cf[i - 1] + gf[i]; cb[i] = cb[i - 1] + gb[i]; }
        *(LAS f32x2*)(TOT + sg * 128 + 2 * kp) = cf[7]; *(LAS f32x2*)(TOT + 1024 + sg * 128 + 2 * kp) = cb[7];
        __syncthreads();
        f32x2 pf = {0.f, 0.f}, pb = {0.f, 0.f}, Tb = {0.f, 0.f};
#pragma unroll
        for (int s8 = 0; s8 < 8; ++s8) { const f32x2 t = *(const LAS f32x2*)(TOT + s8 * 128 + 2 * kp), t2 = *(const LAS f32x2*)(TOT + 1024 + s8 * 128 + 2 * kp);
            if (s8 < sg) { pf += t; pb += t2; } Tb += t2; }
#pragma unroll
        for (int i = 0; i < 8; ++i) {
            const f32x2 bf = pf + cf[i]; const f32x2 bb = Tb - (pb + cb[i]) + gb[i];
            const float qx = bflo(qw[i]), qy = bfhi(qw[i]); const int s = 8 * sg + i;
            *(LAS unsigned*)(QF + s * 272 + kp * 4) = pk2(qx * __expf(bf.x), qy * __expf(bf.y));
            *(LAS unsigned*)(KF + s * 272 + kp * 4) = pk2((1.f - __expf(gf[i].x)) * __expf(-bf.x), (1.f - __expf(gf[i].y)) * __expf(-bf.y));
            *(LAS unsigned*)(QB + s * 272 + kp * 4) = pk2(qx * __expf(bb.x), qy * __expf(bb.y));
            *(LAS unsigned*)(KB + s * 272 + kp * 4) = pk2((1.f - __expf(gb[i].x)) * __expf(-bb.x), (1.f - __expf(gb[i].y)) * __expf(-bb.y));
        }
    } else {
        const bf16_t* Qp = (const bf16_t*)(p.ws + WS_RQ) + (row0 + 8 * sg) * 512 + h * 128 + 2 * kp;
        const bf16_t* Kp = (const bf16_t*)(p.ws + WS_RK) + (row0 + 8 * sg) * 512 + h * 128 + 2 * kp;
        const float lgf = log_sigmoid_f(p.ret_dl[h]), lgb = log_sigmoid_f(p.ret_dl[4 + h]);
#pragma unroll
        for (int i = 0; i < 8; ++i) {
            const unsigned qw = *(const unsigned*)(Qp + (size_t)i * 512), kw = *(const unsigned*)(Kp + (size_t)i * 512); const int s = 8 * sg + i;
            const float bf = (float)(s + 1) * lgf, bb = (float)(64 - s) * lgb;
            const float ef = __expf(bf), eb = __expf(bb), nf = __expf(-bf), nb = __expf(-bb);
            *(LAS unsigned*)(QF + s * 272 + kp * 4) = pk2(bflo(qw) * ef, bfhi(qw) * ef);
            *(LAS unsigned*)(KF + s * 272 + kp * 4) = pk2(bflo(kw) * nf, bfhi(kw) * nf);
            *(LAS unsigned*)(QB + s * 272 + kp * 4) = pk2(bflo(qw) * eb, bfhi(qw) * eb);
            *(LAS unsigned*)(KB + s * 272 + kp * 4) = pk2(bflo(kw) * nb, bfhi(kw) * nb);
        }
    }
    if (!RET) {
        const bf16_t* V = (const bf16_t*)(p.ws + WS_V) + (row0 + 8 * sg) * 1024 + h * 128 + 2 * lane;
        unsigned w[8];
#pragma unroll
        for (int i = 0; i < 8; ++i) w[i] = *(const unsigned*)(V + (size_t)i * 1024);
        u32x4 a, b;
        a.x = (w[0] & 0xffffu) | (w[1] << 16); a.y = (w[2] & 0xffffu) | (w[3] << 16); a.z = (w[4] & 0xffffu) | (w[5] << 16); a.w = (w[6] & 0xffffu) | (w[7] << 16);
        b.x = (w[0] >> 16) | (w[1] & 0xffff0000u); b.y = (w[2] >> 16) | (w[3] & 0xffff0000u); b.z = (w[4] >> 16) | (w[5] & 0xffff0000u); b.w = (w[6] >> 16) | (w[7] & 0xffff0000u);
        *(LAS u32x4*)(VT + (2 * lane) * 144 + sg * 16) = a; *(LAS u32x4*)(VT + (2 * lane + 1) * 144 + sg * 16) = b;
    } else {
        const bf16_t* V = (const bf16_t*)(p.ws + WS_RV) + (row0 + 8 * sg) * 1024 + h * 256 + 4 * lane;
        u32x2 w[8];
#pragma unroll
        for (int i = 0; i < 8; ++i) w[i] = *(const u32x2*)(V + (size_t)i * 1024);
        u32x4 a, b, c, d;
        a.x = (w[0].x & 0xffffu) | (w[1].x << 16); a.y = (w[2].x & 0xffffu) | (w[3].x << 16); a.z = (w[4].x & 0xffffu) | (w[5].x << 16); a.w = (w[6].x & 0xffffu) | (w[7].x << 16);
        b.x = (w[0].x >> 16) | (w[1].x & 0xffff0000u); b.y = (w[2].x >> 16) | (w[3].x & 0xffff0000u); b.z = (w[4].x >> 16) | (w[5].x & 0xffff0000u); b.w = (w[6].x >> 16) | (w[7].x & 0xffff0000u);
        c.x = (w[0].y & 0xffffu) | (w[1].y << 16); c.y = (w[2].y & 0xffffu) | (w[3].y << 16); c.z = (w[4].y & 0xffffu) | (w[5].y << 16); c.w = (w[6].y & 0xffffu) | (w[7].y << 16);
        d.x = (w[0].y >> 16) | (w[1].y & 0xffff0000u); d.y = (w[2].y >> 16) | (w[3].y & 0xffff0000u); d.z = (w[4].y >> 16) | (w[5].y & 0xffff0000u); d.w = (w[6].y >> 16) | (w[7].y & 0xffff0000u);
        *(LAS u32x4*)(VT + (4 * lane) * 144 + sg * 16) = a; *(LAS u32x4*)(VT + (4 * lane + 1) * 144 + sg * 16) = b;
        *(LAS u32x4*)(VT + (4 * lane + 2) * 144 + sg * 16) = c; *(LAS u32x4*)(VT + (4 * lane + 3) * 144 + sg * 16) = d;
    }
    __syncthreads();
    const int fr = lane & 15, fq = lane >> 4, tt = sg >> 1;
#pragma unroll
    for (int sti = 0; sti < 2; ++sti) {
        const int st = (sg & 1) * 2 + sti;
        f32x4 af = {0.f, 0.f, 0.f, 0.f}, ab = {0.f, 0.f, 0.f, 0.f};
        if (st <= tt) {
#pragma unroll
            for (int ks = 0; ks < 4; ++ks) { const bf16x8 a = *(const LAS bf16x8*)(KF + (16 * st + fr) * 272 + ks * 64 + 16 * fq), b = *(const LAS bf16x8*)(QF + (16 * tt + fr) * 272 + ks * 64 + 16 * fq); af = mfma16(a, b, af); }
        }
        if (st >= tt) {
#pragma unroll
            for (int ks = 0; ks < 4; ++ks) { const bf16x8 a = *(const LAS bf16x8*)(KB + (16 * st + fr) * 272 + ks * 64 + 16 * fq), b = *(const LAS bf16x8*)(QB + (16 * tt + fr) * 272 + ks * 64 + 16 * fq); ab = mfma16(a, b, ab); }
        }
        f32x4 r;
#pragma unroll
        for (int j = 0; j < 4; ++j) { const int sl = 16 * st + 4 * fq + j, tl = 16 * tt + fr; r[j] = (sl <= tl ? af[j] : 0.f) + (sl >= tl ? ab[j] : 0.f); }
        u32x2 w; w.x = pk2(r[0], r[1]); w.y = pk2(r[2], r[3]);
        *(LAS u32x2*)(PP + (16 * tt + fr) * 144 + (16 * st + 4 * fq) * 2) = w;
    }
    __syncthreads();
    constexpr int NVT = DV / 32;
    const int vt0 = (sg & 1) * NVT;
    bf16x8 pb[2], qfb[4], qbb[4];
#pragma unroll
    for (int ks = 0; ks < 2; ++ks) pb[ks] = *(const LAS bf16x8*)(PP + (16 * tt + fr) * 144 + ks * 64 + 16 * fq);
#pragma unroll
    for (int ks = 0; ks < 4; ++ks) { qfb[ks] = *(const LAS bf16x8*)(QF + (16 * tt + fr) * 272 + ks * 64 + 16 * fq); qbb[ks] = *(const LAS bf16x8*)(QB + (16 * tt + fr) * 272 + ks * 64 + 16 * fq); }
    const bf16_t* SF = (const bf16_t*)(p.ws + WS_SST + (RET ? SST_RET_OFF : 0)) + ((size_t)(0 * (RET ? 4 : 8) + h) * NXCH + xc) * DV * 128;
    const bf16_t* SB = (const bf16_t*)(p.ws + WS_SST + (RET ? SST_RET_OFF : 0)) + ((size_t)(1 * (RET ? 4 : 8) + h) * NXCH + xc) * DV * 128;
    f32x4 o[NVT]; float ss = 0.f;
#pragma unroll
    for (int vi = 0; vi < NVT; ++vi) {
        const int vt = vt0 + vi; f32x4 acc = {0.f, 0.f, 0.f, 0.f};
#pragma unroll
        for (int ks = 0; ks < 2; ++ks) { const bf16x8 a = *(const LAS bf16x8*)(VT + (16 * vt + fr) * 144 + ks * 64 + 16 * fq); acc = mfma16(a, pb[ks], acc); }
#pragma unroll
        for (int ks = 0; ks < 4; ++ks) { const bf16x8 a = *(const bf16x8*)(SF + (size_t)(16 * vt + fr) * 128 + ks * 32 + 8 * fq); acc = mfma16(a, qfb[ks], acc); }
#pragma unroll
        for (int ks = 0; ks < 4; ++ks) { const bf16x8 a = *(const bf16x8*)(SB + (size_t)(16 * vt + fr) * 128 + ks * 32 + 8 * fq); acc = mfma16(a, qbb[ks], acc); }
        o[vi] = acc; ss += (acc[0] * acc[0] + acc[1] * acc[1]) + (acc[2] * acc[2] + acc[3] * acc[3]);
    }
    ss += __shfl_xor(ss, 16); ss += __shfl_xor(ss, 32);
    if (fq == 0) RS[(sg & 1) * 64 + 16 * tt + fr] = ss;
    __syncthreads();
    const float rstd = rsqrtf((RS[16 * tt + fr] + RS[64 + 16 * tt + fr]) * (1.f / DV) + EPS);
    const float* NW = (RET ? p.ret_nw : p.hg_nw) + h * DV;
    const bf16_t* GT = (const bf16_t*)(p.ws + (RET ? WS_RGATE : WS_HGATE)) + (row0 + 16 * tt + fr) * 1024 + h * DV;
    bf16_t* PO = (bf16_t*)(p.ws + WS_PREOUT) + ((size_t)xc * 64 + 16 * tt + fr) * DM + (RET ? 1024 : 0) + h * DV;
#pragma unroll
    for (int vi = 0; vi < NVT; ++vi) {
        const int v = 16 * (vt0 + vi) + 4 * fq;
        const f32x4 nw = *(const f32x4*)(NW + v); const u32x2 gw = *(const u32x2*)(GT + v);
        const f32x4 r = {o[vi][0] * rstd * nw[0] * bflo(gw.x), o[vi][1] * rstd * nw[1] * bfhi(gw.x), o[vi][2] * rstd * nw[2] * bflo(gw.y), o[vi][3] * rstd * nw[3] * bfhi(gw.y)};
        u32x2 w; w.x = pk2(r[0], r[1]); w.y = pk2(r[2], r[3]);
        *(u32x2*)(PO + v) = w;
    }
    __syncthreads();
}
__device__ __forceinline__ void p5_out(const Params& p, LAS unsigned char* lds) {
    constexpr int NR = 4 * NXCH, NH = 8 * NXCH;
    for (int it = blockIdx.x; it < NR + NH; it += gridDim.x) {
        if (it < NR) s3_item<true>(p, lds, it / NXCH, it % NXCH);
        else { const int r = it - NR; s3_item<false>(p, lds, r / NXCH, r % NXCH); }
    }
}

__device__ __forceinline__ void p7_norm_route(const Params& p, LAS unsigned char* lds) {
    const int tid = threadIdx.x, wave = tid >> 6, lane = tid & 63;
    LAS float* G1 = (LAS float*)lds; LAS float* SH2 = G1 + 2048; LAS float* SC2 = SH2 + 2048; LAS int* CNTL = (LAS int*)(SC2 + 2048);
    mod_reduce_to_lds(p, G1, 4096, 2048, false); mod_reduce_to_lds(p, SH2, 6144, 2048, false); mod_reduce_to_lds(p, SC2, 8192, 2048, false);
    const float* OX = (const float*)(p.ws + WS_OUTX); bf16_t* HX2 = (bf16_t*)(p.ws + WS_HX2);
    const float* WR = (const float*)(p.ws + WS_CTL + CTL_WR);
    int* CNT = (int*)(p.ws + WS_CTL + CTL_CNT); f32x4* ROUTE = (f32x4*)(p.ws + WS_CTL + CTL_ROUTE);
    for (int grp = blockIdx.x; grp < NGRP; grp += gridDim.x) {
        if (tid < 32) CNTL[tid] = 0;
        __syncthreads();
        f32x4 hv[4][8];
#pragma unroll
        for (int r = 0; r < 4; ++r) {
            const int t = grp * 32 + wave * 4 + r;
            f32x4 ov[8]; float ss = 0.f;
#pragma unroll
            for (int j = 0; j < 8; ++j) { ov[j] = *(const f32x4*)(OX + (size_t)t * DM + 4 * (lane + 64 * j)); ss += (ov[j][0] * ov[j][0] + ov[j][1] * ov[j][1]) + (ov[j][2] * ov[j][2] + ov[j][3] * ov[j][3]); }
            const float rstd = rsqrtf(wave_sum(ss) * (1.f / DM) + EPS); float ss2 = 0.f;
#pragma unroll
            for (int j = 0; j < 8; ++j) { const int col = 4 * (lane + 64 * j);
                const f32x4 xv = *(const f32x4*)(p.x + (size_t)t * DM + col), nw = *(const f32x4*)(p.norm_w + DM + col), g1 = *(const LAS f32x4*)(G1 + col);
                const f32x4 x1 = xv + g1 * (ov[j] * rstd * nw);
                *(f32x4*)(p.out + (size_t)t * DM + col) = x1; hv[r][j] = x1;
                ss2 += (x1[0] * x1[0] + x1[1] * x1[1]) + (x1[2] * x1[2] + x1[3] * x1[3]); }
            const float rstd2 = rsqrtf(wave_sum(ss2) * (1.f / DM) + EPS);
#pragma unroll
            for (int j = 0; j < 8; ++j) { const int col = 4 * (lane + 64 * j);
                const f32x4 nw = *(const f32x4*)(p.norm_w + 2 * DM + col), a = *(const LAS f32x4*)(SC2 + col), b = *(const LAS f32x4*)(SH2 + col);
                const f32x4 hx = (hv[r][j] * rstd2 * nw) * (a + 1.f) + b; hv[r][j] = hx;
                u32x2 w; w.x = pk2(hx[0], hx[1]); w.y = pk2(hx[2], hx[3]); *(u32x2*)(HX2 + (size_t)t * DM + col) = w; }
            asm volatile("" ::: "memory");
        }
        {
            LAS float* LG = (LAS float*)(lds + 32768) + wave * 160;
#pragma unroll 1
            for (int o = 0; o < 36; ++o) {
                float a0 = 0.f, a1 = 0.f, a2 = 0.f, a3 = 0.f;
#pragma unroll
                for (int j = 0; j < 8; ++j) { const f32x4 w = *(const f32x4*)(WR + o * 2048 + 4 * (lane + 64 * j));
                    a0 += (hv[0][j][0] * w[0] + hv[0][j][1] * w[1]) + (hv[0][j][2] * w[2] + hv[0][j][3] * w[3]);
                    a1 += (hv[1][j][0] * w[0] + hv[1][j][1] * w[1]) + (hv[1][j][2] * w[2] + hv[1][j][3] * w[3]);
                    a2 += (hv[2][j][0] * w[0] + hv[2][j][1] * w[1]) + (hv[2][j][2] * w[2] + hv[2][j][3] * w[3]);
                    a3 += (hv[3][j][0] * w[0] + hv[3][j][1] * w[1]) + (hv[3][j][2] * w[2] + hv[3][j][3] * w[3]); }
                a0 = wave_sum(a0); a1 = wave_sum(a1); a2 = wave_sum(a2); a3 = wave_sum(a3);
                if (lane == 0) { LG[o] = a0; LG[40 + o] = a1; LG[80 + o] = a2; LG[120 + o] = a3; }
            }
            LDS_WAIT(); asm volatile("" ::: "memory");
            const LAS float* Lr = LG + (lane & 3) * 40;
            const float L0 = Lr[0] + p.rgb[0], L1 = Lr[1] + p.rgb[1], L2 = Lr[2] + p.rgb[2], L3 = Lr[3] + p.rgb[3];
            int grpi = 0; float gmax = L0;
            if (L1 > gmax) { gmax = L1; grpi = 1; }
            if (L2 > gmax) { gmax = L2; grpi = 2; }
            if (L3 > gmax) { gmax = L3; grpi = 3; }
            const float psel = 1.f / ((__expf(L0 - gmax) + __expf(L1 - gmax)) + (__expf(L2 - gmax) + __expf(L3 - gmax)));
            float le[8];
#pragma unroll
            for (int j = 0; j < 8; ++j) le[j] = Lr[4 + grpi * 8 + j] + p.reb[grpi * 8 + j];
            int i1 = 0; float v1 = le[0];
#pragma unroll
            for (int j = 1; j < 8; ++j) if (le[j] > v1) { v1 = le[j]; i1 = j; }
            int i2 = -1; float v2 = -3.0e38f;
#pragma unroll
            for (int j = 0; j < 8; ++j) if (j != i1 && le[j] > v2) { v2 = le[j]; i2 = j; }
            const float e2 = __expf(v2 - v1); const float ga = psel / (1.f + e2), gb2 = psel * e2 / (1.f + e2);
            if (lane < 4) {
                const int t = grp * 32 + wave * 4 + lane; const int ea = grpi * 8 + i1, eb = grpi * 8 + i2;
                f32x4 rt; rt[0] = __builtin_bit_cast(float, ea); rt[1] = __builtin_bit_cast(float, eb); rt[2] = ga; rt[3] = gb2; ROUTE[t] = rt;
                atomicAdd((int*)&CNTL[ea], 1); atomicAdd((int*)&CNTL[eb], 1);
            }
        }
        __syncthreads();
        if (tid < 32) CNT[grp * 32 + tid] = CNTL[tid];
        __syncthreads();
    }
}
__device__ __forceinline__ void p8_slots(const Params& p, LAS unsigned char* lds) {
    const int tid = threadIdx.x, wave = tid >> 6, lane = tid & 63;
    LAS int* PT = (LAS int*)lds;
    LAS int* PP = PT + 512;
    LAS int* TOTE = PP + 512;
    LAS int* BASE = TOTE + 32;
    LAS int* SLOTL = BASE + 32;
    const int* CNT = (const int*)(p.ws + WS_CTL + CTL_CNT); const f32x4* ROUTE = (const f32x4*)(p.ws + WS_CTL + CTL_ROUTE);
    int* SLOT = (int*)(p.ws + WS_CTL + CTL_SLOT); int* TILES = (int*)(p.ws + WS_CTL + CTL_TILES);
    const bf16_t* HX2 = (const bf16_t*)(p.ws + WS_HX2); bf16_t* XS = (bf16_t*)(p.ws + WS_XS);
    for (int grp = blockIdx.x; grp < NGRP; grp += gridDim.x) {
        { const int e = tid & 31, part = tid >> 5; int t = 0, pr = 0;
          for (int g = part * 16; g < part * 16 + 16; ++g) { const int c = CNT[g * 32 + e]; t += c; if (g < grp) pr += c; }
          PT[part * 32 + e] = t; PP[part * 32 + e] = pr; }
        __syncthreads();
        if (tid < 32) { int t = 0, pr = 0; for (int q = 0; q < 16; ++q) { t += PT[q * 32 + tid]; pr += PP[q * 32 + tid]; } TOTE[tid] = t; BASE[tid] = pr; }
        __syncthreads();
        if (tid == 0) { int st = 0; for (int e = 0; e < 32; ++e) { const int t = TOTE[e]; BASE[e] += st;
                if (grp == 0) { const int nt = (t + 255) >> 8; for (int q = 0; q < nt; ++q) TILES[1 + (st >> 8) + q] = e; }
                st += ((t + 255) >> 8) << 8; }
            if (grp == 0) TILES[0] = st >> 8; }
        __syncthreads();
        if (wave == 0) {
            const int t = grp * 32 + (lane >> 1); const f32x4 rt = ROUTE[t]; const int e = __builtin_bit_cast(int, (lane & 1) ? rt[1] : rt[0]);
            int rank = 0; const unsigned long long ltmask = (1ull << lane) - 1ull;
            for (int q = 0; q < 32; ++q) { const unsigned long long m = __ballot(e == q); if (e == q) rank = __popcll(m & ltmask); }
            const int slot = BASE[e] + rank; SLOTL[lane] = slot; SLOT[grp * 64 + lane] = slot;
        }
        __syncthreads();
        for (int a = wave * 8; a < wave * 8 + 8; ++a) {
            const int t = grp * 32 + (a >> 1); const int slot = SLOTL[a];
            const u32x4* src = (const u32x4*)(HX2 + (size_t)t * DM); u32x4* dst = (u32x4*)(XS + (size_t)slot * DM);
#pragma unroll
            for (int j = 0; j < 4; ++j) dst[lane + 64 * j] = src[lane + 64 * j];
        }
        __syncthreads();
    }
}
__device__ __forceinline__ void p11_final(const Params& p, LAS unsigned char* lds) {
    const int tid = threadIdx.x, wave = tid >> 6, lane = tid & 63;
    LAS float* G2 = (LAS float*)lds;
    mod_reduce_to_lds(p, G2, 10240, 2048, false);
    __syncthreads();
    const float* YB = (const float*)(p.ws + WS_YB); const int* SLOT = (const int*)(p.ws + WS_CTL + CTL_SLOT); const f32x4* ROUTE = (const f32x4*)(p.ws + WS_CTL + CTL_ROUTE);
    const int gw = blockIdx.x * NWAVES + wave, NGW = gridDim.x * NWAVES;
    for (int t = gw; t < SEQ; t += NGW) {
        const int sa = SLOT[2 * t], sb = SLOT[2 * t + 1]; const f32x4 rt = ROUTE[t]; const float ga = rt[2], gb = rt[3];
        f32x4 y[8]; float ss = 0.f;
#pragma unroll
        for (int j = 0; j < 8; ++j) { const int col = 4 * (lane + 64 * j);
            const f32x4 ya = *(const f32x4*)(YB + (size_t)sa * DM + col), yb = *(const f32x4*)(YB + (size_t)sb * DM + col);
            y[j] = ya * ga + yb * gb; ss += (y[j][0] * y[j][0] + y[j][1] * y[j][1]) + (y[j][2] * y[j][2] + y[j][3] * y[j][3]); }
        const float rstd = rsqrtf(wave_sum(ss) * (1.f / DM) + EPS);
#pragma unroll
        for (int j = 0; j < 8; ++j) { const int col = 4 * (lane + 64 * j);
            const f32x4 nw = *(const f32x4*)(p.norm_w + 3 * DM + col), g2 = *(const LAS f32x4*)(G2 + col);
            f32x4* op = (f32x4*)(p.out + (size_t)t * DM + col); *op = *op + g2 * (y[j] * rstd * nw); }
    }
}

constexpr int NPHASE = 12;
__global__ void __launch_bounds__(NTHREADS, 2) fwd_kernel(Params p) {
    extern __shared__ __attribute__((aligned(16))) unsigned char lds_raw[];
    LAS unsigned char* lds = (LAS unsigned char*)lds_raw;
    cg::grid_group grid = cg::this_grid();
    const int lo = p.ph_lo, hi = p.ph_hi;
    const int G = gridDim.x, bx = blockIdx.x;
    const int vcu = (G % 8 == 0) ? (bx % 8) * (G / 8) + bx / 8 : bx;
#ifndef PHM
#define PHM 0xfff
#endif
#define IN(k) (((PHM >> (k)) & 1) && lo <= (k) && (k) < hi)
#define SEAM(k) do { if (IN(k) && IN((k) + 1)) grid.sync(); } while (0)
    if (IN(0)) { p0_prologue(p, lds); } SEAM(0);
    if (IN(1)) { p1_hrows(p, lds); } SEAM(1);
    if (IN(2)) {
        pg8::Gemm g{(const bf16_t*)(p.ws + WS_H), (const bf16_t*)(p.ws + WS_WTIN), MT, PW, DM}; pg8::StaticOrder S; S.init(MT, PW, G, bx);
        EpiProj E{p.ws};
        pg8::gemm_phase<EpiProj, pg8::StaticOrder, true, true>(lds, g, S, E);
    } SEAM(2);
    if (IN(3)) { p3_local(p, lds); } SEAM(3);
    if (IN(4)) { p4_scan(p); } SEAM(4);
    if (IN(5)) { p5_out(p, lds); } SEAM(5);
    if (IN(6)) {
        pg8::Gemm g{(const bf16_t*)(p.ws + WS_PREOUT), (const bf16_t*)(p.ws + WS_WTOUT), SEQ, DM, DM}; pg8::StaticOrder S; S.init(SEQ, DM, G, bx);
        EpiF32 E{(float*)(p.ws + WS_OUTX), DM};
        pg8::gemm_phase<EpiF32, pg8::StaticOrder, true, true>(lds, g, S, E);
    } SEAM(6);
    if (IN(7)) { p7_norm_route(p, lds); } SEAM(7);
    if (IN(8)) { p8_slots(p, lds); } SEAM(8);
    if (IN(9)) {
        pg8::Gemm g{(const bf16_t*)(p.ws + WS_XS), (const bf16_t*)(p.ws + WS_WTGU), 0, 0, DM}; MoeOrder S{(const int*)(p.ws + WS_CTL + CTL_TILES), G, vcu};
        EpiGateUp E{(bf16_t*)(p.ws + WS_GACT)};
        pg8::gemm_phase<EpiGateUp, MoeOrder, true, true>(lds, g, S, E);
    } SEAM(9);
    if (IN(10)) {
        pg8::Gemm g{(const bf16_t*)(p.ws + WS_GACT), (const bf16_t*)(p.ws + WS_WTD), 0, 0, DE}; MoeOrder S{(const int*)(p.ws + WS_CTL + CTL_TILES), G, vcu};
        EpiF32 E{(float*)(p.ws + WS_YB), DM};
        pg8::gemm_phase<EpiF32, MoeOrder, true, true>(lds, g, S, E);
    } SEAM(10);
    if (IN(11)) { p11_final(p, lds); }
#undef IN
#undef SEAM
}

#ifndef MK_ONE_LAUNCH
#define MK_ONE_LAUNCH 1
#endif
extern "C" void kernel_launch(void* const* d_in, const int* in_sizes, int n_in, void* d_out, int out_size, void* d_ws, size_t ws_size, hipStream_t stream) {
    static int grid = 0;
    if (grid == 0) {
        if (n_in != 20 || ws_size < WS_END) { fprintf(stderr, "kernel_launch: unexpected n_in %d or ws_size %zu (< %zu)\n", n_in, ws_size, (size_t)WS_END); grid = -1; return; }
        int dev = 0, cus = 0, per_cu = 0;
        if (hipGetDevice(&dev) != hipSuccess || hipDeviceGetAttribute(&cus, hipDeviceAttributeMultiprocessorCount, dev) != hipSuccess) { grid = -1; return; }
        if (hipFuncSetAttribute((const void*)fwd_kernel, hipFuncAttributeMaxDynamicSharedMemorySize, LDS_BYTES) != hipSuccess) { fprintf(stderr, "kernel_launch: hipFuncSetAttribute failed\n"); grid = -1; return; }
        if (hipOccupancyMaxActiveBlocksPerMultiprocessor(&per_cu, (const void*)fwd_kernel, NTHREADS, LDS_BYTES) != hipSuccess || per_cu < 1) { fprintf(stderr, "kernel_launch: occupancy query says %d blocks per CU\n", per_cu); (void)hipGetLastError(); grid = -1; return; }
        grid = cus;
    }
    if (grid < 0) return;
    Params p{};
    const float* const* in = (const float* const*)d_in;
    p.x = in[0]; p.c = in[1]; p.ctx = in[2]; p.c_ctx = in[3]; p.w_mod = in[4]; p.b_mod = in[5]; p.norm_w = in[6]; p.w_in = in[7]; p.hg_lb = in[8]; p.hg_nw = in[9];
    p.ret_dl = in[10]; p.ret_nw = in[11]; p.w_out = in[12]; p.rgw = in[13]; p.rgb = in[14]; p.rew = in[15]; p.reb = in[16]; p.w_gate = in[17]; p.w_up = in[18]; p.w_down = in[19];
    p.out = (float*)d_out; p.ws = (unsigned char*)d_ws;
#if MK_ONE_LAUNCH
    p.ph_lo = 0; p.ph_hi = NPHASE;
    void* args[] = {&p};
    hipError_t e = hipLaunchCooperativeKernel((const void*)fwd_kernel, dim3(grid), dim3(NTHREADS), args, LDS_BYTES, stream);
    if (e != hipSuccess) fprintf(stderr, "cooperative launch failed: %s (grid %d)\n", hipGetErrorString(e), grid);
#else
    for (int k = 0; k < NPHASE; ++k) { p.ph_lo = k; p.ph_hi = k + 1; hipLaunchKernelGGL(fwd_kernel, dim3(grid), dim3(NTHREADS), LDS_BYTES, stream, p); }
#endif
}
```

```cpp
#include <hip/hip_runtime.h>
#include <hip/hip_cooperative_groups.h>
#include <cstdio>
#include <cstdint>
namespace cg = cooperative_groups;

namespace pg8 {
#define PG8_LAS __attribute__((address_space(3)))
typedef unsigned short bf16_t;
typedef short bf16x8 __attribute__((ext_vector_type(8)));
typedef float f32x4 __attribute__((ext_vector_type(4)));
typedef unsigned u32x4 __attribute__((ext_vector_type(4)));
constexpr int BM = 256, BK = 64, HALF = 128, HTB = HALF * BK * 2  , STAGE_BYTES = 8 * HTB, NXCD = 8, WGM = 8;

__host__ __device__ __forceinline__ int lds_byte(int r, int c) { const int st = (r >> 4) * 2 + (c >> 5), rr = r & 15, cc = c & 31, ob = rr * 64 + cc * 2; return st * 1024 + (ob ^ (((ob >> 9) & 1) << 5)); }
__host__ __device__ __forceinline__ void stage_rc(int b, int& R, int& C) { const int st = b / 1024, sb = b % 1024, swz = sb ^ (((sb >> 9) & 1) << 5); R = (st >> 1) * 16 + swz / 64; C = (st & 1) * 32 + (swz % 64) / 2; }
__host__ __device__ __forceinline__ int perm32(int rho) { const int n = rho >> 4, i = rho & 15; return 8 * (i >> 2) + 4 * n + (i & 3); }

struct Unit { int pm, pn, pb; };
struct Gemm { const bf16_t* A; const bf16_t* Bt; int M, N, K; };

struct StaticOrder {
    int nM, nN, nwg, G, c;
    __host__ __device__ void init(int M, int N, int G_, int c_) { nM = M / BM; nN = N / BM; nwg = nM * nN; G = G_; c = c_; }
    __host__ __device__ bool next(int i, Unit& u) const {
        const long L = (long)i * G + c; if (L >= nwg) return false;
        int wgid = (int)L; { const int q = nwg / NXCD, r = nwg % NXCD, xcd = wgid % NXCD, off = wgid / NXCD; wgid = (xcd < r ? xcd * (q + 1) : r * (q + 1) + (xcd - r) * q) + off; }
        const int nig = WGM * nN, gid = wgid / nig, fm = gid * WGM, gsz = (nM - fm) < WGM ? (nM - fm) : WGM;
        u.pm = fm + ((wgid % nig) % gsz); u.pn = (wgid % nig) / gsz; u.pb = u.pn; return true;
    }
    __device__ __forceinline__ void a_ready(const Unit&) const {}
    __device__ __forceinline__ void done(const Unit&) const {}
};

__device__ __forceinline__ unsigned cvt_pk_bf16(float lo, float hi) { unsigned r; asm volatile("v_cvt_pk_bf16_f32 %0, %1, %2" : "=v"(r) : "v"(lo), "v"(hi)); return r; }
template <class Epi, class Sched, bool ALIGN_EPI = false, bool SP2 = false>
__device__ __forceinline__ void gemm_phase(PG8_LAS unsigned char* lds, const Gemm g, const Sched& S, const Epi& E) {
    const int tid = threadIdx.x, wid = __builtin_amdgcn_readfirstlane(tid >> 6), lane = tid & 63, wr = wid >> 2, wc = wid & 3, fr = lane & 15, fq = lane >> 4;
    const int K = g.K, nt = K / BK;
    unsigned voffA[2], voffB[2];
#pragma unroll
    for (int i = 0; i < 2; ++i) { int R, C; stage_rc(tid * 16 + i * 8192, R, C); const int Rb = Epi::PERM ? ((R & ~31) + perm32(R & 31)) : R;
        voffA[i] = (unsigned)(R * K + C) * 2u; voffB[i] = (unsigned)(Rb * K + C) * 2u; }
    const size_t kstep = (size_t)(BK * 2);
    const size_t hstep = (size_t)HALF * K * 2;
    const size_t tstep = 2 * hstep;
    const unsigned ldsw = (unsigned)wid * 1024u;
    const int aoff = lds_byte(wr * 64 + fr, fq * 8), boff = lds_byte(wc * 32 + fr, fq * 8);
#define PG8_SA(b, h) (((b) * 2 + (h)) * HTB)
#define PG8_SB(b, h) ((4 + (b) * 2 + (h)) * HTB)
#define PG8_STAGE(bufoff, gbase, voff) do { _Pragma("unroll") for (int _i = 0; _i < 2; ++_i) \
        __builtin_amdgcn_global_load_lds((const unsigned*)((const char*)(gbase) + (voff)[_i]), (PG8_LAS unsigned*)(lds + (bufoff) + ldsw + _i * 8192), 16, 0, 0); } while (0)
#define PG8_LDA(dst, b, h) do { _Pragma("unroll") for (int m = 0; m < 4; ++m) _Pragma("unroll") for (int k = 0; k < 2; ++k) dst[m][k] = *(const PG8_LAS bf16x8*)(lds + PG8_SA(b, h) + aoff + m * 2048 + k * 1024); } while (0)
#define PG8_LDB(dst, b, h) do { _Pragma("unroll") for (int n = 0; n < 2; ++n) _Pragma("unroll") for (int k = 0; k < 2; ++k) dst[n][k] = *(const PG8_LAS bf16x8*)(lds + PG8_SB(b, h) + boff + n * 2048 + k * 1024); } while (0)
#define PG8_MMA(ai, bj, At, Bt) do { __builtin_amdgcn_s_setprio(1); _Pragma("unroll") for (int m = 0; m < 4; ++m) _Pragma("unroll") for (int n = 0; n < 2; ++n) _Pragma("unroll") for (int k = 0; k < 2; ++k) \
        acc[ai][bj][m][n] = __builtin_amdgcn_mfma_f32_16x16x32_bf16(Bt[n][k], At[m][k], acc[ai][bj][m][n], 0, 0, 0); __builtin_amdgcn_s_setprio(0); } while (0)
#define PG8_WAIT_V(n) asm volatile("s_waitcnt vmcnt(" #n ")" ::: "memory")
#define PG8_WAIT_L(n) asm volatile("s_waitcnt lgkmcnt(" #n ")" ::: "memory")
#define PG8_BAR __builtin_amdgcn_s_barrier()
#define PG8_SCHED __builtin_amdgcn_sched_barrier(0)
    Unit cur, nxt; int ui = 0;
    if (!S.next(0, cur)) return;
    f32x4 acc[2][2][4][2];
#pragma unroll
    for (int a = 0; a < 2; ++a)
#pragma unroll
        for (int b = 0; b < 2; ++b)
#pragma unroll
            for (int m = 0; m < 4; ++m)
#pragma unroll
                for (int n = 0; n < 2; ++n) acc[a][b][m][n] = (f32x4){0.f, 0.f, 0.f, 0.f};
    bf16x8 At[4][2], B0[2][2], B1[2][2];
    const char* cA = (const char*)g.A + (size_t)cur.pm * tstep; const char* cB = (const char*)g.Bt + (size_t)cur.pb * tstep;
    S.a_ready(cur);
    if constexpr (SP2) {
        PG8_STAGE(PG8_SB(0, 0), cB, voffB); PG8_STAGE(PG8_SB(0, 1), cB + hstep, voffB); PG8_STAGE(PG8_SA(0, 0), cA, voffA); PG8_STAGE(PG8_SA(0, 1), cA + hstep, voffA);
        if (wr == 1) PG8_BAR;
        PG8_WAIT_V(2); PG8_BAR;
        PG8_STAGE(PG8_SB(1, 0), cB + kstep, voffB); PG8_STAGE(PG8_SA(1, 0), cA + kstep, voffA); PG8_STAGE(PG8_SB(1, 1), cB + hstep + kstep, voffB);
        PG8_WAIT_V(6); PG8_BAR;
    } else {
        PG8_STAGE(PG8_SB(0, 0), cB, voffB); PG8_STAGE(PG8_SA(0, 0), cA, voffA); PG8_STAGE(PG8_SB(0, 1), cB + hstep, voffB); PG8_STAGE(PG8_SA(0, 1), cA + hstep, voffA);
        if (wr == 1) PG8_BAR;
        PG8_WAIT_V(4); PG8_BAR;
        PG8_STAGE(PG8_SB(1, 0), cB + kstep, voffB); PG8_STAGE(PG8_SA(1, 0), cA + kstep, voffA); PG8_STAGE(PG8_SB(1, 1), cB + hstep + kstep, voffB);
        PG8_WAIT_V(6); PG8_BAR;
    }
    for (;;) {
        const bool has_next = S.next(ui + 1, nxt);
        const char* nA = has_next ? (const char*)g.A + (size_t)nxt.pm * tstep : cA; const char* nB = has_next ? (const char*)g.Bt + (size_t)nxt.pb * tstep : cB;
        for (int t = 0; t < nt; t += 2) {
            const bool last = (t == nt - 2);
            const char* a1 = cA + (size_t)(t + 1) * kstep;
            const char* a2 = last ? nA : cA + (size_t)(t + 2) * kstep; const char* b2 = last ? nB : cB + (size_t)(t + 2) * kstep;
            const char* a3 = a2 + kstep; const char* b3 = b2 + kstep;
            if (last && has_next) S.a_ready(nxt);
            if constexpr (SP2) {
            PG8_LDB(B0, 0, 0); PG8_LDB(B1, 0, 1); PG8_SCHED; PG8_LDA(At, 0, 0); PG8_STAGE(PG8_SA(1, 1), a1 + hstep, voffA);
            PG8_WAIT_V(8); PG8_WAIT_L(0); PG8_BAR; PG8_MMA(0, 0, At, B0); PG8_MMA(0, 1, At, B1); PG8_BAR; PG8_SCHED;
            PG8_LDA(At, 0, 1); PG8_STAGE(PG8_SB(0, 0), b2, voffB); PG8_STAGE(PG8_SB(0, 1), b2 + hstep, voffB); PG8_STAGE(PG8_SA(0, 0), a2, voffA);
            PG8_WAIT_V(8); PG8_WAIT_L(0); PG8_BAR; PG8_MMA(1, 0, At, B0); PG8_MMA(1, 1, At, B1); PG8_BAR; PG8_SCHED;
            PG8_LDB(B0, 1, 0); PG8_LDB(B1, 1, 1); PG8_SCHED; PG8_LDA(At, 1, 0); PG8_STAGE(PG8_SA(0, 1), a2 + hstep, voffA);
            PG8_WAIT_V(8); PG8_WAIT_L(0); PG8_BAR; PG8_MMA(0, 0, At, B0); PG8_MMA(0, 1, At, B1); PG8_BAR; PG8_SCHED;
            PG8_LDA(At, 1, 1); PG8_STAGE(PG8_SB(1, 0), b3, voffB); PG8_STAGE(PG8_SB(1, 1), b3 + hstep, voffB); PG8_STAGE(PG8_SA(1, 0), a3, voffA);
            PG8_WAIT_V(8); PG8_WAIT_L(0); PG8_BAR; PG8_MMA(1, 0, At, B0); PG8_MMA(1, 1, At, B1); PG8_BAR; PG8_SCHED;
            } else {
            PG8_LDB(B0, 0, 0); PG8_SCHED; PG8_LDA(At, 0, 0); PG8_STAGE(PG8_SA(1, 1), a1 + hstep, voffA);
            PG8_WAIT_L(8); PG8_BAR; PG8_WAIT_L(0); PG8_MMA(0, 0, At, B0); PG8_BAR; PG8_SCHED;
            PG8_LDB(B1, 0, 1); PG8_STAGE(PG8_SB(0, 0), b2, voffB);
            PG8_BAR; PG8_WAIT_L(0); PG8_MMA(0, 1, At, B1); PG8_BAR;
            PG8_LDA(At, 0, 1); PG8_STAGE(PG8_SA(0, 0), a2, voffA);
            PG8_BAR; PG8_WAIT_L(0); PG8_MMA(1, 0, At, B0); PG8_BAR; PG8_SCHED;
            PG8_STAGE(PG8_SB(0, 1), b2 + hstep, voffB);
            PG8_WAIT_V(6); PG8_BAR; PG8_MMA(1, 1, At, B1); PG8_BAR;
            PG8_LDB(B0, 1, 0); PG8_SCHED; PG8_LDA(At, 1, 0); PG8_STAGE(PG8_SA(0, 1), a2 + hstep, voffA);
            PG8_WAIT_L(8); PG8_BAR; PG8_WAIT_L(0); PG8_MMA(0, 0, At, B0); PG8_BAR; PG8_SCHED;
            PG8_LDB(B1, 1, 1); PG8_STAGE(PG8_SB(1, 0), b3, voffB);
            PG8_BAR; PG8_WAIT_L(0); PG8_MMA(0, 1, At, B1); PG8_BAR;
            PG8_LDA(At, 1, 1); PG8_STAGE(PG8_SA(1, 0), a3, voffA);
            PG8_BAR; PG8_WAIT_L(0); PG8_MMA(1, 0, At, B0); PG8_BAR; PG8_SCHED;
            PG8_STAGE(PG8_SB(1, 1), b3 + hstep, voffB);
            PG8_WAIT_V(6); PG8_BAR; PG8_MMA(1, 1, At, B1); PG8_BAR;
            }
        }
        if constexpr (ALIGN_EPI) { if (wr == 0) PG8_BAR; }
        if constexpr (!Epi::AFTER_DRAIN) { E(acc, cur, wr, wc, fr, fq); S.done(cur); }
        if (!has_next) break;
#pragma unroll
        for (int a = 0; a < 2; ++a)
#pragma unroll
            for (int b = 0; b < 2; ++b)
#pragma unroll
                for (int m = 0; m < 4; ++m)
#pragma unroll
                    for (int n = 0; n < 2; ++n) acc[a][b][m][n] = (f32x4){0.f, 0.f, 0.f, 0.f};
        cur = nxt; cA = nA; cB = nB; ++ui;
        if constexpr (ALIGN_EPI) { if (wr == 1) PG8_BAR; }
    }
    PG8_WAIT_V(0);
    if constexpr (!ALIGN_EPI) { if (wr == 0) PG8_BAR; }
    PG8_BAR;
    if constexpr (Epi::AFTER_DRAIN) { E.fused(acc, cur, wr, wc, fr, fq, lds, wid, lane); S.done(cur); }
#undef PG8_SA
#undef PG8_SB
#undef PG8_STAGE
#undef PG8_LDA
#undef PG8_LDB
#undef PG8_MMA
#undef PG8_WAIT_V
#undef PG8_WAIT_L
#undef PG8_BAR
#undef PG8_SCHED
}
}
#define LAS __attribute__((address_space(3)))
typedef unsigned short bf16_t;
typedef short bf16x8 __attribute__((ext_vector_type(8)));
typedef float f32x4 __attribute__((ext_vector_type(4)));
typedef float f32x2 __attribute__((ext_vector_type(2)));
typedef unsigned u32x4 __attribute__((ext_vector_type(4)));
typedef unsigned u32x2 __attribute__((ext_vector_type(2)));

constexpr int DM = 2048, SEQ = 8192, CTXL = 256, MT = SEQ + CTXL, PW = 8192;
constexpr int NCH = MT / 64  , NXCH = SEQ / 64  , NCCH = CTXL / 64  ;
constexpr int NE = 32, DE = 1024, NGRP = 256  ;
constexpr float EPS = 1e-6f;
constexpr int NWAVES = 8, NTHREADS = 512;
constexpr int LDS_BYTES = 147456;

constexpr size_t MiB = 1u << 20;
constexpr size_t WS_WTGU = 0, WS_WTD = 256 * MiB, WS_CTL = 384 * MiB, WS_WTIN = 388 * MiB, WS_WTOUT = 420 * MiB;
constexpr size_t WS_H = 428 * MiB, WS_Q = 461 * MiB, WS_GF = 478 * MiB, WS_GB = 511 * MiB, WS_V = 544 * MiB, WS_HGATE = 561 * MiB;
constexpr size_t WS_RQ = 578 * MiB, WS_RK = 587 * MiB, WS_RV = 596 * MiB, WS_RGATE = 613 * MiB;
constexpr size_t WS_LOCAL = 630 * MiB, WS_DEC = 762 * MiB, WS_SST = 764 * MiB, WS_PREOUT = 892 * MiB, WS_END = 924 * MiB;
constexpr size_t WS_OUTX = 428 * MiB, WS_HX2 = 492 * MiB, WS_XS = 524 * MiB, WS_GACT = 620 * MiB, WS_YB = 668 * MiB;
constexpr size_t CTL_MODP = 0, CTL_LB = 256 * 1024, CTL_CNT = 272 * 1024, CTL_ROUTE = 304 * 1024, CTL_SLOT = 432 * 1024, CTL_TILES = 496 * 1024, CTL_WR = 512 * 1024, CTL_BAR = 1024 * 1024;
constexpr int MISC_OFF = LDS_BYTES - 256;
constexpr size_t LOCAL_RET_OFF = (size_t)2 * 8 * NCH * 128 * 128 * 2;
constexpr size_t SST_RET_OFF = (size_t)2 * 8 * NXCH * 128 * 128 * 2;
constexpr int DEC_RET_ITEM0 = 2 * 8 * NCH;

struct Params {
    const float *x, *c, *ctx, *c_ctx, *w_mod, *b_mod, *norm_w, *w_in, *hg_lb, *hg_nw, *ret_dl, *ret_nw, *w_out, *rgw, *rgb, *rew, *reb, *w_gate, *w_up, *w_down;
    float* out; unsigned char* ws;
    int ph_lo, ph_hi;
};

#define LDS_WAIT() asm volatile("s_waitcnt lgkmcnt(0)" ::: "memory")
__device__ __forceinline__ unsigned f2bf(float f) { unsigned u = __builtin_bit_cast(unsigned, f); return (u + 0x7fffu + ((u >> 16) & 1u)) >> 16; }
__device__ __forceinline__ unsigned pk2(float lo, float hi) { return f2bf(lo) | (f2bf(hi) << 16); }
__device__ __forceinline__ float bflo(unsigned w) { return __builtin_bit_cast(float, w << 16); }
__device__ __forceinline__ float bfhi(unsigned w) { return __builtin_bit_cast(float, w & 0xffff0000u); }
__device__ __forceinline__ float silu_f(float z) { return z / (1.f + __expf(-z)); }
__device__ __forceinline__ float sigmoid_f(float z) { return 1.f / (1.f + __expf(-z)); }
__device__ __forceinline__ float wave_sum(float v) {
#pragma unroll
    for (int o = 1; o < 64; o <<= 1) v += __shfl_xor(v, o);
    return v;
}
__device__ __forceinline__ f32x4 mfma16(bf16x8 a, bf16x8 b, f32x4 c) { return __builtin_amdgcn_mfma_f32_16x16x32_bf16(a, b, c, 0, 0, 0); }
__device__ __forceinline__ float log_sigmoid_f(float z) { return fminf(z, 0.f) - log1pf(__expf(-fabsf(z))); }

__device__ __forceinline__ void p0_gemv(const Params& p, LAS unsigned char* lds) {
    const int tid = threadIdx.x, wave = tid >> 6, lane = tid & 63;
    float* modp = (float*)(p.ws + WS_CTL + CTL_MODP);
    LAS float* red = (LAS float*)lds;
    for (int it = blockIdx.x; it < 192; it += gridDim.x) {
        const int cb = it % 48, kq = it / 48;
        const int col = cb * 256 + lane * 4;
        const int r0 = kq * 512 + wave * 64;
        const bool hasc = cb < 16;
        f32x4 ax = {0.f, 0.f, 0.f, 0.f}, ac = {0.f, 0.f, 0.f, 0.f};
        for (int r = 0; r < 64; r += 16) {
            f32x4 w[16];
#pragma unroll
            for (int i = 0; i < 16; ++i) w[i] = *(const f32x4*)(p.w_mod + (size_t)(r0 + r + i) * 12288 + col);
#pragma unroll
            for (int i = 0; i < 16; ++i) {
                const float sx = silu_f(p.c[r0 + r + i]); ax += w[i] * sx;
                if (hasc) { const float sc = silu_f(p.c_ctx[r0 + r + i]); ac += w[i] * sc; }
            }
        }
        *(LAS f32x4*)(red + (wave * 2 + 0) * 256 + lane * 4) = ax;
        *(LAS f32x4*)(red + (wave * 2 + 1) * 256 + lane * 4) = ac;
        __syncthreads();
        const int vsel = tid >> 8, cc = tid & 255;
        float s = 0.f;
#pragma unroll
        for (int w8 = 0; w8 < 8; ++w8) s += red[(w8 * 2 + vsel) * 256 + cc];
        if (vsel == 0) modp[kq * 16384 + cb * 256 + cc] = s; else if (hasc) modp[kq * 16384 + 12288 + cb * 256 + cc] = s;
        __syncthreads();
    }
}
__device__ __forceinline__ void transpose_item(const float* W, int ldw, int K, int k0, int n0src, bf16_t* WT, size_t drow0, LAS float* scr, int lane) {
    f32x4 v[16];
    const int rr = lane >> 4, c4 = (lane & 15) * 4;
#pragma unroll
    for (int i = 0; i < 16; ++i) v[i] = *(const f32x4*)(W + (size_t)(k0 + rr + 4 * i) * ldw + n0src + c4);
#pragma unroll
    for (int i = 0; i < 16; ++i) { LAS float* d = scr + (rr + 4 * i) * 65 + c4; d[0] = v[i][0]; d[1] = v[i][1]; d[2] = v[i][2]; d[3] = v[i][3]; }
    LDS_WAIT(); asm volatile("" ::: "memory");
    const int c = lane & 7;
#pragma unroll
    for (int j = 0; j < 8; ++j) {
        const int n = (lane >> 3) + 8 * j; const LAS float* s = scr + (8 * c) * 65 + n;
        u32x4 o; o.x = pk2(s[0 * 65], s[1 * 65]); o.y = pk2(s[2 * 65], s[3 * 65]); o.z = pk2(s[4 * 65], s[5 * 65]); o.w = pk2(s[6 * 65], s[7 * 65]);
        *(u32x4*)(WT + (drow0 + n) * (size_t)K + k0 + 8 * c) = o;
    }
    LDS_WAIT(); asm volatile("" ::: "memory");
}
__device__ __forceinline__ void p0_prologue(const Params& p, LAS unsigned char* lds) {
    const int tid = threadIdx.x, wave = __builtin_amdgcn_readfirstlane(tid >> 6), lane = tid & 63;
    p0_gemv(p, lds);
    {
        float* LB = (float*)(p.ws + WS_CTL + CTL_LB); float* WR = (float*)(p.ws + WS_CTL + CTL_WR);
        const int gt = blockIdx.x * NTHREADS + tid, NT = gridDim.x * NTHREADS;
        for (int i = gt; i < 2048; i += NT) { const float l0 = p.hg_lb[i], l1 = p.hg_lb[2048 + i]; LB[i] = 1.f / (1.f + __expf(l1 - l0)); }
        for (int i = gt; i < 36 * 2048; i += NT) { const int o = i >> 11, k = i & 2047; WR[i] = (o < 4) ? p.rgw[k * 4 + o] : p.rew[k * 32 + (o - 4)]; }
    }
    LAS float* scr = (LAS float*)(lds + wave * 16640);
    const int gw = blockIdx.x * NWAVES + wave, NGW = gridDim.x * NWAVES;
    bf16_t* WTIN = (bf16_t*)(p.ws + WS_WTIN); bf16_t* WTOUT = (bf16_t*)(p.ws + WS_WTOUT); bf16_t* WTGU = (bf16_t*)(p.ws + WS_WTGU); bf16_t* WTD = (bf16_t*)(p.ws + WS_WTD);
    constexpr int I_IN = 32 * 128, I_OUT = 32 * 32, I_G = 32 * 32 * 16, I_D = 32 * 16 * 32;
    constexpr int NITEMS = I_IN + I_OUT + 2 * I_G + I_D;
    for (int it = gw; it < NITEMS; it += NGW) {
        int r = it;
        if (r < I_IN) {
            const int kb = r / 128, nb = r % 128; const int drow = nb * 64, pn = drow >> 8;
            int src = drow;
            if (pn >= 20 && pn < 24) { const int q4 = (drow & 255) >> 6, bj = q4 >> 1, hl = q4 & 1; const int pn0 = pn >= 22 ? 22 : 20; src = (pn >= 22 ? 5632 : 5120) + ((pn - pn0) * 2 + hl) * 128 + bj * 64; }
            transpose_item(p.w_in, PW, DM, kb * 64, src, WTIN, (size_t)drow, scr, lane); continue; }
        r -= I_IN;
        if (r < I_OUT) { const int kb = r / 32, nb = r % 32; transpose_item(p.w_out, DM, DM, kb * 64, nb * 64, WTOUT, (size_t)nb * 64, scr, lane); continue; }
        r -= I_OUT;
        if (r < 2 * I_G) {
            const int isup = r >= I_G; if (isup) r -= I_G;
            const int e = r / 512, rem = r % 512, kb = rem / 16, nb = rem % 16, n0 = nb * 64;
            const float* W = (isup ? p.w_up : p.w_gate) + (size_t)e * DM * DE;
            transpose_item(W, DE, DM, kb * 64, n0, WTGU, (size_t)e * 2048 + (n0 >> 7) * 256 + isup * 128 + (n0 & 127), scr, lane); continue; }
        r -= 2 * I_G;
        { const int e = r / 512, rem = r % 512, kb = rem / 32, nb = rem % 32;
          transpose_item(p.w_down + (size_t)e * DE * DM, DM, DE, kb * 64, nb * 64, WTD, (size_t)e * 2048 + nb * 64, scr, lane); }
    }
}

__device__ __forceinline__ void mod_reduce_to_lds(const Params& p, LAS float* dst, int j0, int n, bool ctxvec) {
    const float* modp = (const float*)(p.ws + WS_CTL + CTL_MODP);
    for (int i = threadIdx.x; i < n; i += NTHREADS) {
        const int j = j0 + i; const int jj = ctxvec ? 12288 + j : j;
        dst[i] = ((modp[jj] + modp[16384 + jj]) + (modp[2 * 16384 + jj] + modp[3 * 16384 + jj])) + p.b_mod[j];
    }
}
__device__ __forceinline__ void p1_hrows(const Params& p, LAS unsigned char* lds) {
    const int tid = threadIdx.x, wave = tid >> 6, lane = tid & 63;
    LAS float* SH = (LAS float*)lds; LAS float* SC = SH + 2048; LAS float* CSH = SC + 2048; LAS float* CSC = CSH + 2048;
    mod_reduce_to_lds(p, SH, 0, 2048, false); mod_reduce_to_lds(p, SC, 2048, 2048, false);
    mod_reduce_to_lds(p, CSH, 0, 2048, true); mod_reduce_to_lds(p, CSC, 2048, 2048, true);
    __syncthreads();
    bf16_t* H = (bf16_t*)(p.ws + WS_H);
    const int gw = blockIdx.x * NWAVES + wave, NGW = gridDim.x * NWAVES;
    for (int m = gw; m < MT; m += NGW) {
        const bool isc = m < CTXL;
        const float* xr = isc ? p.ctx + (size_t)m * DM : p.x + (size_t)(m - CTXL) * DM;
        const LAS float* sh = isc ? CSH : SH; const LAS float* sc = isc ? CSC : SC;
        f32x4 v[8]; float ss = 0.f;
#pragma unroll
        for (int j = 0; j < 8; ++j) { v[j] = *(const f32x4*)(xr + 4 * (lane + 64 * j)); ss += (v[j][0] * v[j][0] + v[j][1] * v[j][1]) + (v[j][2] * v[j][2] + v[j][3] * v[j][3]); }
        const float rstd = rsqrtf(wave_sum(ss) * (1.f / DM) + EPS);
#pragma unroll
        for (int j = 0; j < 8; ++j) {
            const int col = 4 * (lane + 64 * j);
            const f32x4 nw = *(const f32x4*)(p.norm_w + col); const f32x4 a = *(const LAS f32x4*)(sc + col); const f32x4 b = *(const LAS f32x4*)(sh + col);
            const f32x4 o = (v[j] * rstd * nw) * (a + 1.f) + b;
            u32x2 w; w.x = pk2(o[0], o[1]); w.y = pk2(o[2], o[3]);
            *(u32x2*)(H + (size_t)m * DM + col) = w;
        }
    }
}

struct EpiF32 {
    static constexpr bool PERM = false, AFTER_DRAIN = false;
    float* C; int ldc;
    __device__ __forceinline__ void operator()(const f32x4 (&acc)[2][2][4][2], const pg8::Unit& u, int wr, int wc, int fr, int fq) const {
        const int row0 = u.pm * 256 + wr * 64 + fr, col0 = u.pn * 256 + wc * 32 + 4 * fq;
#pragma unroll
        for (int ai = 0; ai < 2; ++ai)
#pragma unroll
            for (int m = 0; m < 4; ++m) { float* rowp = C + (size_t)(row0 + ai * 128 + m * 16) * ldc + col0;
#pragma unroll
                for (int bj = 0; bj < 2; ++bj)
#pragma unroll
                    for (int n = 0; n < 2; ++n) *(f32x4*)(rowp + bj * 128 + n * 16) = acc[ai][bj][m][n]; }
    }
};
struct EpiGateUp {
    static constexpr bool PERM = false, AFTER_DRAIN = false;
    bf16_t* G;
    __device__ __forceinline__ void operator()(const f32x4 (&acc)[2][2][4][2], const pg8::Unit& u, int wr, int wc, int fr, int fq) const {
        const int row0 = u.pm * 256 + wr * 64 + fr, col0 = u.pn * 128 + wc * 32 + 4 * fq;
#pragma unroll
        for (int ai = 0; ai < 2; ++ai)
#pragma unroll
            for (int m = 0; m < 4; ++m) { bf16_t* rowp = G + (size_t)(row0 + ai * 128 + m * 16) * DE + col0;
#pragma unroll
                for (int n = 0; n < 2; ++n) { const f32x4 g = acc[ai][0][m][n], up = acc[ai][1][m][n];
                    u32x2 w; w.x = pk2(silu_f(g[0]) * up[0], silu_f(g[1]) * up[1]); w.y = pk2(silu_f(g[2]) * up[2], silu_f(g[3]) * up[3]);
                    *(u32x2*)(rowp + n * 16) = w; } }
    }
};
struct EpiProj {
    static constexpr bool PERM = false, AFTER_DRAIN = false;
    unsigned char* ws;
    __device__ __forceinline__ void store_bf16(bf16_t* base, int ld, int colt, int mode, const f32x4 (&acc)[2][2][4][2], int row0, int wc, int fq) const {
#pragma unroll
        for (int ai = 0; ai < 2; ++ai)
#pragma unroll
            for (int m = 0; m < 4; ++m) { bf16_t* rowp = base + (size_t)(row0 + ai * 128 + m * 16) * ld + colt + wc * 32 + 4 * fq;
#pragma unroll
                for (int bj = 0; bj < 2; ++bj)
#pragma unroll
                    for (int n = 0; n < 2; ++n) { f32x4 v = acc[ai][bj][m][n];
                        if (mode == 1) { v[0] = silu_f(v[0]); v[1] = silu_f(v[1]); v[2] = silu_f(v[2]); v[3] = silu_f(v[3]); }
                        u32x2 w; w.x = pk2(v[0], v[1]); w.y = pk2(v[2], v[3]);
                        *(u32x2*)(rowp + bj * 128 + n * 16) = w; } }
    }
    __device__ __forceinline__ void operator()(const f32x4 (&acc)[2][2][4][2], const pg8::Unit& u, int wr, int wc, int fr, int fq) const {
        const int pn = u.pn, row0 = u.pm * 256 + wr * 64 + fr;
        if (pn < 4) { store_bf16((bf16_t*)(ws + WS_Q), 1024, pn * 256, 1, acc, row0, wc, fq); return; }
        if (pn < 12) {
            const int d = pn >= 8; float* Gp = (float*)(ws + (d ? WS_GB : WS_GF)); const float* LB = (const float*)(ws + WS_CTL + CTL_LB) + d * 1024;
            const int colt = (pn - (d ? 8 : 4)) * 256 + wc * 32 + 4 * fq;
#pragma unroll
            for (int bj = 0; bj < 2; ++bj)
#pragma unroll
                for (int n = 0; n < 2; ++n) { const int col = colt + bj * 128 + n * 16; const f32x4 lb = *(const f32x4*)(LB + col);
#pragma unroll
                    for (int ai = 0; ai < 2; ++ai)
#pragma unroll
                        for (int m = 0; m < 4; ++m) { const f32x4 z = acc[ai][bj][m][n]; f32x4 g;
#pragma unroll
                            for (int j = 0; j < 4; ++j) g[j] = __logf(lb[j] + (1.f - lb[j]) * sigmoid_f(z[j]));
                            *(f32x4*)(Gp + (size_t)(row0 + ai * 128 + m * 16) * 1024 + col) = g; } }
            return; }
        if (pn < 16) { store_bf16((bf16_t*)(ws + WS_V), 1024, (pn - 12) * 256, 0, acc, row0, wc, fq); return; }
        if (pn < 20) { store_bf16((bf16_t*)(ws + WS_HGATE), 1024, (pn - 16) * 256, 1, acc, row0, wc, fq); return; }
        if (pn < 24) {
            const bool isk = pn >= 22; bf16_t* O = (bf16_t*)(ws + (isk ? WS_RK : WS_RQ)); const float scl = isk ? 0.08838834764831845f : 1.f;
            const int head = (pn - (isk ? 22 : 20)) * 2 + (wc >> 1); const bool colang = (wc & 1) != 0; const bool ropeon = u.pm > 0;
#pragma unroll
            for (int ai = 0; ai < 2; ++ai)
#pragma unroll
                for (int m = 0; m < 4; ++m) { const int row = row0 + ai * 128 + m * 16; const int t = row - CTXL; const float pos = (float)(colang ? (t & 63) : (t >> 6));
#pragma unroll
                    for (int n = 0; n < 2; ++n) { const int i0 = 16 * n + 4 * fq; const f32x4 x1 = acc[ai][0][m][n], x2 = acc[ai][1][m][n]; f32x4 o1, o2;
#pragma unroll
                        for (int j = 0; j < 4; ++j) { float cs = 1.f, sn = 0.f;
                            if (ropeon) { const float ang = pos * exp2f(-(float)(i0 + j) * 0.41524101186092029f); cs = __cosf(ang); sn = __sinf(ang); }
                            o1[j] = (x1[j] * cs - x2[j] * sn) * scl; o2[j] = (x1[j] * sn + x2[j] * cs) * scl; }
                        bf16_t* dp = O + (size_t)row * 512 + head * 128 + 32 * (wc & 1) + i0;
                        u32x2 w; w.x = pk2(o1[0], o1[1]); w.y = pk2(o1[2], o1[3]); *(u32x2*)dp = w;
                        w.x = pk2(o2[0], o2[1]); w.y = pk2(o2[2], o2[3]); *(u32x2*)(dp + 64) = w; } }
            return; }
        if (pn < 28) { store_bf16((bf16_t*)(ws + WS_RV), 1024, (pn - 24) * 256, 0, acc, row0, wc, fq); return; }
        store_bf16((bf16_t*)(ws + WS_RGATE), 1024, (pn - 28) * 256, 1, acc, row0, wc, fq);
    }
};
struct MoeOrder {
    const int* tiles; int G, c;
    __device__ __forceinline__ bool next(int i, pg8::Unit& u) const {
        const int nt = tiles[0]; const int L = i * G + c; if (L >= nt * 8) return false;
        const int t = L >> 3, pn = L & 7; u.pm = t; u.pn = pn; u.pb = tiles[1 + t] * 8 + pn; return true;
    }
    __device__ __forceinline__ void a_ready(const pg8::Unit&) const {}
    __device__ __forceinline__ void done(const pg8::Unit&) const {}
};

__device__ __forceinline__ void vt_write2(LAS unsigned char* VT, const unsigned (&w)[8], int lane, int sg) {
    u32x4 a, b;
    a.x = (w[0] & 0xffffu) | (w[1] << 16); a.y = (w[2] & 0xffffu) | (w[3] << 16); a.z = (w[4] & 0xffffu) | (w[5] << 16); a.w = (w[6] & 0xffffu) | (w[7] << 16);
    b.x = (w[0] >> 16) | (w[1] & 0xffff0000u); b.y = (w[2] >> 16) | (w[3] & 0xffff0000u); b.z = (w[4] >> 16) | (w[5] & 0xffff0000u); b.w = (w[6] >> 16) | (w[7] & 0xffff0000u);
    *(LAS u32x4*)(VT + (2 * lane) * 144 + sg * 16) = a; *(LAS u32x4*)(VT + (2 * lane + 1) * 144 + sg * 16) = b;
}
__device__ __forceinline__ void vt_write4(LAS unsigned char* VT, const u32x2 (&w)[8], int lane, int sg) {
    u32x4 a, b, c, d;
    a.x = (w[0].x & 0xffffu) | (w[1].x << 16); a.y = (w[2].x & 0xffffu) | (w[3].x << 16); a.z = (w[4].x & 0xffffu) | (w[5].x << 16); a.w = (w[6].x & 0xffffu) | (w[7].x << 16);
    b.x = (w[0].x >> 16) | (w[1].x & 0xffff0000u); b.y = (w[2].x >> 16) | (w[3].x & 0xffff0000u); b.z = (w[4].x >> 16) | (w[5].x & 0xffff0000u); b.w = (w[6].x >> 16) | (w[7].x & 0xffff0000u);
    c.x = (w[0].y & 0xffffu) | (w[1].y << 16); c.y = (w[2].y & 0xffffu) | (w[3].y << 16); c.z = (w[4].y & 0xffffu) | (w[5].y << 16); c.w = (w[6].y & 0xffffu) | (w[7].y << 16);
    d.x = (w[0].y >> 16) | (w[1].y & 0xffff0000u); d.y = (w[2].y >> 16) | (w[3].y & 0xffff0000u); d.z = (w[4].y >> 16) | (w[5].y & 0xffff0000u); d.w = (w[6].y >> 16) | (w[7].y & 0xffff0000u);
    *(LAS u32x4*)(VT + (4 * lane) * 144 + sg * 16) = a; *(LAS u32x4*)(VT + (4 * lane + 1) * 144 + sg * 16) = b;
    *(LAS u32x4*)(VT + (4 * lane + 2) * 144 + sg * 16) = c; *(LAS u32x4*)(VT + (4 * lane + 3) * 144 + sg * 16) = d;
}
template <bool RET> struct S1Raw { f32x2 g[8]; unsigned kw[8]; unsigned w2[8]; u32x2 w4[8]; };
template <bool RET>
__device__ __forceinline__ void s1_load(const Params& p, int it, int sg, int lane, S1Raw<RET>& R) {
    const int cc = it % NCH, dh = it / NCH; const int dir = RET ? dh >> 2 : dh >> 3, h = RET ? dh & 3 : dh & 7;
    const size_t row0 = (size_t)cc * 64 + 8 * sg;
    if (!RET) {
        const float* G = (const float*)(p.ws + (dir ? WS_GB : WS_GF)) + row0 * 1024 + h * 128 + 2 * lane;
        const bf16_t* V = (const bf16_t*)(p.ws + WS_V) + row0 * 1024 + h * 128 + 2 * lane;
#pragma unroll
        for (int i = 0; i < 8; ++i) { R.g[i] = *(const f32x2*)(G + (size_t)i * 1024); R.w2[i] = *(const unsigned*)(V + (size_t)i * 1024); }
    } else {
        const bf16_t* K = (const bf16_t*)(p.ws + WS_RK) + row0 * 512 + h * 128 + 2 * lane;
        const bf16_t* V = (const bf16_t*)(p.ws + WS_RV) + row0 * 1024 + h * 256 + 4 * lane;
#pragma unroll
        for (int i = 0; i < 8; ++i) { R.kw[i] = *(const unsigned*)(K + (size_t)i * 512); R.w4[i] = *(const u32x2*)(V + (size_t)i * 1024); }
    }
}
template <bool RET>
__device__ __forceinline__ void s1_process(const Params& p, LAS unsigned char* lds, int it, int sg, int lane, const S1Raw<RET>& R) {
    constexpr int DV = RET ? 256 : 128;
    const int cc = it % NCH, dh = it / NCH; const int dir = RET ? dh >> 2 : dh >> 3, h = RET ? dh & 3 : dh & 7; const int kp = lane;
    LAS unsigned char* KT = lds;
    LAS unsigned char* VT = lds + 18432;
    LAS float* TOT = (LAS float*)(lds + 18432 + 36864);
    float* DEC = (float*)(p.ws + WS_DEC) + (size_t)((RET ? DEC_RET_ITEM0 : 0) + it) * 128;
    float kx[8], ky[8]; float decx, decy;
    if (!RET) {
        f32x2 cs[8];
        cs[0] = R.g[0];
#pragma unroll
        for (int i = 1; i < 8; ++i) cs[i] = cs[i - 1] + R.g[i];
        *(LAS f32x2*)(TOT + sg * 128 + 2 * kp) = cs[7];
        __syncthreads();
        f32x2 pre = {0.f, 0.f}, T = {0.f, 0.f};
#pragma unroll
        for (int s8 = 0; s8 < 8; ++s8) { const f32x2 t = *(const LAS f32x2*)(TOT + s8 * 128 + 2 * kp); if (s8 < sg) pre += t; T += t; }
#pragma unroll
        for (int i = 0; i < 8; ++i) { f32x2 b = pre + cs[i]; if (dir) b = T - b + R.g[i];
            kx[i] = (1.f - __expf(R.g[i].x)) * __expf(-b.x); ky[i] = (1.f - __expf(R.g[i].y)) * __expf(-b.y); }
        decx = __expf(T.x); decy = __expf(T.y);
    } else {
        const float lg = log_sigmoid_f(p.ret_dl[dir * 4 + h]);
#pragma unroll
        for (int i = 0; i < 8; ++i) { const int s = 8 * sg + i; const float e = dir ? (float)(64 - s) : (float)(s + 1);
            const float sc = __expf(-lg * e); kx[i] = bflo(R.kw[i]) * sc; ky[i] = bfhi(R.kw[i]) * sc; }
        decx = decy = __expf(64.f * lg);
    }
    { u32x4 a, b; a.x = pk2(kx[0], kx[1]); a.y = pk2(kx[2], kx[3]); a.z = pk2(kx[4], kx[5]); a.w = pk2(kx[6], kx[7]);
      b.x = pk2(ky[0], ky[1]); b.y = pk2(ky[2], ky[3]); b.z = pk2(ky[4], ky[5]); b.w = pk2(ky[6], ky[7]);
      *(LAS u32x4*)(KT + (2 * kp) * 144 + sg * 16) = a; *(LAS u32x4*)(KT + (2 * kp + 1) * 144 + sg * 16) = b; }
    if (sg == 0) { f32x2 d = {decx, decy}; *(f32x2*)(DEC + 2 * kp) = d; }
    if (!RET) vt_write2(VT, R.w2, lane, sg); else vt_write4(VT, R.w4, lane, sg);
    __syncthreads();
    const int fr = lane & 15, fq = lane >> 4;
    const bf16x8 a0 = *(const LAS bf16x8*)(KT + (16 * sg + fr) * 144 + 16 * fq), a1 = *(const LAS bf16x8*)(KT + (16 * sg + fr) * 144 + 64 + 16 * fq);
    bf16_t* LOC = (bf16_t*)(p.ws + WS_LOCAL + (RET ? LOCAL_RET_OFF : 0)) + (size_t)it * DV * 128 + (size_t)sg * DV * 16;
#pragma unroll
    for (int vt = 0; vt < DV / 16; ++vt) {
        const bf16x8 b0 = *(const LAS bf16x8*)(VT + (16 * vt + fr) * 144 + 16 * fq), b1 = *(const LAS bf16x8*)(VT + (16 * vt + fr) * 144 + 64 + 16 * fq);
        f32x4 acc = {0.f, 0.f, 0.f, 0.f};
        acc = mfma16(a0, b0, acc); acc = mfma16(a1, b1, acc);
        u32x2 w; w.x = pk2(acc[0], acc[1]); w.y = pk2(acc[2], acc[3]);
        *(u32x2*)(LOC + (16 * vt + fr) * 16 + 4 * fq) = w;
    }
}
template <bool RET>
__device__ __forceinline__ void p3_loop(const Params& p, LAS unsigned char* lds, int nitems) {
    const int sg = __builtin_amdgcn_readfirstlane(threadIdx.x >> 6), lane = threadIdx.x & 63, G = gridDim.x;
    int it = blockIdx.x; if (it >= nitems) return;
    S1Raw<RET> A, B; s1_load<RET>(p, it, sg, lane, A);
    for (;;) {
        int nx = it + G; bool has = nx < nitems;
        if (has) s1_load<RET>(p, nx, sg, lane, B);
        s1_process<RET>(p, lds, it, sg, lane, A);
        if (!has) break;
        it = nx; nx = it + G; has = nx < nitems;
        if (has) s1_load<RET>(p, nx, sg, lane, A);
        s1_process<RET>(p, lds + 65536, it, sg, lane, B);
        if (!has) break;
        it = nx;
    }
}
__device__ __forceinline__ void p3_local(const Params& p, LAS unsigned char* lds) {
    p3_loop<true>(p, lds, 2 * 4 * NCH);
    __syncthreads();
    p3_loop<false>(p, lds, 2 * 8 * NCH);
}
__device__ __forceinline__ void p4_scan(const Params& p) {
    const int NTOT = 131072;
    for (int e = blockIdx.x * NTHREADS + threadIdx.x; e < NTOT; e += gridDim.x * NTHREADS) {
        const bool ret = e >= 65536; const int e2 = ret ? e - 65536 : e;
        const int dh = ret ? e2 >> 13 : e2 >> 12; const int rem = ret ? e2 & 8191 : e2 & 4095;
        const int DV = ret ? 256 : 128; const int off = rem * 4; const int k = (off / (DV * 16)) * 16 + (off & 15);
        const int dir = ret ? dh >> 2 : dh >> 3;
        const bf16_t* loc = (const bf16_t*)(p.ws + WS_LOCAL + (ret ? LOCAL_RET_OFF : 0)) + (size_t)dh * NCH * DV * 128 + off;
        const float* dec = (const float*)(p.ws + WS_DEC) + (size_t)((ret ? DEC_RET_ITEM0 : 0) + dh * NCH) * 128 + k;
        bf16_t* sst = (bf16_t*)(p.ws + WS_SST + (ret ? SST_RET_OFF : 0)) + (size_t)dh * NXCH * DV * 128 + off;
        const size_t cstride = (size_t)DV * 128;
        f32x4 S = {0.f, 0.f, 0.f, 0.f};
        for (int i0 = 0; i0 < NCH; i0 += 12) {
            u32x2 lw[12]; f32x4 dc[12]; int ccs[12];
#pragma unroll
            for (int j = 0; j < 12; ++j) { const int i = i0 + j; const int cc = dir ? (i < NCCH ? NCCH - 1 - i : NCH + NCCH - 1 - i) : i; ccs[j] = cc;
                lw[j] = __builtin_nontemporal_load((const u32x2*)(loc + (size_t)cc * cstride)); dc[j] = *(const f32x4*)(dec + (size_t)cc * 128); }
#pragma unroll
            for (int j = 0; j < 12; ++j) {
                if (ccs[j] >= NCCH) { u32x2 w; w.x = pk2(S[0], S[1]); w.y = pk2(S[2], S[3]); *(u32x2*)(sst + (size_t)(ccs[j] - NCCH) * cstride) = w; }
                const f32x4 l = {bflo(lw[j].x), bfhi(lw[j].x), bflo(lw[j].y), bfhi(lw[j].y)};
                S = (S + l) * dc[j];
            }
        }
    }
}
template <bool RET>
__device__ __forceinline__ void s3_item(const Params& p, LAS unsigned char* lds, int h, int xc) {
    constexpr int DV = RET ? 256 : 128, NVW = DV / 128;
    const int tid = threadIdx.x, sg = __builtin_amdgcn_readfirstlane(tid >> 6), lane = tid & 63, kp = lane, fr = lane & 15, fq = lane >> 4;
    LAS unsigned char* QF = lds; LAS unsigned char* QB = lds + 17408; LAS unsigned char* KF = lds + 2 * 17408; LAS unsigned char* KB = lds + 3 * 17408;
    LAS unsigned char* VT = lds + 69632;
    LAS unsigned char* PP = lds + 106496;
    LAS float* TOT = (LAS float*)(lds + 115712);
    LAS float* RS = (LAS float*)(lds + 123904);
    const size_t row0 = (size_t)CTXL + (size_t)xc * 64;
    const bf16_t* SF = (const bf16_t*)(p.ws + WS_SST + (RET ? SST_RET_OFF : 0)) + ((size_t)(0 * (RET ? 4 : 8) + h) * NXCH + xc) * DV * 128;
    const bf16_t* SB = (const bf16_t*)(p.ws + WS_SST + (RET ? SST_RET_OFF : 0)) + ((size_t)(1 * (RET ? 4 : 8) + h) * NXCH + xc) * DV * 128;
    bf16x8 sf[NVW][4], sb[NVW][4];
#pragma unroll
    for (int vi = 0; vi < NVW; ++vi)
#pragma unroll
        for (int ks = 0; ks < 4; ++ks) { const size_t o = ((size_t)(2 * ks + (fq >> 1)) * DV + 16 * (sg * NVW + vi) + fr) * 16 + 8 * (fq & 1);
            sf[vi][ks] = *(const bf16x8*)(SF + o); sb[vi][ks] = *(const bf16x8*)(SB + o); }
    const bf16_t* GT = (const bf16_t*)(p.ws + (RET ? WS_RGATE : WS_HGATE)) + (row0 + fr) * 1024 + h * DV + 4 * fq;
    u32x2 gtv[4][NVW]; f32x4 nwv[NVW];
#pragma unroll
    for (int vi = 0; vi < NVW; ++vi) { nwv[vi] = *(const f32x4*)((RET ? p.ret_nw : p.hg_nw) + h * DV + 16 * (sg * NVW + vi) + 4 * fq);
#pragma unroll
        for (int tt = 0; tt < 4; ++tt) gtv[tt][vi] = *(const u32x2*)(GT + (size_t)(16 * tt) * 1024 + 16 * (sg * NVW + vi)); }
    if (!RET) {
        const float* GFp = (const float*)(p.ws + WS_GF) + (row0 + 8 * sg) * 1024 + h * 128 + 2 * kp;
        const float* GBp = (const float*)(p.ws + WS_GB) + (row0 + 8 * sg) * 1024 + h * 128 + 2 * kp;
        const bf16_t* Qp = (const bf16_t*)(p.ws + WS_Q) + (row0 + 8 * sg) * 1024 + h * 128 + 2 * kp;
        const bf16_t* V = (const bf16_t*)(p.ws + WS_V) + (row0 + 8 * sg) * 1024 + h * 128 + 2 * lane;
        f32x2 gf[8], gb[8], cf[8], cb[8]; unsigned qw[8], vw[8];
#pragma unroll
        for (int i = 0; i < 8; ++i) { gf[i] = *(const f32x2*)(GFp + (size_t)i * 1024); gb[i] = *(const f32x2*)(GBp + (size_t)i * 1024); qw[i] = *(const unsigned*)(Qp + (size_t)i * 1024); vw[i] = *(const unsigned*)(V + (size_t)i * 1024); }
        cf[0] = gf[0]; cb[0] = gb[0];
#pragma unroll
        for (int i = 1; i < 8; ++i) { cf[i] = cf[i - 1] + gf[i]; cb[i] = cb[i - 1] + gb[i]; }
        *(LAS f32x2*)(TOT + sg * 128 + 2 * kp) = cf[7]; *(LAS f32x2*)(TOT + 1024 + sg * 128 + 2 * kp) = cb[7];
        vt_write2(VT, vw, lane, sg);
        __syncthreads();
        f32x2 pf = {0.f, 0.f}, pb = {0.f, 0.f}, Tb = {0.f, 0.f};
#pragma unroll
        for (int s8 = 0; s8 < 8; ++s8) { const f32x2 t = *(const LAS f32x2*)(TOT + s8 * 128 + 2 * kp), t2 = *(const LAS f32x2*)(TOT + 1024 + s8 * 128 + 2 * kp);
            if (s8 < sg) { pf += t; pb += t2; } Tb += t2; }
#pragma unroll
        for (int i = 0; i < 8; ++i) {
            const f32x2 bf = pf + cf[i]; const f32x2 bb = Tb - (pb + cb[i]) + gb[i];
            const float qx = bflo(qw[i]), qy = bfhi(qw[i]); const int s = 8 * sg + i;
            *(LAS unsigned*)(QF + s * 272 + kp * 4) = pk2(qx * __expf(bf.x), qy * __expf(bf.y));
            *(LAS unsigned*)(KF + s * 272 + kp * 4) = pk2((1.f - __expf(gf[i].x)) * __expf(-bf.x), (1.f - __expf(gf[i].y)) * __expf(-bf.y));
            *(LAS unsigned*)(QB + s * 272 + kp * 4) = pk2(qx * __expf(bb.x), qy * __expf(bb.y));
            *(LAS unsigned*)(KB + s * 272 + kp * 4) = pk2((1.f - __expf(gb[i].x)) * __expf(-bb.x), (1.f - __expf(gb[i].y)) * __expf(-bb.y));
        }
    } else {
        const bf16_t* Qp = (const bf16_t*)(p.ws + WS_RQ) + (row0 + 8 * sg) * 512 + h * 128 + 2 * kp;
        const bf16_t* Kp = (const bf16_t*)(p.ws + WS_RK) + (row0 + 8 * sg) * 512 + h * 128 + 2 * kp;
        const bf16_t* V = (const bf16_t*)(p.ws + WS_RV) + (row0 + 8 * sg) * 1024 + h * 256 + 4 * lane;
        const float lgf = log_sigmoid_f(p.ret_dl[h]), lgb = log_sigmoid_f(p.ret_dl[4 + h]);
        unsigned qw[8], kw[8]; u32x2 vw[8];
#pragma unroll
        for (int i = 0; i < 8; ++i) { qw[i] = *(const unsigned*)(Qp + (size_t)i * 512); kw[i] = *(const unsigned*)(Kp + (size_t)i * 512); vw[i] = *(const u32x2*)(V + (size_t)i * 1024); }
        vt_write4(VT, vw, lane, sg);
#pragma unroll
        for (int i = 0; i < 8; ++i) {
            const int s = 8 * sg + i;
            const float bf = (float)(s + 1) * lgf, bb = (float)(64 - s) * lgb;
            const float ef = __expf(bf), eb = __expf(bb), nf = __expf(-bf), nb = __expf(-bb);
            *(LAS unsigned*)(QF + s * 272 + kp * 4) = pk2(bflo(qw[i]) * ef, bfhi(qw[i]) * ef);
            *(LAS unsigned*)(KF + s * 272 + kp * 4) = pk2(bflo(kw[i]) * nf, bfhi(kw[i]) * nf);
            *(LAS unsigned*)(QB + s * 272 + kp * 4) = pk2(bflo(qw[i]) * eb, bfhi(qw[i]) * eb);
            *(LAS unsigned*)(KB + s * 272 + kp * 4) = pk2(bflo(kw[i]) * nb, bfhi(kw[i]) * nb);
        }
    }
    __syncthreads();
    {
        const int tt = sg >> 1;
#pragma unroll
        for (int sti = 0; sti < 2; ++sti) {
            const int st = (sg & 1) * 2 + sti;
            f32x4 af = {0.f, 0.f, 0.f, 0.f}, ab = {0.f, 0.f, 0.f, 0.f};
            if (st <= tt) {
#pragma unroll
                for (int ks = 0; ks < 4; ++ks) { const bf16x8 a = *(const LAS bf16x8*)(KF + (16 * st + fr) * 272 + ks * 64 + 16 * fq), b = *(const LAS bf16x8*)(QF + (16 * tt + fr) * 272 + ks * 64 + 16 * fq); af = mfma16(a, b, af); }
            }
            if (st >= tt) {
#pragma unroll
                for (int ks = 0; ks < 4; ++ks) { const bf16x8 a = *(const LAS bf16x8*)(KB + (16 * st + fr) * 272 + ks * 64 + 16 * fq), b = *(const LAS bf16x8*)(QB + (16 * tt + fr) * 272 + ks * 64 + 16 * fq); ab = mfma16(a, b, ab); }
            }
            f32x4 r;
#pragma unroll
            for (int j = 0; j < 4; ++j) { const int sl = 16 * st + 4 * fq + j, tl = 16 * tt + fr; r[j] = (sl <= tl ? af[j] : 0.f) + (sl >= tl ? ab[j] : 0.f); }
            u32x2 w; w.x = pk2(r[0], r[1]); w.y = pk2(r[2], r[3]);
            *(LAS u32x2*)(PP + (16 * tt + fr) * 144 + (16 * st + 4 * fq) * 2) = w;
        }
    }
    __syncthreads();
    f32x4 o[4][NVW];
#pragma unroll
    for (int tt = 0; tt < 4; ++tt) {
        bf16x8 pb[2], qfb[4], qbb[4];
#pragma unroll
        for (int ks = 0; ks < 2; ++ks) pb[ks] = *(const LAS bf16x8*)(PP + (16 * tt + fr) * 144 + ks * 64 + 16 * fq);
#pragma unroll
        for (int ks = 0; ks < 4; ++ks) { qfb[ks] = *(const LAS bf16x8*)(QF + (16 * tt + fr) * 272 + ks * 64 + 16 * fq); qbb[ks] = *(const LAS bf16x8*)(QB + (16 * tt + fr) * 272 + ks * 64 + 16 * fq); }
        float ss = 0.f;
#pragma unroll
        for (int vi = 0; vi < NVW; ++vi) {
            const int vt = sg * NVW + vi; f32x4 acc = {0.f, 0.f, 0.f, 0.f};
#pragma unroll
            for (int ks = 0; ks < 2; ++ks) { const bf16x8 a = *(const LAS bf16x8*)(VT + (16 * vt + fr) * 144 + ks * 64 + 16 * fq); acc = mfma16(a, pb[ks], acc); }
#pragma unroll
            for (int ks = 0; ks < 4; ++ks) acc = mfma16(sf[vi][ks], qfb[ks], acc);
#pragma unroll
            for (int ks = 0; ks < 4; ++ks) acc = mfma16(sb[vi][ks], qbb[ks], acc);
            o[tt][vi] = acc; ss += (acc[0] * acc[0] + acc[1] * acc[1]) + (acc[2] * acc[2] + acc[3] * acc[3]);
        }
        ss += __shfl_xor(ss, 16); ss += __shfl_xor(ss, 32);
        if (fq == 0) RS[sg * 64 + 16 * tt + fr] = ss;
    }
    __syncthreads();
    bf16_t* PO = (bf16_t*)(p.ws + WS_PREOUT) + ((size_t)xc * 64 + fr) * DM + (RET ? 1024 : 0) + h * DV + 4 * fq;
#pragma unroll
    for (int tt = 0; tt < 4; ++tt) {
        float tot = 0.f;
#pragma unroll
        for (int w8 = 0; w8 < 8; ++w8) tot += RS[w8 * 64 + 16 * tt + fr];
        const float rstd = rsqrtf(tot * (1.f / DV) + EPS);
#pragma unroll
        for (int vi = 0; vi < NVW; ++vi) {
            const u32x2 gw = gtv[tt][vi]; const f32x4 nw = nwv[vi]; const f32x4 a = o[tt][vi];
            u32x2 w; w.x = pk2(a[0] * rstd * nw[0] * bflo(gw.x), a[1] * rstd * nw[1] * bfhi(gw.x)); w.y = pk2(a[2] * rstd * nw[2] * bflo(gw.y), a[3] * rstd * nw[3] * bfhi(gw.y));
            *(u32x2*)(PO + (size_t)(16 * tt) * DM + 16 * (sg * NVW + vi)) = w;
        }
    }
    __syncthreads();
}
__device__ __forceinline__ void p5_out(const Params& p, LAS unsigned char* lds) {
    constexpr int NR = 4 * NXCH, NH = 8 * NXCH;
    for (int it = blockIdx.x; it < NR + NH; it += gridDim.x) {
        if (it < NR) s3_item<true>(p, lds, it / NXCH, it % NXCH);
        else { const int r = it - NR; s3_item<false>(p, lds, r / NXCH, r % NXCH); }
    }
}

__device__ __forceinline__ void p7_norm_route(const Params& p, LAS unsigned char* lds) {
    const int tid = threadIdx.x, wave = tid >> 6, lane = tid & 63;
    LAS float* G1 = (LAS float*)lds; LAS float* SH2 = G1 + 2048; LAS float* SC2 = SH2 + 2048; LAS int* CNTL = (LAS int*)(SC2 + 2048);
    mod_reduce_to_lds(p, G1, 4096, 2048, false); mod_reduce_to_lds(p, SH2, 6144, 2048, false); mod_reduce_to_lds(p, SC2, 8192, 2048, false);
    const float* OX = (const float*)(p.ws + WS_OUTX); bf16_t* HX2 = (bf16_t*)(p.ws + WS_HX2);
    const float* WR = (const float*)(p.ws + WS_CTL + CTL_WR);
    int* CNT = (int*)(p.ws + WS_CTL + CTL_CNT); f32x4* ROUTE = (f32x4*)(p.ws + WS_CTL + CTL_ROUTE);
    for (int grp = blockIdx.x; grp < NGRP; grp += gridDim.x) {
        if (tid < 32) CNTL[tid] = 0;
        __syncthreads();
        f32x4 hv[4][8];
#pragma unroll
        for (int r = 0; r < 4; ++r) {
            const int t = grp * 32 + wave * 4 + r;
            f32x4 ov[8]; float ss = 0.f;
#pragma unroll
            for (int j = 0; j < 8; ++j) { ov[j] = *(const f32x4*)(OX + (size_t)t * DM + 4 * (lane + 64 * j)); ss += (ov[j][0] * ov[j][0] + ov[j][1] * ov[j][1]) + (ov[j][2] * ov[j][2] + ov[j][3] * ov[j][3]); }
            const float rstd = rsqrtf(wave_sum(ss) * (1.f / DM) + EPS); float ss2 = 0.f;
#pragma unroll
            for (int j = 0; j < 8; ++j) { const int col = 4 * (lane + 64 * j);
                const f32x4 xv = *(const f32x4*)(p.x + (size_t)t * DM + col), nw = *(const f32x4*)(p.norm_w + DM + col), g1 = *(const LAS f32x4*)(G1 + col);
                const f32x4 x1 = xv + g1 * (ov[j] * rstd * nw);
                *(f32x4*)(p.out + (size_t)t * DM + col) = x1; hv[r][j] = x1;
                ss2 += (x1[0] * x1[0] + x1[1] * x1[1]) + (x1[2] * x1[2] + x1[3] * x1[3]); }
            const float rstd2 = rsqrtf(wave_sum(ss2) * (1.f / DM) + EPS);
#pragma unroll
            for (int j = 0; j < 8; ++j) { const int col = 4 * (lane + 64 * j);
                const f32x4 nw = *(const f32x4*)(p.norm_w + 2 * DM + col), a = *(const LAS f32x4*)(SC2 + col), b = *(const LAS f32x4*)(SH2 + col);
                const f32x4 hx = (hv[r][j] * rstd2 * nw) * (a + 1.f) + b; hv[r][j] = hx;
                u32x2 w; w.x = pk2(hx[0], hx[1]); w.y = pk2(hx[2], hx[3]); *(u32x2*)(HX2 + (size_t)t * DM + col) = w; }
            asm volatile("" ::: "memory");
        }
        {
            LAS float* LG = (LAS float*)(lds + 32768) + wave * 160;
#pragma unroll 1
            for (int o = 0; o < 36; ++o) {
                float a0 = 0.f, a1 = 0.f, a2 = 0.f, a3 = 0.f;
#pragma unroll
                for (int j = 0; j < 8; ++j) { const f32x4 w = *(const f32x4*)(WR + o * 2048 + 4 * (lane + 64 * j));
                    a0 += (hv[0][j][0] * w[0] + hv[0][j][1] * w[1]) + (hv[0][j][2] * w[2] + hv[0][j][3] * w[3]);
                    a1 += (hv[1][j][0] * w[0] + hv[1][j][1] * w[1]) + (hv[1][j][2] * w[2] + hv[1][j][3] * w[3]);
                    a2 += (hv[2][j][0] * w[0] + hv[2][j][1] * w[1]) + (hv[2][j][2] * w[2] + hv[2][j][3] * w[3]);
                    a3 += (hv[3][j][0] * w[0] + hv[3][j][1] * w[1]) + (hv[3][j][2] * w[2] + hv[3][j][3] * w[3]); }
                a0 = wave_sum(a0); a1 = wave_sum(a1); a2 = wave_sum(a2); a3 = wave_sum(a3);
                if (lane == 0) { LG[o] = a0; LG[40 + o] = a1; LG[80 + o] = a2; LG[120 + o] = a3; }
            }
            LDS_WAIT(); asm volatile("" ::: "memory");
            const LAS float* Lr = LG + (lane & 3) * 40;
            const float L0 = Lr[0] + p.rgb[0], L1 = Lr[1] + p.rgb[1], L2 = Lr[2] + p.rgb[2], L3 = Lr[3] + p.rgb[3];
            int grpi = 0; float gmax = L0;
            if (L1 > gmax) { gmax = L1; grpi = 1; }
            if (L2 > gmax) { gmax = L2; grpi = 2; }
            if (L3 > gmax) { gmax = L3; grpi = 3; }
            const float psel = 1.f / ((__expf(L0 - gmax) + __expf(L1 - gmax)) + (__expf(L2 - gmax) + __expf(L3 - gmax)));
            float le[8];
#pragma unroll
            for (int j = 0; j < 8; ++j) le[j] = Lr[4 + grpi * 8 + j] + p.reb[grpi * 8 + j];
            int i1 = 0; float v1 = le[0];
#pragma unroll
            for (int j = 1; j < 8; ++j) if (le[j] > v1) { v1 = le[j]; i1 = j; }
            int i2 = -1; float v2 = -3.0e38f;
#pragma unroll
            for (int j = 0; j < 8; ++j) if (j != i1 && le[j] > v2) { v2 = le[j]; i2 = j; }
            const float e2 = __expf(v2 - v1); const float ga = psel / (1.f + e2), gb2 = psel * e2 / (1.f + e2);
            if (lane < 4) {
                const int t = grp * 32 + wave * 4 + lane; const int ea = grpi * 8 + i1, eb = grpi * 8 + i2;
                f32x4 rt; rt[0] = __builtin_bit_cast(float, ea); rt[1] = __builtin_bit_cast(float, eb); rt[2] = ga; rt[3] = gb2; ROUTE[t] = rt;
                atomicAdd((int*)&CNTL[ea], 1); atomicAdd((int*)&CNTL[eb], 1);
            }
        }
        __syncthreads();
        if (tid < 32) CNT[grp * 32 + tid] = CNTL[tid];
        __syncthreads();
    }
}
__device__ __forceinline__ void p8_slots(const Params& p, LAS unsigned char* lds) {
    const int tid = threadIdx.x, wave = tid >> 6, lane = tid & 63;
    LAS int* PT = (LAS int*)lds;
    LAS int* PP = PT + 512;
    LAS int* TOTE = PP + 512;
    LAS int* BASE = TOTE + 32;
    LAS int* SLOTL = BASE + 32;
    const int* CNT = (const int*)(p.ws + WS_CTL + CTL_CNT); const f32x4* ROUTE = (const f32x4*)(p.ws + WS_CTL + CTL_ROUTE);
    int* SLOT = (int*)(p.ws + WS_CTL + CTL_SLOT); int* TILES = (int*)(p.ws + WS_CTL + CTL_TILES);
    const bf16_t* HX2 = (const bf16_t*)(p.ws + WS_HX2); bf16_t* XS = (bf16_t*)(p.ws + WS_XS);
    for (int grp = blockIdx.x; grp < NGRP; grp += gridDim.x) {
        { const int e = tid & 31, part = tid >> 5; int t = 0, pr = 0;
          for (int g = part * 16; g < part * 16 + 16; ++g) { const int c = CNT[g * 32 + e]; t += c; if (g < grp) pr += c; }
          PT[part * 32 + e] = t; PP[part * 32 + e] = pr; }
        __syncthreads();
        if (tid < 32) { int t = 0, pr = 0; for (int q = 0; q < 16; ++q) { t += PT[q * 32 + tid]; pr += PP[q * 32 + tid]; } TOTE[tid] = t; BASE[tid] = pr; }
        __syncthreads();
        if (tid == 0) { int st = 0; for (int e = 0; e < 32; ++e) { const int t = TOTE[e]; BASE[e] += st;
                if (grp == 0) { const int nt = (t + 255) >> 8; for (int q = 0; q < nt; ++q) TILES[1 + (st >> 8) + q] = e; }
                st += ((t + 255) >> 8) << 8; }
            if (grp == 0) TILES[0] = st >> 8; }
        __syncthreads();
        if (wave == 0) {
            const int t = grp * 32 + (lane >> 1); const f32x4 rt = ROUTE[t]; const int e = __builtin_bit_cast(int, (lane & 1) ? rt[1] : rt[0]);
            int rank = 0; const unsigned long long ltmask = (1ull << lane) - 1ull;
            for (int q = 0; q < 32; ++q) { const unsigned long long m = __ballot(e == q); if (e == q) rank = __popcll(m & ltmask); }
            const int slot = BASE[e] + rank; SLOTL[lane] = slot; SLOT[grp * 64 + lane] = slot;
        }
        __syncthreads();
        for (int a = wave * 8; a < wave * 8 + 8; ++a) {
            const int t = grp * 32 + (a >> 1); const int slot = SLOTL[a];
            const u32x4* src = (const u32x4*)(HX2 + (size_t)t * DM); u32x4* dst = (u32x4*)(XS + (size_t)slot * DM);
#pragma unroll
            for (int j = 0; j < 4; ++j) dst[lane + 64 * j] = src[lane + 64 * j];
        }
        __syncthreads();
    }
}
__device__ __forceinline__ void p11_final(const Params& p, LAS unsigned char* lds) {
    const int tid = threadIdx.x, wave = tid >> 6, lane = tid & 63;
    LAS float* G2 = (LAS float*)lds;
    mod_reduce_to_lds(p, G2, 10240, 2048, false);
    __syncthreads();
    const float* YB = (const float*)(p.ws + WS_YB); const int* SLOT = (const int*)(p.ws + WS_CTL + CTL_SLOT); const f32x4* ROUTE = (const f32x4*)(p.ws + WS_CTL + CTL_ROUTE);
    const int gw = blockIdx.x * NWAVES + wave, NGW = gridDim.x * NWAVES;
    for (int t = gw; t < SEQ; t += NGW) {
        const int sa = SLOT[2 * t], sb = SLOT[2 * t + 1]; const f32x4 rt = ROUTE[t]; const float ga = rt[2], gb = rt[3];
        f32x4 y[8]; float ss = 0.f;
#pragma unroll
        for (int j = 0; j < 8; ++j) { const int col = 4 * (lane + 64 * j);
            const f32x4 ya = *(const f32x4*)(YB + (size_t)sa * DM + col), yb = *(const f32x4*)(YB + (size_t)sb * DM + col);
            y[j] = ya * ga + yb * gb; ss += (y[j][0] * y[j][0] + y[j][1] * y[j][1]) + (y[j][2] * y[j][2] + y[j][3] * y[j][3]); }
        const float rstd = rsqrtf(wave_sum(ss) * (1.f / DM) + EPS);
#pragma unroll
        for (int j = 0; j < 8; ++j) { const int col = 4 * (lane + 64 * j);
            const f32x4 nw = *(const f32x4*)(p.norm_w + 3 * DM + col), g2 = *(const LAS f32x4*)(G2 + col);
            f32x4* op = (f32x4*)(p.out + (size_t)t * DM + col); *op = *op + g2 * (y[j] * rstd * nw); }
    }
}

#define XB_TMO      128
#define XB_XCNT(j)  (256  + 64 * (j))
#define XB_XSUB(j)  (1280 + 64 * (j))
#define XB_XGEN(j)  (2304 + 64 * (j))
#define XB_TOP      3328
#define XB_TOPGEN   3392
#define XCD_BAR_WORDS 3456
#define XB_SPIN_CAP (1u << 18)

__device__ __forceinline__ unsigned xb_ld(unsigned* p)              { return __hip_atomic_load(p, __ATOMIC_RELAXED, __HIP_MEMORY_SCOPE_AGENT); }
__device__ __forceinline__ unsigned xb_add(unsigned* p, unsigned v) { return __hip_atomic_fetch_add(p, v, __ATOMIC_RELAXED, __HIP_MEMORY_SCOPE_AGENT); }
__device__ __forceinline__ unsigned xb_xcc_id() { return (unsigned)__builtin_amdgcn_s_getreg((3 << 11) | 20) & 0xFu; }
#define XB_SPIN(cond, bar) do { unsigned _sp = 0; while (cond) { __builtin_amdgcn_s_sleep(1); \
    if ((++_sp & 255u) == 0u) { if (xb_ld(&(bar)[XB_TMO])) break; if (_sp > XB_SPIN_CAP) { atomicAdd(&(bar)[XB_TMO], 1u); break; } } } } while (0)

struct XcdBarrier {
    unsigned* bar; unsigned x;
    volatile LAS unsigned* st;
};

__device__ __forceinline__ XcdBarrier xcd_barrier_post(unsigned* bar, volatile LAS unsigned* st) {
    XcdBarrier b; b.bar = bar; b.x = xb_xcc_id(); b.st = st;
    if (threadIdx.x == 0) (void)xb_add(&bar[XB_XCNT(b.x)], 1u);
    return b;
}
__device__ __forceinline__ void xcd_barrier_complete(unsigned* bar, unsigned x, unsigned& nloc, unsigned& nx) {
    const unsigned G = gridDim.x * gridDim.y * gridDim.z;
    unsigned sum, cnt, mine, sp = 0u;
    for (;;) {
        sum = 0u; cnt = 0u; mine = 0u;
#pragma unroll
        for (unsigned j = 0; j < 16; ++j) { const unsigned c = xb_ld(&bar[XB_XCNT(j)]); sum += c; cnt += (c > 0u) ? 1u : 0u; mine = (j == x) ? c : mine; }
        if (sum == G) break;
        __builtin_amdgcn_s_sleep(1);
        if ((++sp & 255u) == 0u) { if (xb_ld(&bar[XB_TMO])) break; if (sp > XB_SPIN_CAP) { atomicAdd(&bar[XB_TMO], 1u); break; } }
    }
    nloc = mine > 0u ? mine : 1u; nx = cnt > 0u ? cnt : 1u;
}

__device__ __forceinline__ void xcd_barrier(const XcdBarrier& b) {
    asm volatile("s_waitcnt vmcnt(0)" ::: "memory");
    __syncthreads();
    if (threadIdx.x == 0) {
        unsigned* bar = b.bar;
        __builtin_amdgcn_s_waitcnt(0);
        unsigned nloc = b.st[0], nx = b.st[1];
        if (nloc == 0u) { xcd_barrier_complete(bar, b.x, nloc, nx); b.st[0] = nloc; b.st[1] = nx; }
        const unsigned old = xb_add(&bar[XB_XSUB(b.x)], 1u);
        const unsigned gen = old / nloc;
        if (old + 1u == (gen + 1u) * nloc) {
            __builtin_amdgcn_fence(__ATOMIC_RELEASE, "agent");
            asm volatile("s_waitcnt vmcnt(0)" ::: "memory");
            const unsigned og = xb_add(&bar[XB_TOP], 1u);
            const unsigned tg = og / nx;
            if (og + 1u == (tg + 1u) * nx) xb_add(&bar[XB_TOPGEN], 1u);
            else XB_SPIN(xb_ld(&bar[XB_TOPGEN]) == tg, bar);
            __builtin_amdgcn_fence(__ATOMIC_ACQUIRE, "agent");
            xb_add(&bar[XB_XGEN(b.x)], 1u);
            asm volatile("s_waitcnt vmcnt(0)" ::: "memory");
        } else {
            XB_SPIN(xb_ld(&bar[XB_XGEN(b.x)]) == gen, bar);
            __builtin_amdgcn_fence(__ATOMIC_ACQUIRE, "agent");
            asm volatile("s_waitcnt vmcnt(0)" ::: "memory");
        }
    }
    __syncthreads();
}

constexpr int NPHASE = 12;
__global__ void __launch_bounds__(NTHREADS, 2) fwd_kernel(Params p) {
    extern __shared__ __attribute__((aligned(16))) unsigned char lds_raw[];
    LAS unsigned char* lds = (LAS unsigned char*)lds_raw;
    cg::grid_group grid = cg::this_grid();
    const int lo = p.ph_lo, hi = p.ph_hi;
    volatile LAS unsigned* MISC = (volatile LAS unsigned*)(lds + MISC_OFF);
    if (threadIdx.x < 64) MISC[threadIdx.x] = 0u;
    __syncthreads();
    XcdBarrier bar; bar.bar = (unsigned*)(p.ws + WS_CTL + CTL_BAR); bar.x = 0; bar.st = nullptr;
    if (hi - lo > 1) bar = xcd_barrier_post((unsigned*)(p.ws + WS_CTL + CTL_BAR), MISC + 8);
    if (lo < 0) grid.sync();
    const int G = gridDim.x, bx = blockIdx.x;
    const int vcu = (G % 8 == 0) ? (bx % 8) * (G / 8) + bx / 8 : bx;
#ifndef PHM
#define PHM 0xfff
#endif
#define IN(k) (((PHM >> (k)) & 1) && lo <= (k) && (k) < hi)
#ifndef REPM
#define REPM 0
#endif
#define SEAM(k) do { if (IN(k) && IN((k) + 1)) xcd_barrier(bar); } while (0)
    if (IN(0)) for (int rep_ = 0; rep_ <= ((REPM >> 0) & 1); ++rep_) { if (rep_) xcd_barrier(bar); p0_prologue(p, lds); } SEAM(0);
    if (IN(1)) for (int rep_ = 0; rep_ <= ((REPM >> 1) & 1); ++rep_) { if (rep_) xcd_barrier(bar); p1_hrows(p, lds); } SEAM(1);
    if (IN(2)) for (int rep_ = 0; rep_ <= ((REPM >> 2) & 1); ++rep_) { if (rep_) xcd_barrier(bar);
        pg8::Gemm g{(const bf16_t*)(p.ws + WS_H), (const bf16_t*)(p.ws + WS_WTIN), MT, PW, DM}; pg8::StaticOrder S; S.init(MT, PW, G, bx);
        EpiProj E{p.ws};
        pg8::gemm_phase<EpiProj, pg8::StaticOrder, true, true>(lds, g, S, E);
    } SEAM(2);
    if (IN(3)) for (int rep_ = 0; rep_ <= ((REPM >> 3) & 1); ++rep_) { if (rep_) xcd_barrier(bar); p3_local(p, lds); } SEAM(3);
    if (IN(4)) for (int rep_ = 0; rep_ <= ((REPM >> 4) & 1); ++rep_) { if (rep_) xcd_barrier(bar); p4_scan(p); } SEAM(4);
    if (IN(5)) for (int rep_ = 0; rep_ <= ((REPM >> 5) & 1); ++rep_) { if (rep_) xcd_barrier(bar); p5_out(p, lds); } SEAM(5);
    if (IN(6)) for (int rep_ = 0; rep_ <= ((REPM >> 6) & 1); ++rep_) { if (rep_) xcd_barrier(bar);
        pg8::Gemm g{(const bf16_t*)(p.ws + WS_PREOUT), (const bf16_t*)(p.ws + WS_WTOUT), SEQ, DM, DM}; pg8::StaticOrder S; S.init(SEQ, DM, G, bx);
        EpiF32 E{(float*)(p.ws + WS_OUTX), DM};
        pg8::gemm_phase<EpiF32, pg8::StaticOrder, true, true>(lds, g, S, E);
    } SEAM(6);
    if (IN(7)) for (int rep_ = 0; rep_ <= ((REPM >> 7) & 1); ++rep_) { if (rep_) xcd_barrier(bar); p7_norm_route(p, lds); } SEAM(7);
    if (IN(8)) for (int rep_ = 0; rep_ <= ((REPM >> 8) & 1); ++rep_) { if (rep_) xcd_barrier(bar); p8_slots(p, lds); } SEAM(8);
    if (IN(9)) for (int rep_ = 0; rep_ <= ((REPM >> 9) & 1); ++rep_) { if (rep_) xcd_barrier(bar);
        pg8::Gemm g{(const bf16_t*)(p.ws + WS_XS), (const bf16_t*)(p.ws + WS_WTGU), 0, 0, DM}; MoeOrder S{(const int*)(p.ws + WS_CTL + CTL_TILES), G, vcu};
        EpiGateUp E{(bf16_t*)(p.ws + WS_GACT)};
        pg8::gemm_phase<EpiGateUp, MoeOrder, true, true>(lds, g, S, E);
    } SEAM(9);
    if (IN(10)) for (int rep_ = 0; rep_ <= ((REPM >> 10) & 1); ++rep_) { if (rep_) xcd_barrier(bar);
        pg8::Gemm g{(const bf16_t*)(p.ws + WS_GACT), (const bf16_t*)(p.ws + WS_WTD), 0, 0, DE}; MoeOrder S{(const int*)(p.ws + WS_CTL + CTL_TILES), G, vcu};
        EpiF32 E{(float*)(p.ws + WS_YB), DM};
        pg8::gemm_phase<EpiF32, MoeOrder, true, true>(lds, g, S, E);
    } SEAM(10);
    if (IN(11)) for (int rep_ = 0; rep_ <= ((REPM >> 11) & 1); ++rep_) { if (rep_) xcd_barrier(bar); p11_final(p, lds); }
#undef IN
#undef SEAM
}

#ifndef MK_ONE_LAUNCH
#define MK_ONE_LAUNCH 1
#endif
extern "C" void kernel_launch(void* const* d_in, const int* in_sizes, int n_in, void* d_out, int out_size, void* d_ws, size_t ws_size, hipStream_t stream) {
    static int grid = 0;
    if (grid == 0) {
        if (n_in != 20 || ws_size < WS_END) { fprintf(stderr, "kernel_launch: unexpected n_in %d or ws_size %zu (< %zu)\n", n_in, ws_size, (size_t)WS_END); grid = -1; return; }
        int dev = 0, cus = 0, per_cu = 0;
        if (hipGetDevice(&dev) != hipSuccess || hipDeviceGetAttribute(&cus, hipDeviceAttributeMultiprocessorCount, dev) != hipSuccess) { grid = -1; return; }
        if (hipFuncSetAttribute((const void*)fwd_kernel, hipFuncAttributeMaxDynamicSharedMemorySize, LDS_BYTES) != hipSuccess) { fprintf(stderr, "kernel_launch: hipFuncSetAttribute failed\n"); grid = -1; return; }
        if (hipOccupancyMaxActiveBlocksPerMultiprocessor(&per_cu, (const void*)fwd_kernel, NTHREADS, LDS_BYTES) != hipSuccess || per_cu < 1) { fprintf(stderr, "kernel_launch: occupancy query says %d blocks per CU\n", per_cu); (void)hipGetLastError(); grid = -1; return; }
        grid = cus;
    }
    if (grid < 0) return;
    Params p{};
    const float* const* in = (const float* const*)d_in;
    p.x = in[0]; p.c = in[1]; p.ctx = in[2]; p.c_ctx = in[3]; p.w_mod = in[4]; p.b_mod = in[5]; p.norm_w = in[6]; p.w_in = in[7]; p.hg_lb = in[8]; p.hg_nw = in[9];
    p.ret_dl = in[10]; p.ret_nw = in[11]; p.w_out = in[12]; p.rgw = in[13]; p.rgb = in[14]; p.rew = in[15]; p.reb = in[16]; p.w_gate = in[17]; p.w_up = in[18]; p.w_down = in[19];
    p.out = (float*)d_out; p.ws = (unsigned char*)d_ws;
#if MK_ONE_LAUNCH
    (void)hipMemsetAsync((char*)d_ws + WS_CTL + CTL_BAR, 0, XCD_BAR_WORDS * 4, stream);
    p.ph_lo = 0; p.ph_hi = NPHASE;
    void* args[] = {&p};
    hipError_t e = hipLaunchCooperativeKernel((const void*)fwd_kernel, dim3(grid), dim3(NTHREADS), args, LDS_BYTES, stream);
    if (e != hipSuccess) fprintf(stderr, "cooperative launch failed: %s (grid %d)\n", hipGetErrorString(e), grid);
#else
    for (int k = 0; k < NPHASE; ++k) { p.ph_lo = k; p.ph_hi = k + 1; hipLaunchKernelGGL(fwd_kernel, dim3(grid), dim3(NTHREADS), LDS_BYTES, stream, p); }
#endif
}
```

```cpp
#include <hip/hip_runtime.h>
#include <hip/hip_cooperative_groups.h>
#include <cstdio>
#include <cstdint>
namespace cg = cooperative_groups;

namespace pg8 {
#define PG8_LAS __attribute__((address_space(3)))
typedef unsigned short bf16_t;
typedef short bf16x8 __attribute__((ext_vector_type(8)));
typedef float f32x4 __attribute__((ext_vector_type(4)));
typedef unsigned u32x4 __attribute__((ext_vector_type(4)));
constexpr int BM = 256, BK = 64, HALF = 128, HTB = HALF * BK * 2  , STAGE_BYTES = 8 * HTB, NXCD = 8, WGM = 8;

__host__ __device__ __forceinline__ int lds_byte(int r, int c) { const int st = (r >> 4) * 2 + (c >> 5), rr = r & 15, cc = c & 31, ob = rr * 64 + cc * 2; return st * 1024 + (ob ^ (((ob >> 9) & 1) << 5)); }
__host__ __device__ __forceinline__ void stage_rc(int b, int& R, int& C) { const int st = b / 1024, sb = b % 1024, swz = sb ^ (((sb >> 9) & 1) << 5); R = (st >> 1) * 16 + swz / 64; C = (st & 1) * 32 + (swz % 64) / 2; }
__host__ __device__ __forceinline__ int perm32(int rho) { const int n = rho >> 4, i = rho & 15; return 8 * (i >> 2) + 4 * n + (i & 3); }

struct Unit { int pm, pn, pb; };
struct Gemm { const bf16_t* A; const bf16_t* Bt; int M, N, K; };

struct StaticOrder {
    int nM, nN, nwg, G, c;
    __host__ __device__ void init(int M, int N, int G_, int c_) { nM = M / BM; nN = N / BM; nwg = nM * nN; G = G_; c = c_; }
    __host__ __device__ bool next(int i, Unit& u) const {
        const long L = (long)i * G + c; if (L >= nwg) return false;
        int wgid = (int)L; { const int q = nwg / NXCD, r = nwg % NXCD, xcd = wgid % NXCD, off = wgid / NXCD; wgid = (xcd < r ? xcd * (q + 1) : r * (q + 1) + (xcd - r) * q) + off; }
        const int nig = WGM * nN, gid = wgid / nig, fm = gid * WGM, gsz = (nM - fm) < WGM ? (nM - fm) : WGM;
        u.pm = fm + ((wgid % nig) % gsz); u.pn = (wgid % nig) / gsz; u.pb = u.pn; return true;
    }
    __device__ __forceinline__ void a_ready(const Unit&) const {}
    __device__ __forceinline__ void done(const Unit&) const {}
};

__device__ __forceinline__ unsigned cvt_pk_bf16(float lo, float hi) { unsigned r; asm volatile("v_cvt_pk_bf16_f32 %0, %1, %2" : "=v"(r) : "v"(lo), "v"(hi)); return r; }
template <class Epi, class Sched, bool ALIGN_EPI = false, bool SP2 = false>
__device__ __forceinline__ void gemm_phase(PG8_LAS unsigned char* lds, const Gemm g, const Sched& S, const Epi& E) {
    const int tid = threadIdx.x, wid = __builtin_amdgcn_readfirstlane(tid >> 6), lane = tid & 63, wr = wid >> 2, wc = wid & 3, fr = lane & 15, fq = lane >> 4;
    const int K = g.K, nt = K / BK;
    unsigned voffA[2], voffB[2];
#pragma unroll
    for (int i = 0; i < 2; ++i) { int R, C; stage_rc(tid * 16 + i * 8192, R, C); const int Rb = Epi::PERM ? ((R & ~31) + perm32(R & 31)) : R;
        voffA[i] = (unsigned)(R * K + C) * 2u; voffB[i] = (unsigned)(Rb * K + C) * 2u; }
    const size_t kstep = (size_t)(BK * 2);
    const size_t hstep = (size_t)HALF * K * 2;
    const size_t tstep = 2 * hstep;
    const unsigned ldsw = (unsigned)wid * 1024u;
    const int aoff = lds_byte(wr * 64 + fr, fq * 8), boff = lds_byte(wc * 32 + fr, fq * 8);
#define PG8_SA(b, h) (((b) * 2 + (h)) * HTB)
#define PG8_SB(b, h) ((4 + (b) * 2 + (h)) * HTB)
#define PG8_STAGE(bufoff, gbase, voff) do { _Pragma("unroll") for (int _i = 0; _i < 2; ++_i) \
        __builtin_amdgcn_global_load_lds((const unsigned*)((const char*)(gbase) + (voff)[_i]), (PG8_LAS unsigned*)(lds + (bufoff) + ldsw + _i * 8192), 16, 0, 0); } while (0)
#define PG8_LDA(dst, b, h) do { _Pragma("unroll") for (int m = 0; m < 4; ++m) _Pragma("unroll") for (int k = 0; k < 2; ++k) dst[m][k] = *(const PG8_LAS bf16x8*)(lds + PG8_SA(b, h) + aoff + m * 2048 + k * 1024); } while (0)
#define PG8_LDB(dst, b, h) do { _Pragma("unroll") for (int n = 0; n < 2; ++n) _Pragma("unroll") for (int k = 0; k < 2; ++k) dst[n][k] = *(const PG8_LAS bf16x8*)(lds + PG8_SB(b, h) + boff + n * 2048 + k * 1024); } while (0)
#define PG8_MMA(ai, bj, At, Bt) do { __builtin_amdgcn_s_setprio(1); _Pragma("unroll") for (int m = 0; m < 4; ++m) _Pragma("unroll") for (int n = 0; n < 2; ++n) _Pragma("unroll") for (int k = 0; k < 2; ++k) \
        acc[ai][bj][m][n] = __builtin_amdgcn_mfma_f32_16x16x32_bf16(Bt[n][k], At[m][k], acc[ai][bj][m][n], 0, 0, 0); __builtin_amdgcn_s_setprio(0); } while (0)
#define PG8_WAIT_V(n) asm volatile("s_waitcnt vmcnt(" #n ")" ::: "memory")
#define PG8_WAIT_L(n) asm volatile("s_waitcnt lgkmcnt(" #n ")" ::: "memory")
#define PG8_BAR __builtin_amdgcn_s_barrier()
#define PG8_SCHED __builtin_amdgcn_sched_barrier(0)
    Unit cur, nxt; int ui = 0;
    if (!S.next(0, cur)) return;
    f32x4 acc[2][2][4][2];
#pragma unroll
    for (int a = 0; a < 2; ++a)
#pragma unroll
        for (int b = 0; b < 2; ++b)
#pragma unroll
            for (int m = 0; m < 4; ++m)
#pragma unroll
                for (int n = 0; n < 2; ++n) acc[a][b][m][n] = (f32x4){0.f, 0.f, 0.f, 0.f};
    bf16x8 At[4][2], B0[2][2], B1[2][2];
    const char* cA = (const char*)g.A + (size_t)cur.pm * tstep; const char* cB = (const char*)g.Bt + (size_t)cur.pb * tstep;
    S.a_ready(cur);
    if constexpr (SP2) {
        PG8_STAGE(PG8_SB(0, 0), cB, voffB); PG8_STAGE(PG8_SB(0, 1), cB + hstep, voffB); PG8_STAGE(PG8_SA(0, 0), cA, voffA); PG8_STAGE(PG8_SA(0, 1), cA + hstep, voffA);
        if (wr == 1) PG8_BAR;
        PG8_WAIT_V(2); PG8_BAR;
        PG8_STAGE(PG8_SB(1, 0), cB + kstep, voffB); PG8_STAGE(PG8_SA(1, 0), cA + kstep, voffA); PG8_STAGE(PG8_SB(1, 1), cB + hstep + kstep, voffB);
        PG8_WAIT_V(6); PG8_BAR;
    } else {
        PG8_STAGE(PG8_SB(0, 0), cB, voffB); PG8_STAGE(PG8_SA(0, 0), cA, voffA); PG8_STAGE(PG8_SB(0, 1), cB + hstep, voffB); PG8_STAGE(PG8_SA(0, 1), cA + hstep, voffA);
        if (wr == 1) PG8_BAR;
        PG8_WAIT_V(4); PG8_BAR;
        PG8_STAGE(PG8_SB(1, 0), cB + kstep, voffB); PG8_STAGE(PG8_SA(1, 0), cA + kstep, voffA); PG8_STAGE(PG8_SB(1, 1), cB + hstep + kstep, voffB);
        PG8_WAIT_V(6); PG8_BAR;
    }
    for (;;) {
        const bool has_next = S.next(ui + 1, nxt);
        const char* nA = has_next ? (const char*)g.A + (size_t)nxt.pm * tstep : cA; const char* nB = has_next ? (const char*)g.Bt + (size_t)nxt.pb * tstep : cB;
        for (int t = 0; t < nt; t += 2) {
            const bool last = (t == nt - 2);
            const char* a1 = cA + (size_t)(t + 1) * kstep;
            const char* a2 = last ? nA : cA + (size_t)(t + 2) * kstep; const char* b2 = last ? nB : cB + (size_t)(t + 2) * kstep;
            const char* a3 = a2 + kstep; const char* b3 = b2 + kstep;
            if (last && has_next) S.a_ready(nxt);
            if constexpr (SP2) {
            PG8_LDB(B0, 0, 0); PG8_LDB(B1, 0, 1); PG8_SCHED; PG8_LDA(At, 0, 0); PG8_STAGE(PG8_SA(1, 1), a1 + hstep, voffA);
            PG8_WAIT_V(8); PG8_WAIT_L(0); PG8_BAR; PG8_MMA(0, 0, At, B0); PG8_MMA(0, 1, At, B1); PG8_BAR; PG8_SCHED;
            PG8_LDA(At, 0, 1); PG8_STAGE(PG8_SB(0, 0), b2, voffB); PG8_STAGE(PG8_SB(0, 1), b2 + hstep, voffB); PG8_STAGE(PG8_SA(0, 0), a2, voffA);
            PG8_WAIT_V(8); PG8_WAIT_L(0); PG8_BAR; PG8_MMA(1, 0, At, B0); PG8_MMA(1, 1, At, B1); PG8_BAR; PG8_SCHED;
            PG8_LDB(B0, 1, 0); PG8_LDB(B1, 1, 1); PG8_SCHED; PG8_LDA(At, 1, 0); PG8_STAGE(PG8_SA(0, 1), a2 + hstep, voffA);
            PG8_WAIT_V(8); PG8_WAIT_L(0); PG8_BAR; PG8_MMA(0, 0, At, B0); PG8_MMA(0, 1, At, B1); PG8_BAR; PG8_SCHED;
            PG8_LDA(At, 1, 1); PG8_STAGE(PG8_SB(1, 0), b3, voffB); PG8_STAGE(PG8_SB(1, 1), b3 + hstep, voffB); PG8_STAGE(PG8_SA(1, 0), a3, voffA);
            PG8_WAIT_V(8); PG8_WAIT_L(0); PG8_BAR; PG8_MMA(1, 0, At, B0); PG8_MMA(1, 1, At, B1); PG8_BAR; PG8_SCHED;
            } else {
            PG8_LDB(B0, 0, 0); PG8_SCHED; PG8_LDA(At, 0, 0); PG8_STAGE(PG8_SA(1, 1), a1 + hstep, voffA);
            PG8_WAIT_L(8); PG8_BAR; PG8_WAIT_L(0); PG8_MMA(0, 0, At, B0); PG8_BAR; PG8_SCHED;
            PG8_LDB(B1, 0, 1); PG8_STAGE(PG8_SB(0, 0), b2, voffB);
            PG8_BAR; PG8_WAIT_L(0); PG8_MMA(0, 1, At, B1); PG8_BAR;
            PG8_LDA(At, 0, 1); PG8_STAGE(PG8_SA(0, 0), a2, voffA);
            PG8_BAR; PG8_WAIT_L(0); PG8_MMA(1, 0, At, B0); PG8_BAR; PG8_SCHED;
            PG8_STAGE(PG8_SB(0, 1), b2 + hstep, voffB);
            PG8_WAIT_V(6); PG8_BAR; PG8_MMA(1, 1, At, B1); PG8_BAR;
            PG8_LDB(B0, 1, 0); PG8_SCHED; PG8_LDA(At, 1, 0); PG8_STAGE(PG8_SA(0, 1), a2 + hstep, voffA);
            PG8_WAIT_L(8); PG8_BAR; PG8_WAIT_L(0); PG8_MMA(0, 0, At, B0); PG8_BAR; PG8_SCHED;
            PG8_LDB(B1, 1, 1); PG8_STAGE(PG8_SB(1, 0), b3, voffB);
            PG8_BAR; PG8_WAIT_L(0); PG8_MMA(0, 1, At, B1); PG8_BAR;
            PG8_LDA(At, 1, 1); PG8_STAGE(PG8_SA(1, 0), a3, voffA);
            PG8_BAR; PG8_WAIT_L(0); PG8_MMA(1, 0, At, B0); PG8_BAR; PG8_SCHED;
            PG8_STAGE(PG8_SB(1, 1), b3 + hstep, voffB);
            PG8_WAIT_V(6); PG8_BAR; PG8_MMA(1, 1, At, B1); PG8_BAR;
            }
        }
        if constexpr (ALIGN_EPI) { if (wr == 0) PG8_BAR; }
        if constexpr (!Epi::AFTER_DRAIN) { E(acc, cur, wr, wc, fr, fq); S.done(cur); }
        if (!has_next) break;
#pragma unroll
        for (int a = 0; a < 2; ++a)
#pragma unroll
            for (int b = 0; b < 2; ++b)
#pragma unroll
                for (int m = 0; m < 4; ++m)
#pragma unroll
                    for (int n = 0; n < 2; ++n) acc[a][b][m][n] = (f32x4){0.f, 0.f, 0.f, 0.f};
        cur = nxt; cA = nA; cB = nB; ++ui;
        if constexpr (ALIGN_EPI) { if (wr == 1) PG8_BAR; }
    }
    PG8_WAIT_V(0);
    if constexpr (!ALIGN_EPI) { if (wr == 0) PG8_BAR; }
    PG8_BAR;
    if constexpr (Epi::AFTER_DRAIN) { E.fused(acc, cur, wr, wc, fr, fq, lds, wid, lane); S.done(cur); }
#undef PG8_SA
#undef PG8_SB
#undef PG8_STAGE
#undef PG8_LDA
#undef PG8_LDB
#undef PG8_MMA
#undef PG8_WAIT_V
#undef PG8_WAIT_L
#undef PG8_BAR
#undef PG8_SCHED
}
}
#define LAS __attribute__((address_space(3)))
typedef unsigned short bf16_t;
typedef short bf16x8 __attribute__((ext_vector_type(8)));
typedef float f32x4 __attribute__((ext_vector_type(4)));
typedef float f32x2 __attribute__((ext_vector_type(2)));
typedef unsigned u32x4 __attribute__((ext_vector_type(4)));
typedef unsigned u32x2 __attribute__((ext_vector_type(2)));

constexpr int DM = 2048, SEQ = 8192, CTXL = 256, MT = SEQ + CTXL, PW = 8192;
constexpr int NCH = MT / 64  , NXCH = SEQ / 64  , NCCH = CTXL / 64  ;
constexpr int NE = 32, DE = 1024, NGRP = 256  ;
constexpr float EPS = 1e-6f;
constexpr int NWAVES = 8, NTHREADS = 512;
constexpr int LDS_BYTES = 147456;

constexpr size_t MiB = 1u << 20;
constexpr size_t WS_WTGU = 0, WS_WTD = 256 * MiB, WS_CTL = 384 * MiB, WS_WTIN = 388 * MiB, WS_WTOUT = 420 * MiB;
constexpr size_t WS_H = 428 * MiB, WS_Q = 461 * MiB, WS_GF = 478 * MiB, WS_GB = 511 * MiB, WS_V = 544 * MiB, WS_HGATE = 561 * MiB;
constexpr size_t WS_RQ = 578 * MiB, WS_RK = 587 * MiB, WS_RV = 596 * MiB, WS_RGATE = 613 * MiB;
constexpr size_t WS_LOCAL = 630 * MiB, WS_DEC = 762 * MiB, WS_SST = 764 * MiB, WS_PREOUT = 892 * MiB, WS_END = 924 * MiB;
constexpr size_t WS_OUTX = 428 * MiB, WS_HX2 = 492 * MiB, WS_XS = 524 * MiB, WS_GACT = 620 * MiB, WS_YB = 668 * MiB;
constexpr size_t CTL_MODP = 0, CTL_LB = 256 * 1024, CTL_CNT = 272 * 1024, CTL_ROUTE = 304 * 1024, CTL_SLOT = 432 * 1024, CTL_TILES = 496 * 1024, CTL_WR = 512 * 1024, CTL_BAR = 1024 * 1024;
constexpr int MISC_OFF = LDS_BYTES - 256;
constexpr size_t LOCAL_RET_OFF = (size_t)2 * 8 * NCH * 128 * 128 * 2;
constexpr size_t SST_RET_OFF = (size_t)2 * 8 * NXCH * 128 * 128 * 2;
constexpr int DEC_RET_ITEM0 = 2 * 8 * NCH;

struct Params {
    const float *x, *c, *ctx, *c_ctx, *w_mod, *b_mod, *norm_w, *w_in, *hg_lb, *hg_nw, *ret_dl, *ret_nw, *w_out, *rgw, *rgb, *rew, *reb, *w_gate, *w_up, *w_down;
    float* out; unsigned char* ws;
    int ph_lo, ph_hi;
};

#define LDS_WAIT() asm volatile("s_waitcnt lgkmcnt(0)" ::: "memory")
__device__ __forceinline__ unsigned f2bf(float f) { unsigned u = __builtin_bit_cast(unsigned, f); return (u + 0x7fffu + ((u >> 16) & 1u)) >> 16; }
__device__ __forceinline__ unsigned pk2(float lo, float hi) { return f2bf(lo) | (f2bf(hi) << 16); }
__device__ __forceinline__ float bflo(unsigned w) { return __builtin_bit_cast(float, w << 16); }
__device__ __forceinline__ float bfhi(unsigned w) { return __builtin_bit_cast(float, w & 0xffff0000u); }
__device__ __forceinline__ float silu_f(float z) { return z / (1.f + __expf(-z)); }
__device__ __forceinline__ float sigmoid_f(float z) { return 1.f / (1.f + __expf(-z)); }
__device__ __forceinline__ float wave_sum(float v) {
#pragma unroll
    for (int o = 1; o < 64; o <<= 1) v += __shfl_xor(v, o);
    return v;
}
__device__ __forceinline__ f32x4 mfma16(bf16x8 a, bf16x8 b, f32x4 c) { return __builtin_amdgcn_mfma_f32_16x16x32_bf16(a, b, c, 0, 0, 0); }
__device__ __forceinline__ float log_sigmoid_f(float z) { return fminf(z, 0.f) - log1pf(__expf(-fabsf(z))); }

__device__ __forceinline__ void p0_gemv(const Params& p, LAS unsigned char* lds) {
    const int tid = threadIdx.x, wave = tid >> 6, lane = tid & 63;
    float* modp = (float*)(p.ws + WS_CTL + CTL_MODP);
    LAS float* red = (LAS float*)lds;
    for (int it = blockIdx.x; it < 192; it += gridDim.x) {
        const int cb = it % 48, kq = it / 48;
        const int col = cb * 256 + lane * 4;
        const int r0 = kq * 512 + wave * 64;
        const bool hasc = cb < 16;
        f32x4 ax = {0.f, 0.f, 0.f, 0.f}, ac = {0.f, 0.f, 0.f, 0.f};
        for (int r = 0; r < 64; r += 16) {
            f32x4 w[16];
#pragma unroll
            for (int i = 0; i < 16; ++i) w[i] = *(const f32x4*)(p.w_mod + (size_t)(r0 + r + i) * 12288 + col);
#pragma unroll
            for (int i = 0; i < 16; ++i) {
                const float sx = silu_f(p.c[r0 + r + i]); ax += w[i] * sx;
                if (hasc) { const float sc = silu_f(p.c_ctx[r0 + r + i]); ac += w[i] * sc; }
            }
        }
        *(LAS f32x4*)(red + (wave * 2 + 0) * 256 + lane * 4) = ax;
        *(LAS f32x4*)(red + (wave * 2 + 1) * 256 + lane * 4) = ac;
        __syncthreads();
        const int vsel = tid >> 8, cc = tid & 255;
        float s = 0.f;
#pragma unroll
        for (int w8 = 0; w8 < 8; ++w8) s += red[(w8 * 2 + vsel) * 256 + cc];
        if (vsel == 0) modp[kq * 16384 + cb * 256 + cc] = s; else if (hasc) modp[kq * 16384 + 12288 + cb * 256 + cc] = s;
        __syncthreads();
    }
}
__device__ __forceinline__ void transpose_item(const float* W, int ldw, int K, int k0, int n0src, bf16_t* WT, size_t drow0, LAS float* scr, int lane) {
    f32x4 v[16];
    const int rr = lane >> 4, c4 = (lane & 15) * 4;
#pragma unroll
    for (int i = 0; i < 16; ++i) v[i] = *(const f32x4*)(W + (size_t)(k0 + rr + 4 * i) * ldw + n0src + c4);
#pragma unroll
    for (int i = 0; i < 16; ++i) { LAS float* d = scr + (rr + 4 * i) * 65 + c4; d[0] = v[i][0]; d[1] = v[i][1]; d[2] = v[i][2]; d[3] = v[i][3]; }
    LDS_WAIT(); asm volatile("" ::: "memory");
    const int c = lane & 7;
#pragma unroll
    for (int j = 0; j < 8; ++j) {
        const int n = (lane >> 3) + 8 * j; const LAS float* s = scr + (8 * c) * 65 + n;
        u32x4 o; o.x = pk2(s[0 * 65], s[1 * 65]); o.y = pk2(s[2 * 65], s[3 * 65]); o.z = pk2(s[4 * 65], s[5 * 65]); o.w = pk2(s[6 * 65], s[7 * 65]);
        *(u32x4*)(WT + (drow0 + n) * (size_t)K + k0 + 8 * c) = o;
    }
    LDS_WAIT(); asm volatile("" ::: "memory");
}
constexpr int TI_IN = 32 * 128, TI_OUT = 32 * 32, TI_G = 32 * 32 * 16, TI_D = 32 * 16 * 32;
#ifndef CONV_N5
#define CONV_N5 4
#endif
__device__ __forceinline__ void transpose_dispatch(const Params& p, LAS unsigned char* lds, int it, int wave, int lane) {
    LAS float* scr = (LAS float*)(lds + wave * 16640);
    bf16_t* WTIN = (bf16_t*)(p.ws + WS_WTIN); bf16_t* WTOUT = (bf16_t*)(p.ws + WS_WTOUT); bf16_t* WTGU = (bf16_t*)(p.ws + WS_WTGU); bf16_t* WTD = (bf16_t*)(p.ws + WS_WTD);
    int r = it;
    if (r < TI_IN) {
        const int kb = r / 128, nb = r % 128; const int drow = nb * 64, pn = drow >> 8;
        int src = drow;
        if (pn >= 20 && pn < 24) { const int q4 = (drow & 255) >> 6, bj = q4 >> 1, hl = q4 & 1; const int pn0 = pn >= 22 ? 22 : 20; src = (pn >= 22 ? 5632 : 5120) + ((pn - pn0) * 2 + hl) * 128 + bj * 64; }
        transpose_item(p.w_in, PW, DM, kb * 64, src, WTIN, (size_t)drow, scr, lane); return; }
    r -= TI_IN;
    if (r < TI_OUT) { const int kb = r / 32, nb = r % 32; transpose_item(p.w_out, DM, DM, kb * 64, nb * 64, WTOUT, (size_t)nb * 64, scr, lane); return; }
    r -= TI_OUT;
    if (r < 2 * TI_G) {
        const int isup = r >= TI_G; if (isup) r -= TI_G;
        const int e = r / 512, rem = r % 512, kb = rem / 16, nb = rem % 16, n0 = nb * 64;
        const float* W = (isup ? p.w_up : p.w_gate) + (size_t)e * DM * DE;
        transpose_item(W, DE, DM, kb * 64, n0, WTGU, (size_t)e * 2048 + (n0 >> 7) * 256 + isup * 128 + (n0 & 127), scr, lane); return; }
    r -= 2 * TI_G;
    { const int e = r / 512, rem = r % 512, kb = rem / 32, nb = rem % 32;
      transpose_item(p.w_down + (size_t)e * DE * DM, DM, DE, kb * 64, nb * 64, WTD, (size_t)e * 2048 + nb * 64, scr, lane); }
}
__device__ __forceinline__ void p0_prologue(const Params& p, LAS unsigned char* lds) {
    const int tid = threadIdx.x, wave = __builtin_amdgcn_readfirstlane(tid >> 6), lane = tid & 63;
    p0_gemv(p, lds);
    {
        float* LB = (float*)(p.ws + WS_CTL + CTL_LB); float* WR = (float*)(p.ws + WS_CTL + CTL_WR);
        const int gt = blockIdx.x * NTHREADS + tid, NT = gridDim.x * NTHREADS;
        for (int i = gt; i < 2048; i += NT) { const float l0 = p.hg_lb[i], l1 = p.hg_lb[2048 + i]; LB[i] = 1.f / (1.f + __expf(l1 - l0)); }
        for (int i = gt; i < 36 * 2048; i += NT) { const int o = i >> 11, k = i & 2047; WR[i] = (o < 4) ? p.rgw[k * 4 + o] : p.rew[k * 32 + (o - 4)]; }
    }
    const int gw = blockIdx.x * NWAVES + wave, NGW = gridDim.x * NWAVES;
    for (int it = gw; it < TI_IN + TI_OUT; it += NGW) transpose_dispatch(p, lds, it, wave, lane);
}
struct CvItem { const float* src; bf16_t* dst; int ldw, K; };
__device__ __forceinline__ CvItem cv_item(const Params& p, int r) {
    CvItem c;
    if (r < 2 * TI_G) { const int isup = r >= TI_G; if (isup) r -= TI_G;
        const int e = r / 512, rem = r % 512, kb = rem / 16, nb = rem % 16, n0 = nb * 64;
        c.src = (isup ? p.w_up : p.w_gate) + (size_t)e * DM * DE + (size_t)(kb * 64) * DE + n0; c.ldw = DE; c.K = DM;
        c.dst = (bf16_t*)(p.ws + WS_WTGU) + ((size_t)e * 2048 + (n0 >> 7) * 256 + isup * 128 + (n0 & 127)) * DM + kb * 64; }
    else { r -= 2 * TI_G; const int e = r / 512, rem = r % 512, kb = rem / 32, nb = rem % 32;
        c.src = p.w_down + (size_t)e * DE * DM + (size_t)(kb * 64) * DM + nb * 64; c.ldw = DM; c.K = DE;
        c.dst = (bf16_t*)(p.ws + WS_WTD) + ((size_t)e * 2048 + nb * 64) * DE + kb * 64; }
    return c;
}
__device__ __forceinline__ void cv_load(const CvItem& c, f32x4 (&v)[16], int lane) {
    const float* s = c.src + (size_t)(lane >> 4) * c.ldw + (lane & 15) * 4;
#pragma unroll
    for (int i = 0; i < 16; ++i) v[i] = __builtin_nontemporal_load((const f32x4*)(s + (size_t)(4 * i) * c.ldw));
}
__device__ __forceinline__ void cv_store(const CvItem& c, const f32x4 (&v)[16], LAS float* scr, int lane) {
    const int rr = lane >> 4, c4 = (lane & 15) * 4;
#pragma unroll
    for (int i = 0; i < 16; ++i) { LAS float* d = scr + (rr + 4 * i) * 65 + c4; d[0] = v[i][0]; d[1] = v[i][1]; d[2] = v[i][2]; d[3] = v[i][3]; }
    LDS_WAIT(); asm volatile("" ::: "memory");
    const int cc = lane & 7;
#pragma unroll
    for (int j = 0; j < 8; ++j) {
        const int n = (lane >> 3) + 8 * j; const LAS float* s = scr + (8 * cc) * 65 + n;
        u32x4 o; o.x = pk2(s[0 * 65], s[1 * 65]); o.y = pk2(s[2 * 65], s[3 * 65]); o.z = pk2(s[4 * 65], s[5 * 65]); o.w = pk2(s[6 * 65], s[7 * 65]);
        __builtin_nontemporal_store(o, (u32x4*)(c.dst + (size_t)n * c.K + 8 * cc));
    }
    LDS_WAIT(); asm volatile("" ::: "memory");
}
__device__ __forceinline__ void p2_convert(const Params& p, LAS unsigned char* lds, int c, int G) {
    int tid_ = threadIdx.x; asm volatile("" : "+v"(tid_));
    const int wave = __builtin_amdgcn_readfirstlane(tid_ >> 6), lane = tid_ & 63;
    LAS float* scr = (LAS float*)(lds + wave * 16640);
    constexpr int NG = (2 * TI_G + TI_D) / 8;
    int g0, g1;
    if (G == 256) { if (c < 32) { g0 = CONV_N5 * c; g1 = g0 + CONV_N5; } else { const int q = c - 32; constexpr int n4 = (NG - 32 * CONV_N5) / 224, ex = (NG - 32 * CONV_N5) % 224; g0 = 32 * CONV_N5 + q * n4 + (q < ex ? q : ex); g1 = g0 + n4 + (q < ex ? 1 : 0); } }
    else { const int per = (NG + G - 1) / G; g0 = c * per; g1 = g0 + per; if (g1 > NG) g1 = NG; }
    if (g0 >= g1) return;
    f32x4 va[16], vb[16];
    int g = g0; CvItem ia = cv_item(p, g * 8 + wave), ib = ia; cv_load(ia, va, lane);
    for (;;) {
        bool has = g + 1 < g1; if (has) { ib = cv_item(p, (g + 1) * 8 + wave); cv_load(ib, vb, lane); }
        cv_store(ia, va, scr, lane);
        if (!has) break;
        ++g; has = g + 1 < g1; if (has) { ia = cv_item(p, (g + 1) * 8 + wave); cv_load(ia, va, lane); }
        cv_store(ib, vb, scr, lane);
        if (!has) break;
        ++g;
    }
    asm volatile("s_waitcnt vmcnt(0)" ::: "memory");
}

__device__ __forceinline__ void mod_reduce_to_lds(const Params& p, LAS float* dst, int j0, int n, bool ctxvec) {
    const float* modp = (const float*)(p.ws + WS_CTL + CTL_MODP);
    for (int i = threadIdx.x * 4; i < n; i += NTHREADS * 4) {
        const int j = j0 + i; const int jj = ctxvec ? 12288 + j : j;
        const f32x4 a = *(const f32x4*)(modp + jj), b = *(const f32x4*)(modp + 16384 + jj), c = *(const f32x4*)(modp + 2 * 16384 + jj), d = *(const f32x4*)(modp + 3 * 16384 + jj), e = *(const f32x4*)(p.b_mod + j);
        *(LAS f32x4*)(dst + i) = ((a + b) + (c + d)) + e;
    }
}
__device__ __forceinline__ void p1_hrows(const Params& p, LAS unsigned char* lds) {
    const int tid = threadIdx.x, wave = tid >> 6, lane = tid & 63;
    LAS float* SH = (LAS float*)lds; LAS float* SC = SH + 2048; LAS float* CSH = SC + 2048; LAS float* CSC = CSH + 2048;
    mod_reduce_to_lds(p, SH, 0, 2048, false); mod_reduce_to_lds(p, SC, 2048, 2048, false);
    mod_reduce_to_lds(p, CSH, 0, 2048, true); mod_reduce_to_lds(p, CSC, 2048, 2048, true);
    __syncthreads();
    bf16_t* H = (bf16_t*)(p.ws + WS_H);
    const int gw = blockIdx.x * NWAVES + wave, NGW = gridDim.x * NWAVES;
    for (int m = gw; m < MT; m += NGW) {
        const bool isc = m < CTXL;
        const float* xr = isc ? p.ctx + (size_t)m * DM : p.x + (size_t)(m - CTXL) * DM;
        const LAS float* sh = isc ? CSH : SH; const LAS float* sc = isc ? CSC : SC;
        f32x4 v[8]; float ss = 0.f;
#pragma unroll
        for (int j = 0; j < 8; ++j) { v[j] = *(const f32x4*)(xr + 4 * (lane + 64 * j)); ss += (v[j][0] * v[j][0] + v[j][1] * v[j][1]) + (v[j][2] * v[j][2] + v[j][3] * v[j][3]); }
        const float rstd = rsqrtf(wave_sum(ss) * (1.f / DM) + EPS);
#pragma unroll
        for (int j = 0; j < 8; ++j) {
            const int col = 4 * (lane + 64 * j);
            const f32x4 nw = *(const f32x4*)(p.norm_w + col); const f32x4 a = *(const LAS f32x4*)(sc + col); const f32x4 b = *(const LAS f32x4*)(sh + col);
            const f32x4 o = (v[j] * rstd * nw) * (a + 1.f) + b;
            u32x2 w; w.x = pk2(o[0], o[1]); w.y = pk2(o[2], o[3]);
            *(u32x2*)(H + (size_t)m * DM + col) = w;
        }
    }
}

struct EpiF32 {
    static constexpr bool PERM = false, AFTER_DRAIN = false;
    float* C; int ldc;
    __device__ __forceinline__ void operator()(const f32x4 (&acc)[2][2][4][2], const pg8::Unit& u, int wr, int wc, int fr, int fq) const {
        const int row0 = u.pm * 256 + wr * 64 + fr, col0 = u.pn * 256 + wc * 32 + 4 * fq;
#pragma unroll
        for (int ai = 0; ai < 2; ++ai)
#pragma unroll
            for (int m = 0; m < 4; ++m) { float* rowp = C + (size_t)(row0 + ai * 128 + m * 16) * ldc + col0;
#pragma unroll
                for (int bj = 0; bj < 2; ++bj)
#pragma unroll
                    for (int n = 0; n < 2; ++n) *(f32x4*)(rowp + bj * 128 + n * 16) = acc[ai][bj][m][n]; }
    }
};
struct EpiGateUp {
    static constexpr bool PERM = false, AFTER_DRAIN = false;
    bf16_t* G;
    __device__ __forceinline__ void operator()(const f32x4 (&acc)[2][2][4][2], const pg8::Unit& u, int wr, int wc, int fr, int fq) const {
        const int row0 = u.pm * 256 + wr * 64 + fr, col0 = u.pn * 128 + wc * 32 + 4 * fq;
#pragma unroll
        for (int ai = 0; ai < 2; ++ai)
#pragma unroll
            for (int m = 0; m < 4; ++m) { bf16_t* rowp = G + (size_t)(row0 + ai * 128 + m * 16) * DE + col0;
#pragma unroll
                for (int n = 0; n < 2; ++n) { const f32x4 g = acc[ai][0][m][n], up = acc[ai][1][m][n];
                    u32x2 w; w.x = pk2(silu_f(g[0]) * up[0], silu_f(g[1]) * up[1]); w.y = pk2(silu_f(g[2]) * up[2], silu_f(g[3]) * up[3]);
                    *(u32x2*)(rowp + n * 16) = w; } }
    }
};
struct EpiProj {
    static constexpr bool PERM = false, AFTER_DRAIN = false;
    unsigned char* ws;
    __device__ __forceinline__ void store_bf16(bf16_t* base, int ld, int colt, int mode, const f32x4 (&acc)[2][2][4][2], int row0, int wc, int fq) const {
#pragma unroll
        for (int ai = 0; ai < 2; ++ai)
#pragma unroll
            for (int m = 0; m < 4; ++m) { bf16_t* rowp = base + (size_t)(row0 + ai * 128 + m * 16) * ld + colt + wc * 32 + 4 * fq;
#pragma unroll
                for (int bj = 0; bj < 2; ++bj)
#pragma unroll
                    for (int n = 0; n < 2; ++n) { f32x4 v = acc[ai][bj][m][n];
                        if (mode == 1) { v[0] = silu_f(v[0]); v[1] = silu_f(v[1]); v[2] = silu_f(v[2]); v[3] = silu_f(v[3]); }
                        u32x2 w; w.x = pk2(v[0], v[1]); w.y = pk2(v[2], v[3]);
                        *(u32x2*)(rowp + bj * 128 + n * 16) = w; } }
    }
    __device__ __forceinline__ void operator()(const f32x4 (&acc)[2][2][4][2], const pg8::Unit& u, int wr, int wc, int fr, int fq) const {
        const int pn = u.pn, row0 = u.pm * 256 + wr * 64 + fr;
        if (pn < 4) { store_bf16((bf16_t*)(ws + WS_Q), 1024, pn * 256, 1, acc, row0, wc, fq); return; }
        if (pn < 12) {
            const int d = pn >= 8; float* Gp = (float*)(ws + (d ? WS_GB : WS_GF)); const float* LB = (const float*)(ws + WS_CTL + CTL_LB) + d * 1024;
            const int colt = (pn - (d ? 8 : 4)) * 256 + wc * 32 + 4 * fq;
#pragma unroll
            for (int bj = 0; bj < 2; ++bj)
#pragma unroll
                for (int n = 0; n < 2; ++n) { const int col = colt + bj * 128 + n * 16; const f32x4 lb = *(const f32x4*)(LB + col);
#pragma unroll
                    for (int ai = 0; ai < 2; ++ai)
#pragma unroll
                        for (int m = 0; m < 4; ++m) { const f32x4 z = acc[ai][bj][m][n]; f32x4 g;
#pragma unroll
                            for (int j = 0; j < 4; ++j) g[j] = __logf(lb[j] + (1.f - lb[j]) * sigmoid_f(z[j]));
                            *(f32x4*)(Gp + (size_t)(row0 + ai * 128 + m * 16) * 1024 + col) = g; } }
            return; }
        if (pn < 16) { store_bf16((bf16_t*)(ws + WS_V), 1024, (pn - 12) * 256, 0, acc, row0, wc, fq); return; }
        if (pn < 20) { store_bf16((bf16_t*)(ws + WS_HGATE), 1024, (pn - 16) * 256, 1, acc, row0, wc, fq); return; }
        if (pn < 24) {
            const bool isk = pn >= 22; bf16_t* O = (bf16_t*)(ws + (isk ? WS_RK : WS_RQ)); const float scl = isk ? 0.08838834764831845f : 1.f;
            const int head = (pn - (isk ? 22 : 20)) * 2 + (wc >> 1); const bool colang = (wc & 1) != 0; const bool ropeon = u.pm > 0;
#pragma unroll
            for (int ai = 0; ai < 2; ++ai)
#pragma unroll
                for (int m = 0; m < 4; ++m) { const int row = row0 + ai * 128 + m * 16; const int t = row - CTXL; const float pos = (float)(colang ? (t & 63) : (t >> 6));
#pragma unroll
                    for (int n = 0; n < 2; ++n) { const int i0 = 16 * n + 4 * fq; const f32x4 x1 = acc[ai][0][m][n], x2 = acc[ai][1][m][n]; f32x4 o1, o2;
#pragma unroll
                        for (int j = 0; j < 4; ++j) { float cs = 1.f, sn = 0.f;
                            if (ropeon) { const float ang = pos * exp2f(-(float)(i0 + j) * 0.41524101186092029f); cs = __cosf(ang); sn = __sinf(ang); }
                            o1[j] = (x1[j] * cs - x2[j] * sn) * scl; o2[j] = (x1[j] * sn + x2[j] * cs) * scl; }
                        bf16_t* dp = O + (size_t)row * 512 + head * 128 + 32 * (wc & 1) + i0;
                        u32x2 w; w.x = pk2(o1[0], o1[1]); w.y = pk2(o1[2], o1[3]); *(u32x2*)dp = w;
                        w.x = pk2(o2[0], o2[1]); w.y = pk2(o2[2], o2[3]); *(u32x2*)(dp + 64) = w; } }
            return; }
        if (pn < 28) { store_bf16((bf16_t*)(ws + WS_RV), 1024, (pn - 24) * 256, 0, acc, row0, wc, fq); return; }
        store_bf16((bf16_t*)(ws + WS_RGATE), 1024, (pn - 28) * 256, 1, acc, row0, wc, fq);
    }
};
struct MoeOrder {
    const int* tiles; int G, c;
    __device__ __forceinline__ bool next(int i, pg8::Unit& u) const {
        const int nt = tiles[0]; const int L = i * G + c; if (L >= nt * 8) return false;
        const int t = L >> 3, pn = L & 7; u.pm = t; u.pn = pn; u.pb = tiles[1 + t] * 8 + pn; return true;
    }
    __device__ __forceinline__ void a_ready(const pg8::Unit&) const {}
    __device__ __forceinline__ void done(const pg8::Unit&) const {}
};

__device__ __forceinline__ void vt_write2(LAS unsigned char* VT, const unsigned (&w)[8], int lane, int sg) {
    u32x4 a, b;
    a.x = (w[0] & 0xffffu) | (w[1] << 16); a.y = (w[2] & 0xffffu) | (w[3] << 16); a.z = (w[4] & 0xffffu) | (w[5] << 16); a.w = (w[6] & 0xffffu) | (w[7] << 16);
    b.x = (w[0] >> 16) | (w[1] & 0xffff0000u); b.y = (w[2] >> 16) | (w[3] & 0xffff0000u); b.z = (w[4] >> 16) | (w[5] & 0xffff0000u); b.w = (w[6] >> 16) | (w[7] & 0xffff0000u);
    *(LAS u32x4*)(VT + (2 * lane) * 144 + sg * 16) = a; *(LAS u32x4*)(VT + (2 * lane + 1) * 144 + sg * 16) = b;
}
__device__ __forceinline__ void vt_write4(LAS unsigned char* VT, const u32x2 (&w)[8], int lane, int sg) {
    u32x4 a, b, c, d;
    a.x = (w[0].x & 0xffffu) | (w[1].x << 16); a.y = (w[2].x & 0xffffu) | (w[3].x << 16); a.z = (w[4].x & 0xffffu) | (w[5].x << 16); a.w = (w[6].x & 0xffffu) | (w[7].x << 16);
    b.x = (w[0].x >> 16) | (w[1].x & 0xffff0000u); b.y = (w[2].x >> 16) | (w[3].x & 0xffff0000u); b.z = (w[4].x >> 16) | (w[5].x & 0xffff0000u); b.w = (w[6].x >> 16) | (w[7].x & 0xffff0000u);
    c.x = (w[0].y & 0xffffu) | (w[1].y << 16); c.y = (w[2].y & 0xffffu) | (w[3].y << 16); c.z = (w[4].y & 0xffffu) | (w[5].y << 16); c.w = (w[6].y & 0xffffu) | (w[7].y << 16);
    d.x = (w[0].y >> 16) | (w[1].y & 0xffff0000u); d.y = (w[2].y >> 16) | (w[3].y & 0xffff0000u); d.z = (w[4].y >> 16) | (w[5].y & 0xffff0000u); d.w = (w[6].y >> 16) | (w[7].y & 0xffff0000u);
    *(LAS u32x4*)(VT + (4 * lane) * 144 + sg * 16) = a; *(LAS u32x4*)(VT + (4 * lane + 1) * 144 + sg * 16) = b;
    *(LAS u32x4*)(VT + (4 * lane + 2) * 144 + sg * 16) = c; *(LAS u32x4*)(VT + (4 * lane + 3) * 144 + sg * 16) = d;
}
template <bool RET> struct S1Raw { f32x2 g[8]; unsigned kw[8]; unsigned w2[8]; u32x2 w4[8]; };
template <bool RET>
__device__ __forceinline__ void s1_load(const Params& p, int it, int sg, int lane, S1Raw<RET>& R) {
    const int cc = it % NCH, dh = it / NCH; const int dir = RET ? dh >> 2 : dh >> 3, h = RET ? dh & 3 : dh & 7;
    const size_t row0 = (size_t)cc * 64 + 8 * sg;
    if (!RET) {
        const float* G = (const float*)(p.ws + (dir ? WS_GB : WS_GF)) + row0 * 1024 + h * 128 + 2 * lane;
        const bf16_t* V = (const bf16_t*)(p.ws + WS_V) + row0 * 1024 + h * 128 + 2 * lane;
#pragma unroll
        for (int i = 0; i < 8; ++i) { R.g[i] = *(const f32x2*)(G + (size_t)i * 1024); R.w2[i] = *(const unsigned*)(V + (size_t)i * 1024); }
    } else {
        const bf16_t* K = (const bf16_t*)(p.ws + WS_RK) + row0 * 512 + h * 128 + 2 * lane;
        const bf16_t* V = (const bf16_t*)(p.ws + WS_RV) + row0 * 1024 + h * 256 + 4 * lane;
#pragma unroll
        for (int i = 0; i < 8; ++i) { R.kw[i] = *(const unsigned*)(K + (size_t)i * 512); R.w4[i] = *(const u32x2*)(V + (size_t)i * 1024); }
    }
}
template <bool RET>
__device__ __forceinline__ void s1_process(const Params& p, LAS unsigned char* lds, int it, int sg, int lane, const S1Raw<RET>& R) {
    constexpr int DV = RET ? 256 : 128;
    const int cc = it % NCH, dh = it / NCH; const int dir = RET ? dh >> 2 : dh >> 3, h = RET ? dh & 3 : dh & 7; const int kp = lane;
    LAS unsigned char* KT = lds;
    LAS unsigned char* VT = lds + 18432;
    LAS float* TOT = (LAS float*)(lds + 18432 + 36864);
    float* DEC = (float*)(p.ws + WS_DEC) + (size_t)((RET ? DEC_RET_ITEM0 : 0) + it) * 128;
    float kx[8], ky[8]; float decx, decy;
    if (!RET) {
        f32x2 cs[8];
        cs[0] = R.g[0];
#pragma unroll
        for (int i = 1; i < 8; ++i) cs[i] = cs[i - 1] + R.g[i];
        *(LAS f32x2*)(TOT + sg * 128 + 2 * kp) = cs[7];
        __syncthreads();
        f32x2 pre = {0.f, 0.f}, T = {0.f, 0.f};
#pragma unroll
        for (int s8 = 0; s8 < 8; ++s8) { const f32x2 t = *(const LAS f32x2*)(TOT + s8 * 128 + 2 * kp); if (s8 < sg) pre += t; T += t; }
#pragma unroll
        for (int i = 0; i < 8; ++i) { f32x2 b = pre + cs[i]; if (dir) b = T - b + R.g[i];
            kx[i] = (1.f - __expf(R.g[i].x)) * __expf(-b.x); ky[i] = (1.f - __expf(R.g[i].y)) * __expf(-b.y); }
        decx = __expf(T.x); decy = __expf(T.y);
    } else {
        const float lg = log_sigmoid_f(p.ret_dl[dir * 4 + h]);
#pragma unroll
        for (int i = 0; i < 8; ++i) { const int s = 8 * sg + i; const float e = dir ? (float)(64 - s) : (float)(s + 1);
            const float sc = __expf(-lg * e); kx[i] = bflo(R.kw[i]) * sc; ky[i] = bfhi(R.kw[i]) * sc; }
        decx = decy = __expf(64.f * lg);
    }
    { u32x4 a, b; a.x = pk2(kx[0], kx[1]); a.y = pk2(kx[2], kx[3]); a.z = pk2(kx[4], kx[5]); a.w = pk2(kx[6], kx[7]);
      b.x = pk2(ky[0], ky[1]); b.y = pk2(ky[2], ky[3]); b.z = pk2(ky[4], ky[5]); b.w = pk2(ky[6], ky[7]);
      *(LAS u32x4*)(KT + (2 * kp) * 144 + sg * 16) = a; *(LAS u32x4*)(KT + (2 * kp + 1) * 144 + sg * 16) = b; }
    if (sg == 0) { f32x2 d = {decx, decy}; *(f32x2*)(DEC + 2 * kp) = d; }
    if (!RET) vt_write2(VT, R.w2, lane, sg); else vt_write4(VT, R.w4, lane, sg);
    __syncthreads();
    const int fr = lane & 15, fq = lane >> 4;
    const bf16x8 a0 = *(const LAS bf16x8*)(KT + (16 * sg + fr) * 144 + 16 * fq), a1 = *(const LAS bf16x8*)(KT + (16 * sg + fr) * 144 + 64 + 16 * fq);
    bf16_t* LOC = (bf16_t*)(p.ws + WS_LOCAL + (RET ? LOCAL_RET_OFF : 0)) + (size_t)it * DV * 128 + (size_t)sg * DV * 16;
#pragma unroll
    for (int vt = 0; vt < DV / 16; ++vt) {
        const bf16x8 b0 = *(const LAS bf16x8*)(VT + (16 * vt + fr) * 144 + 16 * fq), b1 = *(const LAS bf16x8*)(VT + (16 * vt + fr) * 144 + 64 + 16 * fq);
        f32x4 acc = {0.f, 0.f, 0.f, 0.f};
        acc = mfma16(a0, b0, acc); acc = mfma16(a1, b1, acc);
        u32x2 w; w.x = pk2(acc[0], acc[1]); w.y = pk2(acc[2], acc[3]);
        *(u32x2*)(LOC + (16 * vt + fr) * 16 + 4 * fq) = w;
    }
}
template <bool RET>
__device__ __forceinline__ void p3_loop(const Params& p, LAS unsigned char* lds, int nitems) {
    const int sg = __builtin_amdgcn_readfirstlane(threadIdx.x >> 6), lane = threadIdx.x & 63, G = gridDim.x;
    int it = blockIdx.x; if (it >= nitems) return;
    S1Raw<RET> A, B; s1_load<RET>(p, it, sg, lane, A);
    for (;;) {
        int nx = it + G; bool has = nx < nitems;
        if (has) s1_load<RET>(p, nx, sg, lane, B);
        s1_process<RET>(p, lds, it, sg, lane, A);
        if (!has) break;
        it = nx; nx = it + G; has = nx < nitems;
        if (has) s1_load<RET>(p, nx, sg, lane, A);
        s1_process<RET>(p, lds + 65536, it, sg, lane, B);
        if (!has) break;
        it = nx;
    }
}
__device__ __forceinline__ void p3_local(const Params& p, LAS unsigned char* lds) {
    p3_loop<true>(p, lds, 2 * 4 * NCH);
    __syncthreads();
    p3_loop<false>(p, lds, 2 * 8 * NCH);
}
__device__ __forceinline__ void p4_scan(const Params& p) {
    const int NTOT = 131072;
    for (int e = blockIdx.x * NTHREADS + threadIdx.x; e < NTOT; e += gridDim.x * NTHREADS) {
        const bool ret = e >= 65536; const int e2 = ret ? e - 65536 : e;
        const int dh = ret ? e2 >> 13 : e2 >> 12; const int rem = ret ? e2 & 8191 : e2 & 4095;
        const int DV = ret ? 256 : 128; const int off = rem * 4; const int k = (off / (DV * 16)) * 16 + (off & 15);
        const int dir = ret ? dh >> 2 : dh >> 3;
        const bf16_t* loc = (const bf16_t*)(p.ws + WS_LOCAL + (ret ? LOCAL_RET_OFF : 0)) + (size_t)dh * NCH * DV * 128 + off;
        const float* dec = (const float*)(p.ws + WS_DEC) + (size_t)((ret ? DEC_RET_ITEM0 : 0) + dh * NCH) * 128 + k;
        bf16_t* sst = (bf16_t*)(p.ws + WS_SST + (ret ? SST_RET_OFF : 0)) + (size_t)dh * NXCH * DV * 128 + off;
        const size_t cstride = (size_t)DV * 128;
        f32x4 S = {0.f, 0.f, 0.f, 0.f};
        for (int i0 = 0; i0 < NCH; i0 += 12) {
            u32x2 lw[12]; f32x4 dc[12]; int ccs[12];
#pragma unroll
            for (int j = 0; j < 12; ++j) { const int i = i0 + j; const int cc = dir ? (i < NCCH ? NCCH - 1 - i : NCH + NCCH - 1 - i) : i; ccs[j] = cc;
                lw[j] = __builtin_nontemporal_load((const u32x2*)(loc + (size_t)cc * cstride)); dc[j] = *(const f32x4*)(dec + (size_t)cc * 128); }
#pragma unroll
            for (int j = 0; j < 12; ++j) {
                if (ccs[j] >= NCCH) { u32x2 w; w.x = pk2(S[0], S[1]); w.y = pk2(S[2], S[3]); *(u32x2*)(sst + (size_t)(ccs[j] - NCCH) * cstride) = w; }
                const f32x4 l = {bflo(lw[j].x), bfhi(lw[j].x), bflo(lw[j].y), bfhi(lw[j].y)};
                S = (S + l) * dc[j];
            }
        }
    }
}
template <bool RET>
__device__ __forceinline__ void s3_item(const Params& p, LAS unsigned char* lds, int h, int xc) {
    constexpr int DV = RET ? 256 : 128, NVW = DV / 128;
    const int tid = threadIdx.x, sg = __builtin_amdgcn_readfirstlane(tid >> 6), lane = tid & 63, kp = lane, fr = lane & 15, fq = lane >> 4;
    LAS unsigned char* QF = lds; LAS unsigned char* QB = lds + 17408; LAS unsigned char* KF = lds + 2 * 17408; LAS unsigned char* KB = lds + 3 * 17408;
    LAS unsigned char* VT = lds + 69632;
    LAS unsigned char* PP = lds + 106496;
    LAS float* TOT = (LAS float*)(lds + 115712);
    LAS float* RS = (LAS float*)(lds + 123904);
    const size_t row0 = (size_t)CTXL + (size_t)xc * 64;
    const bf16_t* SF = (const bf16_t*)(p.ws + WS_SST + (RET ? SST_RET_OFF : 0)) + ((size_t)(0 * (RET ? 4 : 8) + h) * NXCH + xc) * DV * 128;
    const bf16_t* SB = (const bf16_t*)(p.ws + WS_SST + (RET ? SST_RET_OFF : 0)) + ((size_t)(1 * (RET ? 4 : 8) + h) * NXCH + xc) * DV * 128;
    bf16x8 sf[NVW][4], sb[NVW][4];
#pragma unroll
    for (int vi = 0; vi < NVW; ++vi)
#pragma unroll
        for (int ks = 0; ks < 4; ++ks) { const size_t o = ((size_t)(2 * ks + (fq >> 1)) * DV + 16 * (sg * NVW + vi) + fr) * 16 + 8 * (fq & 1);
            sf[vi][ks] = *(const bf16x8*)(SF + o); sb[vi][ks] = *(const bf16x8*)(SB + o); }
    const bf16_t* GT = (const bf16_t*)(p.ws + (RET ? WS_RGATE : WS_HGATE)) + (row0 + fr) * 1024 + h * DV + 4 * fq;
    u32x2 gtv[4][NVW]; f32x4 nwv[NVW];
#pragma unroll
    for (int vi = 0; vi < NVW; ++vi) { nwv[vi] = *(const f32x4*)((RET ? p.ret_nw : p.hg_nw) + h * DV + 16 * (sg * NVW + vi) + 4 * fq);
#pragma unroll
        for (int tt = 0; tt < 4; ++tt) gtv[tt][vi] = *(const u32x2*)(GT + (size_t)(16 * tt) * 1024 + 16 * (sg * NVW + vi)); }
    if (!RET) {
        const float* GFp = (const float*)(p.ws + WS_GF) + (row0 + 8 * sg) * 1024 + h * 128 + 2 * kp;
        const float* GBp = (const float*)(p.ws + WS_GB) + (row0 + 8 * sg) * 1024 + h * 128 + 2 * kp;
        const bf16_t* Qp = (const bf16_t*)(p.ws + WS_Q) + (row0 + 8 * sg) * 1024 + h * 128 + 2 * kp;
        const bf16_t* V = (const bf16_t*)(p.ws + WS_V) + (row0 + 8 * sg) * 1024 + h * 128 + 2 * lane;
        f32x2 gf[8], gb[8], cf[8], cb[8]; unsigned qw[8], vw[8];
#pragma unroll
        for (int i = 0; i < 8; ++i) { gf[i] = *(const f32x2*)(GFp + (size_t)i * 1024); gb[i] = *(const f32x2*)(GBp + (size_t)i * 1024); qw[i] = *(const unsigned*)(Qp + (size_t)i * 1024); vw[i] = *(const unsigned*)(V + (size_t)i * 1024); }
        cf[0] = gf[0]; cb[0] = gb[0];
#pragma unroll
        for (int i = 1; i < 8; ++i) { cf[i] = cf[i - 1] + gf[i]; cb[i] = cb[i - 1] + gb[i]; }
        *(LAS f32x2*)(TOT + sg * 128 + 2 * kp) = cf[7]; *(LAS f32x2*)(TOT + 1024 + sg * 128 + 2 * kp) = cb[7];
        vt_write2(VT, vw, lane, sg);
        __syncthreads();
        f32x2 pf = {0.f, 0.f}, pb = {0.f, 0.f}, Tb = {0.f, 0.f};
#pragma unroll
        for (int s8 = 0; s8 < 8; ++s8) { const f32x2 t = *(const LAS f32x2*)(TOT + s8 * 128 + 2 * kp), t2 = *(const LAS f32x2*)(TOT + 1024 + s8 * 128 + 2 * kp);
            if (s8 < sg) { pf += t; pb += t2; } Tb += t2; }
#pragma unroll
        for (int i = 0; i < 8; ++i) {
            const f32x2 bf = pf + cf[i]; const f32x2 bb = Tb - (pb + cb[i]) + gb[i];
            const float qx = bflo(qw[i]), qy = bfhi(qw[i]); const int s = 8 * sg + i;
            *(LAS unsigned*)(QF + s * 272 + kp * 4) = pk2(qx * __expf(bf.x), qy * __expf(bf.y));
            *(LAS unsigned*)(KF + s * 272 + kp * 4) = pk2((1.f - __expf(gf[i].x)) * __expf(-bf.x), (1.f - __expf(gf[i].y)) * __expf(-bf.y));
            *(LAS unsigned*)(QB + s * 272 + kp * 4) = pk2(qx * __expf(bb.x), qy * __expf(bb.y));
            *(LAS unsigned*)(KB + s * 272 + kp * 4) = pk2((1.f - __expf(gb[i].x)) * __expf(-bb.x), (1.f - __expf(gb[i].y)) * __expf(-bb.y));
        }
    } else {
        const bf16_t* Qp = (const bf16_t*)(p.ws + WS_RQ) + (row0 + 8 * sg) * 512 + h * 128 + 2 * kp;
        const bf16_t* Kp = (const bf16_t*)(p.ws + WS_RK) + (row0 + 8 * sg) * 512 + h * 128 + 2 * kp;
        const bf16_t* V = (const bf16_t*)(p.ws + WS_RV) + (row0 + 8 * sg) * 1024 + h * 256 + 4 * lane;
        const float lgf = log_sigmoid_f(p.ret_dl[h]), lgb = log_sigmoid_f(p.ret_dl[4 + h]);
        unsigned qw[8], kw[8]; u32x2 vw[8];
#pragma unroll
        for (int i = 0; i < 8; ++i) { qw[i] = *(const unsigned*)(Qp + (size_t)i * 512); kw[i] = *(const unsigned*)(Kp + (size_t)i * 512); vw[i] = *(const u32x2*)(V + (size_t)i * 1024); }
        vt_write4(VT, vw, lane, sg);
#pragma unroll
        for (int i = 0; i < 8; ++i) {
            const int s = 8 * sg + i;
            const float bf = (float)(s + 1) * lgf, bb = (float)(64 - s) * lgb;
            const float ef = __expf(bf), eb = __expf(bb), nf = __expf(-bf), nb = __expf(-bb);
            *(LAS unsigned*)(QF + s * 272 + kp * 4) = pk2(bflo(qw[i]) * ef, bfhi(qw[i]) * ef);
            *(LAS unsigned*)(KF + s * 272 + kp * 4) = pk2(bflo(kw[i]) * nf, bfhi(kw[i]) * nf);
            *(LAS unsigned*)(QB + s * 272 + kp * 4) = pk2(bflo(qw[i]) * eb, bfhi(qw[i]) * eb);
            *(LAS unsigned*)(KB + s * 272 + kp * 4) = pk2(bflo(kw[i]) * nb, bfhi(kw[i]) * nb);
        }
    }
    __syncthreads();
    {
        const int tt = sg >> 1;
#pragma unroll
        for (int sti = 0; sti < 2; ++sti) {
            const int st = (sg & 1) * 2 + sti;
            f32x4 af = {0.f, 0.f, 0.f, 0.f}, ab = {0.f, 0.f, 0.f, 0.f};
            if (st <= tt) {
#pragma unroll
                for (int ks = 0; ks < 4; ++ks) { const bf16x8 a = *(const LAS bf16x8*)(KF + (16 * st + fr) * 272 + ks * 64 + 16 * fq), b = *(const LAS bf16x8*)(QF + (16 * tt + fr) * 272 + ks * 64 + 16 * fq); af = mfma16(a, b, af); }
            }
            if (st >= tt) {
#pragma unroll
                for (int ks = 0; ks < 4; ++ks) { const bf16x8 a = *(const LAS bf16x8*)(KB + (16 * st + fr) * 272 + ks * 64 + 16 * fq), b = *(const LAS bf16x8*)(QB + (16 * tt + fr) * 272 + ks * 64 + 16 * fq); ab = mfma16(a, b, ab); }
            }
            f32x4 r;
#pragma unroll
            for (int j = 0; j < 4; ++j) { const int sl = 16 * st + 4 * fq + j, tl = 16 * tt + fr; r[j] = (sl <= tl ? af[j] : 0.f) + (sl >= tl ? ab[j] : 0.f); }
            u32x2 w; w.x = pk2(r[0], r[1]); w.y = pk2(r[2], r[3]);
            *(LAS u32x2*)(PP + (16 * tt + fr) * 144 + (16 * st + 4 * fq) * 2) = w;
        }
    }
    __syncthreads();
    f32x4 o[4][NVW];
#pragma unroll
    for (int tt = 0; tt < 4; ++tt) {
        bf16x8 pb[2], qfb[4], qbb[4];
#pragma unroll
        for (int ks = 0; ks < 2; ++ks) pb[ks] = *(const LAS bf16x8*)(PP + (16 * tt + fr) * 144 + ks * 64 + 16 * fq);
#pragma unroll
        for (int ks = 0; ks < 4; ++ks) { qfb[ks] = *(const LAS bf16x8*)(QF + (16 * tt + fr) * 272 + ks * 64 + 16 * fq); qbb[ks] = *(const LAS bf16x8*)(QB + (16 * tt + fr) * 272 + ks * 64 + 16 * fq); }
        float ss = 0.f;
#pragma unroll
        for (int vi = 0; vi < NVW; ++vi) {
            const int vt = sg * NVW + vi; f32x4 acc = {0.f, 0.f, 0.f, 0.f};
#pragma unroll
            for (int ks = 0; ks < 2; ++ks) { const bf16x8 a = *(const LAS bf16x8*)(VT + (16 * vt + fr) * 144 + ks * 64 + 16 * fq); acc = mfma16(a, pb[ks], acc); }
#pragma unroll
            for (int ks = 0; ks < 4; ++ks) acc = mfma16(sf[vi][ks], qfb[ks], acc);
#pragma unroll
            for (int ks = 0; ks < 4; ++ks) acc = mfma16(sb[vi][ks], qbb[ks], acc);
            o[tt][vi] = acc; ss += (acc[0] * acc[0] + acc[1] * acc[1]) + (acc[2] * acc[2] + acc[3] * acc[3]);
        }
        ss += __shfl_xor(ss, 16); ss += __shfl_xor(ss, 32);
        if (fq == 0) RS[sg * 64 + 16 * tt + fr] = ss;
    }
    __syncthreads();
    bf16_t* PO = (bf16_t*)(p.ws + WS_PREOUT) + ((size_t)xc * 64 + fr) * DM + (RET ? 1024 : 0) + h * DV + 4 * fq;
#pragma unroll
    for (int tt = 0; tt < 4; ++tt) {
        float tot = 0.f;
#pragma unroll
        for (int w8 = 0; w8 < 8; ++w8) tot += RS[w8 * 64 + 16 * tt + fr];
        const float rstd = rsqrtf(tot * (1.f / DV) + EPS);
#pragma unroll
        for (int vi = 0; vi < NVW; ++vi) {
            const u32x2 gw = gtv[tt][vi]; const f32x4 nw = nwv[vi]; const f32x4 a = o[tt][vi];
            u32x2 w; w.x = pk2(a[0] * rstd * nw[0] * bflo(gw.x), a[1] * rstd * nw[1] * bfhi(gw.x)); w.y = pk2(a[2] * rstd * nw[2] * bflo(gw.y), a[3] * rstd * nw[3] * bfhi(gw.y));
            *(u32x2*)(PO + (size_t)(16 * tt) * DM + 16 * (sg * NVW + vi)) = w;
        }
    }
    __syncthreads();
}
__device__ __forceinline__ void p5_out(const Params& p, LAS unsigned char* lds) {
    constexpr int NR = 4 * NXCH, NH = 8 * NXCH;
    for (int it = blockIdx.x; it < NR + NH; it += gridDim.x) {
        if (it < NR) s3_item<true>(p, lds, it / NXCH, it % NXCH);
        else { const int r = it - NR; s3_item<false>(p, lds, r / NXCH, r % NXCH); }
    }
}

__device__ __forceinline__ void p7_norm_route(const Params& p, LAS unsigned char* lds) {
    const int tid = threadIdx.x, wave = tid >> 6, lane = tid & 63;
    LAS float* G1 = (LAS float*)lds; LAS float* SH2 = G1 + 2048; LAS float* SC2 = SH2 + 2048; LAS int* CNTL = (LAS int*)(SC2 + 2048);
    mod_reduce_to_lds(p, G1, 4096, 2048, false); mod_reduce_to_lds(p, SH2, 6144, 2048, false); mod_reduce_to_lds(p, SC2, 8192, 2048, false);
    const float* OX = (const float*)(p.ws + WS_OUTX); bf16_t* HX2 = (bf16_t*)(p.ws + WS_HX2);
    const float* WR = (const float*)(p.ws + WS_CTL + CTL_WR);
    int* CNT = (int*)(p.ws + WS_CTL + CTL_CNT); f32x4* ROUTE = (f32x4*)(p.ws + WS_CTL + CTL_ROUTE);
    for (int grp = blockIdx.x; grp < NGRP; grp += gridDim.x) {
        if (tid < 32) CNTL[tid] = 0;
        __syncthreads();
        LAS float* LG = (LAS float*)(lds + 32768) + wave * 160;
        const float* WRl = WR + 4 * lane;
#pragma unroll 1
        for (int half = 0; half < 2; ++half) {
            f32x4 hv[2][8];
#pragma unroll
            for (int r = 0; r < 2; ++r) {
                const int t = grp * 32 + wave * 4 + half * 2 + r;
                f32x4 ov[8]; float ss = 0.f;
#pragma unroll
                for (int j = 0; j < 8; ++j) { ov[j] = *(const f32x4*)(OX + (size_t)t * DM + 4 * (lane + 64 * j)); ss += (ov[j][0] * ov[j][0] + ov[j][1] * ov[j][1]) + (ov[j][2] * ov[j][2] + ov[j][3] * ov[j][3]); }
                const float rstd = rsqrtf(wave_sum(ss) * (1.f / DM) + EPS); float ss2 = 0.f;
#pragma unroll
                for (int j = 0; j < 8; ++j) { const int col = 4 * (lane + 64 * j);
                    const f32x4 xv = *(const f32x4*)(p.x + (size_t)t * DM + col), nw = *(const f32x4*)(p.norm_w + DM + col), g1 = *(const LAS f32x4*)(G1 + col);
                    const f32x4 x1 = xv + g1 * (ov[j] * rstd * nw);
                    *(f32x4*)(p.out + (size_t)t * DM + col) = x1; hv[r][j] = x1;
                    ss2 += (x1[0] * x1[0] + x1[1] * x1[1]) + (x1[2] * x1[2] + x1[3] * x1[3]); }
                const float rstd2 = rsqrtf(wave_sum(ss2) * (1.f / DM) + EPS);
#pragma unroll
                for (int j = 0; j < 8; ++j) { const int col = 4 * (lane + 64 * j);
                    const f32x4 nw = *(const f32x4*)(p.norm_w + 2 * DM + col), a = *(const LAS f32x4*)(SC2 + col), b = *(const LAS f32x4*)(SH2 + col);
                    const f32x4 hx = (hv[r][j] * rstd2 * nw) * (a + 1.f) + b; hv[r][j] = hx;
                    u32x2 w; w.x = pk2(hx[0], hx[1]); w.y = pk2(hx[2], hx[3]); *(u32x2*)(HX2 + (size_t)t * DM + col) = w; }
            }
#define P7_LOADW(dst, o) do { _Pragma("unroll") for (int j = 0; j < 8; ++j) dst[j] = *(const f32x4*)(WRl + (o) * 2048 + 256 * j); } while (0)
#define P7_DOT(wv, o) do { float a0 = 0.f, a1 = 0.f; \
                _Pragma("unroll") for (int j = 0; j < 8; ++j) { const f32x4 w = wv[j]; \
                    a0 += (hv[0][j][0] * w[0] + hv[0][j][1] * w[1]) + (hv[0][j][2] * w[2] + hv[0][j][3] * w[3]); \
                    a1 += (hv[1][j][0] * w[0] + hv[1][j][1] * w[1]) + (hv[1][j][2] * w[2] + hv[1][j][3] * w[3]); } \
                const bool b0 = (lane & 1) != 0; \
                float z = b0 ? a1 : a0, sn = b0 ? a0 : a1; z += __shfl_xor(sn, 1); \
                z += __shfl_xor(z, 2); z += __shfl_xor(z, 4); z += __shfl_xor(z, 8); z += __shfl_xor(z, 16); z += __shfl_xor(z, 32); \
                if (lane < 2) LG[(half * 2 + lane) * 40 + (o)] = z; } while (0)
            f32x4 wa[8], wb[8];
            P7_LOADW(wa, 0);
#pragma unroll 1
            for (int o = 0; o < 36; o += 2) {
                P7_LOADW(wb, o + 1);
                P7_DOT(wa, o);
                if (o + 2 < 36) P7_LOADW(wa, o + 2);
                P7_DOT(wb, o + 1);
            }
#undef P7_LOADW
#undef P7_DOT
        }
        {
            LDS_WAIT(); asm volatile("" ::: "memory");
            const LAS float* Lr = LG + (lane & 3) * 40;
            const float L0 = Lr[0] + p.rgb[0], L1 = Lr[1] + p.rgb[1], L2 = Lr[2] + p.rgb[2], L3 = Lr[3] + p.rgb[3];
            int grpi = 0; float gmax = L0;
            if (L1 > gmax) { gmax = L1; grpi = 1; }
            if (L2 > gmax) { gmax = L2; grpi = 2; }
            if (L3 > gmax) { gmax = L3; grpi = 3; }
            const float psel = 1.f / ((__expf(L0 - gmax) + __expf(L1 - gmax)) + (__expf(L2 - gmax) + __expf(L3 - gmax)));
            float le[8];
#pragma unroll
            for (int j = 0; j < 8; ++j) le[j] = Lr[4 + grpi * 8 + j] + p.reb[grpi * 8 + j];
            int i1 = 0; float v1 = le[0];
#pragma unroll
            for (int j = 1; j < 8; ++j) if (le[j] > v1) { v1 = le[j]; i1 = j; }
            int i2 = -1; float v2 = -3.0e38f;
#pragma unroll
            for (int j = 0; j < 8; ++j) if (j != i1 && le[j] > v2) { v2 = le[j]; i2 = j; }
            const float e2 = __expf(v2 - v1); const float ga = psel / (1.f + e2), gb2 = psel * e2 / (1.f + e2);
            if (lane < 4) {
                const int t = grp * 32 + wave * 4 + lane; const int ea = grpi * 8 + i1, eb = grpi * 8 + i2;
                f32x4 rt; rt[0] = __builtin_bit_cast(float, ea); rt[1] = __builtin_bit_cast(float, eb); rt[2] = ga; rt[3] = gb2; ROUTE[t] = rt;
                atomicAdd((int*)&CNTL[ea], 1); atomicAdd((int*)&CNTL[eb], 1);
            }
        }
        __syncthreads();
        if (tid < 32) CNT[grp * 32 + tid] = CNTL[tid];
        __syncthreads();
    }
}
__device__ __forceinline__ void p8_slots(const Params& p, LAS unsigned char* lds) {
    const int tid = threadIdx.x, wave = tid >> 6, lane = tid & 63;
    LAS int* PT = (LAS int*)lds;
    LAS int* PP = PT + 512;
    LAS int* TOTE = PP + 512;
    LAS int* BASE = TOTE + 32;
    LAS int* SLOTL = BASE + 32;
    const int* CNT = (const int*)(p.ws + WS_CTL + CTL_CNT); const f32x4* ROUTE = (const f32x4*)(p.ws + WS_CTL + CTL_ROUTE);
    int* SLOT = (int*)(p.ws + WS_CTL + CTL_SLOT); int* TILES = (int*)(p.ws + WS_CTL + CTL_TILES);
    const bf16_t* HX2 = (const bf16_t*)(p.ws + WS_HX2); bf16_t* XS = (bf16_t*)(p.ws + WS_XS);
    for (int grp = blockIdx.x; grp < NGRP; grp += gridDim.x) {
        { const int e = tid & 31, part = tid >> 5; int t = 0, pr = 0;
          for (int g = part * 16; g < part * 16 + 16; ++g) { const int c = CNT[g * 32 + e]; t += c; if (g < grp) pr += c; }
          PT[part * 32 + e] = t; PP[part * 32 + e] = pr; }
        __syncthreads();
        if (tid < 32) { int t = 0, pr = 0; for (int q = 0; q < 16; ++q) { t += PT[q * 32 + tid]; pr += PP[q * 32 + tid]; } TOTE[tid] = t; BASE[tid] = pr; }
        __syncthreads();
        if (tid == 0) { int st = 0; for (int e = 0; e < 32; ++e) { const int t = TOTE[e]; BASE[e] += st;
                if (grp == 0) { const int nt = (t + 255) >> 8; for (int q = 0; q < nt; ++q) TILES[1 + (st >> 8) + q] = e; }
                st += ((t + 255) >> 8) << 8; }
            if (grp == 0) TILES[0] = st >> 8; }
        __syncthreads();
        if (wave == 0) {
            const int t = grp * 32 + (lane >> 1); const f32x4 rt = ROUTE[t]; const int e = __builtin_bit_cast(int, (lane & 1) ? rt[1] : rt[0]);
            int rank = 0; const unsigned long long ltmask = (1ull << lane) - 1ull;
            for (int q = 0; q < 32; ++q) { const unsigned long long m = __ballot(e == q); if (e == q) rank = __popcll(m & ltmask); }
            const int slot = BASE[e] + rank; SLOTL[lane] = slot; SLOT[grp * 64 + lane] = slot;
        }
        __syncthreads();
        for (int a = wave * 8; a < wave * 8 + 8; ++a) {
            const int t = grp * 32 + (a >> 1); const int slot = SLOTL[a];
            const u32x4* src = (const u32x4*)(HX2 + (size_t)t * DM); u32x4* dst = (u32x4*)(XS + (size_t)slot * DM);
#pragma unroll
            for (int j = 0; j < 4; ++j) dst[lane + 64 * j] = src[lane + 64 * j];
        }
        __syncthreads();
    }
}
__device__ __forceinline__ void p11_final(const Params& p, LAS unsigned char* lds) {
    const int tid = threadIdx.x, wave = tid >> 6, lane = tid & 63;
    LAS float* G2 = (LAS float*)lds;
    mod_reduce_to_lds(p, G2, 10240, 2048, false);
    __syncthreads();
    const float* YB = (const float*)(p.ws + WS_YB); const int* SLOT = (const int*)(p.ws + WS_CTL + CTL_SLOT); const f32x4* ROUTE = (const f32x4*)(p.ws + WS_CTL + CTL_ROUTE);
    const int gw = blockIdx.x * NWAVES + wave, NGW = gridDim.x * NWAVES;
    for (int t = gw; t < SEQ; t += NGW) {
        const int sa = SLOT[2 * t], sb = SLOT[2 * t + 1]; const f32x4 rt = ROUTE[t]; const float ga = rt[2], gb = rt[3];
        f32x4 y[8]; float ss = 0.f;
#pragma unroll
        for (int j = 0; j < 8; ++j) { const int col = 4 * (lane + 64 * j);
            const f32x4 ya = *(const f32x4*)(YB + (size_t)sa * DM + col), yb = *(const f32x4*)(YB + (size_t)sb * DM + col);
            y[j] = ya * ga + yb * gb; ss += (y[j][0] * y[j][0] + y[j][1] * y[j][1]) + (y[j][2] * y[j][2] + y[j][3] * y[j][3]); }
        const float rstd = rsqrtf(wave_sum(ss) * (1.f / DM) + EPS);
#pragma unroll
        for (int j = 0; j < 8; ++j) { const int col = 4 * (lane + 64 * j);
            const f32x4 nw = *(const f32x4*)(p.norm_w + 3 * DM + col), g2 = *(const LAS f32x4*)(G2 + col);
            f32x4* op = (f32x4*)(p.out + (size_t)t * DM + col); *op = *op + g2 * (y[j] * rstd * nw); }
    }
}

#define XB_TMO      128
#define XB_XCNT(j)  (256  + 64 * (j))
#define XB_XSUB(j)  (1280 + 64 * (j))
#define XB_XGEN(j)  (2304 + 64 * (j))
#define XB_TOP      3328
#define XB_TOPGEN   3392
#define XCD_BAR_WORDS 3456
#define XB_SPIN_CAP (1u << 18)

__device__ __forceinline__ unsigned xb_ld(unsigned* p)              { return __hip_atomic_load(p, __ATOMIC_RELAXED, __HIP_MEMORY_SCOPE_AGENT); }
__device__ __forceinline__ unsigned xb_add(unsigned* p, unsigned v) { return __hip_atomic_fetch_add(p, v, __ATOMIC_RELAXED, __HIP_MEMORY_SCOPE_AGENT); }
__device__ __forceinline__ unsigned xb_xcc_id() { return (unsigned)__builtin_amdgcn_s_getreg((3 << 11) | 20) & 0xFu; }
#define XB_SPIN(cond, bar) do { unsigned _sp = 0; while (cond) { __builtin_amdgcn_s_sleep(1); \
    if ((++_sp & 255u) == 0u) { if (xb_ld(&(bar)[XB_TMO])) break; if (_sp > XB_SPIN_CAP) { atomicAdd(&(bar)[XB_TMO], 1u); break; } } } } while (0)

struct XcdBarrier {
    unsigned* bar; unsigned x;
    volatile LAS unsigned* st;
};

__device__ __forceinline__ XcdBarrier xcd_barrier_post(unsigned* bar, volatile LAS unsigned* st) {
    XcdBarrier b; b.bar = bar; b.x = xb_xcc_id(); b.st = st;
    if (threadIdx.x == 0) (void)xb_add(&bar[XB_XCNT(b.x)], 1u);
    return b;
}
__device__ __forceinline__ void xcd_barrier_complete(unsigned* bar, unsigned x, unsigned& nloc, unsigned& nx) {
    const unsigned G = gridDim.x * gridDim.y * gridDim.z;
    unsigned sum, cnt, mine, sp = 0u;
    for (;;) {
        sum = 0u; cnt = 0u; mine = 0u;
#pragma unroll
        for (unsigned j = 0; j < 16; ++j) { const unsigned c = xb_ld(&bar[XB_XCNT(j)]); sum += c; cnt += (c > 0u) ? 1u : 0u; mine = (j == x) ? c : mine; }
        if (sum == G) break;
        __builtin_amdgcn_s_sleep(1);
        if ((++sp & 255u) == 0u) { if (xb_ld(&bar[XB_TMO])) break; if (sp > XB_SPIN_CAP) { atomicAdd(&bar[XB_TMO], 1u); break; } }
    }
    nloc = mine > 0u ? mine : 1u; nx = cnt > 0u ? cnt : 1u;
}

__device__ __forceinline__ void xcd_barrier(const XcdBarrier& b) {
    asm volatile("s_waitcnt vmcnt(0)" ::: "memory");
    __syncthreads();
    if (threadIdx.x == 0) {
        unsigned* bar = b.bar;
        __builtin_amdgcn_s_waitcnt(0);
        unsigned nloc = b.st[0], nx = b.st[1];
        if (nloc == 0u) { xcd_barrier_complete(bar, b.x, nloc, nx); b.st[0] = nloc; b.st[1] = nx; }
        const unsigned old = xb_add(&bar[XB_XSUB(b.x)], 1u);
        const unsigned gen = old / nloc;
        if (old + 1u == (gen + 1u) * nloc) {
            __builtin_amdgcn_fence(__ATOMIC_RELEASE, "agent");
            asm volatile("s_waitcnt vmcnt(0)" ::: "memory");
            const unsigned og = xb_add(&bar[XB_TOP], 1u);
            const unsigned tg = og / nx;
            if (og + 1u == (tg + 1u) * nx) xb_add(&bar[XB_TOPGEN], 1u);
            else XB_SPIN(xb_ld(&bar[XB_TOPGEN]) == tg, bar);
            __builtin_amdgcn_fence(__ATOMIC_ACQUIRE, "agent");
            xb_add(&bar[XB_XGEN(b.x)], 1u);
            asm volatile("s_waitcnt vmcnt(0)" ::: "memory");
        } else {
            XB_SPIN(xb_ld(&bar[XB_XGEN(b.x)]) == gen, bar);
            __builtin_amdgcn_fence(__ATOMIC_ACQUIRE, "agent");
            asm volatile("s_waitcnt vmcnt(0)" ::: "memory");
        }
    }
    __syncthreads();
}

constexpr int NPHASE = 12;
__global__ void __launch_bounds__(NTHREADS, 2) fwd_kernel(Params p) {
    extern __shared__ __attribute__((aligned(16))) unsigned char lds_raw[];
    LAS unsigned char* lds = (LAS unsigned char*)lds_raw;
    cg::grid_group grid = cg::this_grid();
    const int lo = p.ph_lo, hi = p.ph_hi;
    volatile LAS unsigned* MISC = (volatile LAS unsigned*)(lds + MISC_OFF);
    if (threadIdx.x < 64) MISC[threadIdx.x] = 0u;
    __syncthreads();
    XcdBarrier bar; bar.bar = (unsigned*)(p.ws + WS_CTL + CTL_BAR); bar.x = 0; bar.st = nullptr;
    if (hi - lo > 1) bar = xcd_barrier_post((unsigned*)(p.ws + WS_CTL + CTL_BAR), MISC + 8);
    if (lo < 0) grid.sync();
    const int G = gridDim.x, bx = blockIdx.x;
    const int vcu = (G % 8 == 0) ? (bx % 8) * (G / 8) + bx / 8 : bx;
#ifndef PHM
#define PHM 0xfff
#endif
#define IN(k) (((PHM >> (k)) & 1) && lo <= (k) && (k) < hi)
#ifndef REPM
#define REPM 0
#endif
#define SEAM(k) do { if (IN(k) && IN((k) + 1)) xcd_barrier(bar); } while (0)
    if (IN(0)) for (int rep_ = 0; rep_ <= ((REPM >> 0) & 1); ++rep_) { if (rep_) xcd_barrier(bar); p0_prologue(p, lds); } SEAM(0);
    if (IN(1)) for (int rep_ = 0; rep_ <= ((REPM >> 1) & 1); ++rep_) { if (rep_) xcd_barrier(bar); p1_hrows(p, lds); } SEAM(1);
    if (IN(2)) for (int rep_ = 0; rep_ <= ((REPM >> 2) & 1); ++rep_) { if (rep_) xcd_barrier(bar);
        pg8::Gemm g{(const bf16_t*)(p.ws + WS_H), (const bf16_t*)(p.ws + WS_WTIN), MT, PW, DM}; pg8::StaticOrder S; S.init(MT, PW, G, bx);
        EpiProj E{p.ws};
        const bool convfirst = ((bx >> 3) & 1) == 0;
#pragma unroll 1
        for (int step = 0; step < 2; ++step) {
            if ((step == 0) == convfirst) p2_convert(p, lds, bx, G);
            else pg8::gemm_phase<EpiProj, pg8::StaticOrder, true, true>(lds, g, S, E);
            __syncthreads();
        }
    } SEAM(2);
    if (IN(3)) for (int rep_ = 0; rep_ <= ((REPM >> 3) & 1); ++rep_) { if (rep_) xcd_barrier(bar); p3_local(p, lds); } SEAM(3);
    if (IN(4)) for (int rep_ = 0; rep_ <= ((REPM >> 4) & 1); ++rep_) { if (rep_) xcd_barrier(bar); p4_scan(p); } SEAM(4);
    if (IN(5)) for (int rep_ = 0; rep_ <= ((REPM >> 5) & 1); ++rep_) { if (rep_) xcd_barrier(bar); p5_out(p, lds); } SEAM(5);
    if (IN(6)) for (int rep_ = 0; rep_ <= ((REPM >> 6) & 1); ++rep_) { if (rep_) xcd_barrier(bar);
        pg8::Gemm g{(const bf16_t*)(p.ws + WS_PREOUT), (const bf16_t*)(p.ws + WS_WTOUT), SEQ, DM, DM}; pg8::StaticOrder S; S.init(SEQ, DM, G, bx);
        EpiF32 E{(float*)(p.ws + WS_OUTX), DM};
        pg8::gemm_phase<EpiF32, pg8::StaticOrder, true, true>(lds, g, S, E);
    } SEAM(6);
    if (IN(7)) for (int rep_ = 0; rep_ <= ((REPM >> 7) & 1); ++rep_) { if (rep_) xcd_barrier(bar); p7_norm_route(p, lds); } SEAM(7);
    if (IN(8)) for (int rep_ = 0; rep_ <= ((REPM >> 8) & 1); ++rep_) { if (rep_) xcd_barrier(bar); p8_slots(p, lds); } SEAM(8);
    if (IN(9)) for (int rep_ = 0; rep_ <= ((REPM >> 9) & 1); ++rep_) { if (rep_) xcd_barrier(bar);
        pg8::Gemm g{(const bf16_t*)(p.ws + WS_XS), (const bf16_t*)(p.ws + WS_WTGU), 0, 0, DM}; MoeOrder S{(const int*)(p.ws + WS_CTL + CTL_TILES), G, vcu};
        EpiGateUp E{(bf16_t*)(p.ws + WS_GACT)};
        pg8::gemm_phase<EpiGateUp, MoeOrder, true, true>(lds, g, S, E);
    } SEAM(9);
    if (IN(10)) for (int rep_ = 0; rep_ <= ((REPM >> 10) & 1); ++rep_) { if (rep_) xcd_barrier(bar);
        pg8::Gemm g{(const bf16_t*)(p.ws + WS_GACT), (const bf16_t*)(p.ws + WS_WTD), 0, 0, DE}; MoeOrder S{(const int*)(p.ws + WS_CTL + CTL_TILES), G, vcu};
        EpiF32 E{(float*)(p.ws + WS_YB), DM};
        pg8::gemm_phase<EpiF32, MoeOrder, true, true>(lds, g, S, E);
    } SEAM(10);
    if (IN(11)) for (int rep_ = 0; rep_ <= ((REPM >> 11) & 1); ++rep_) { if (rep_) xcd_barrier(bar); p11_final(p, lds); }
#undef IN
#undef SEAM
}

#ifndef MK_ONE_LAUNCH
#define MK_ONE_LAUNCH 1
#endif
extern "C" void kernel_launch(void* const* d_in, const int* in_sizes, int n_in, void* d_out, int out_size, void* d_ws, size_t ws_size, hipStream_t stream) {
    static int grid = 0;
    if (grid == 0) {
        if (n_in != 20 || ws_size < WS_END) { fprintf(stderr, "kernel_launch: unexpected n_in %d or ws_size %zu (< %zu)\n", n_in, ws_size, (size_t)WS_END); grid = -1; return; }
        int dev = 0, cus = 0, per_cu = 0;
        if (hipGetDevice(&dev) != hipSuccess || hipDeviceGetAttribute(&cus, hipDeviceAttributeMultiprocessorCount, dev) != hipSuccess) { grid = -1; return; }
        if (hipFuncSetAttribute((const void*)fwd_kernel, hipFuncAttributeMaxDynamicSharedMemorySize, LDS_BYTES) != hipSuccess) { fprintf(stderr, "kernel_launch: hipFuncSetAttribute failed\n"); grid = -1; return; }
        if (hipOccupancyMaxActiveBlocksPerMultiprocessor(&per_cu, (const void*)fwd_kernel, NTHREADS, LDS_BYTES) != hipSuccess || per_cu < 1) { fprintf(stderr, "kernel_launch: occupancy query says %d blocks per CU\n", per_cu); (void)hipGetLastError(); grid = -1; return; }
        grid = cus;
    }
    if (grid < 0) return;
    Params p{};
    const float* const* in = (const float* const*)d_in;
    p.x = in[0]; p.c = in[1]; p.ctx = in[2]; p.c_ctx = in[3]; p.w_mod = in[4]; p.b_mod = in[5]; p.norm_w = in[6]; p.w_in = in[7]; p.hg_lb = in[8]; p.hg_nw = in[9];
    p.ret_dl = in[10]; p.ret_nw = in[11]; p.w_out = in[12]; p.rgw = in[13]; p.rgb = in[14]; p.rew = in[15]; p.reb = in[16]; p.w_gate = in[17]; p.w_up = in[18]; p.w_down = in[19];
    p.out = (float*)d_out; p.ws = (unsigned char*)d_ws;
#if MK_ONE_LAUNCH
    (void)hipMemsetAsync((char*)d_ws + WS_CTL + CTL_BAR, 0, XCD_BAR_WORDS * 4, stream);
    p.ph_lo = 0; p.ph_hi = NPHASE;
    void* args[] = {&p};
    hipError_t e = hipLaunchCooperativeKernel((const void*)fwd_kernel, dim3(grid), dim3(NTHREADS), args, LDS_BYTES, stream);
    if (e != hipSuccess) fprintf(stderr, "cooperative launch failed: %s (grid %d)\n", hipGetErrorString(e), grid);
#else
    for (int k = 0; k < NPHASE; ++k) { p.ph_lo = k; p.ph_hi = k + 1; hipLaunchKernelGGL(fwd_kernel, dim3(grid), dim3(NTHREADS), LDS_BYTES, stream, p); }
#endif
}
```

```cpp
#include <hip/hip_runtime.h>
#include <hip/hip_cooperative_groups.h>
#include <cstdio>
#include <cstdint>
namespace cg = cooperative_groups;

namespace pg8 {
#define PG8_LAS __attribute__((address_space(3)))
typedef unsigned short bf16_t;
typedef short bf16x8 __attribute__((ext_vector_type(8)));
typedef float f32x4 __attribute__((ext_vector_type(4)));
typedef unsigned u32x4 __attribute__((ext_vector_type(4)));
constexpr int BM = 256, BK = 64, HALF = 128, HTB = HALF * BK * 2  , STAGE_BYTES = 8 * HTB, NXCD = 8, WGM = 8;

__host__ __device__ __forceinline__ int lds_byte(int r, int c) { const int st = (r >> 4) * 2 + (c >> 5), rr = r & 15, cc = c & 31, ob = rr * 64 + cc * 2; return st * 1024 + (ob ^ (((ob >> 9) & 1) << 5)); }
__host__ __device__ __forceinline__ void stage_rc(int b, int& R, int& C) { const int st = b / 1024, sb = b % 1024, swz = sb ^ (((sb >> 9) & 1) << 5); R = (st >> 1) * 16 + swz / 64; C = (st & 1) * 32 + (swz % 64) / 2; }
__host__ __device__ __forceinline__ int perm32(int rho) { const int n = rho >> 4, i = rho & 15; return 8 * (i >> 2) + 4 * n + (i & 3); }

struct Unit { int pm, pn, pb; };
struct Gemm { const bf16_t* A; const bf16_t* Bt; int M, N, K; int scaleA, scaleB; };
typedef int v8i_t __attribute__((ext_vector_type(8)));
typedef int v4i_t __attribute__((ext_vector_type(4)));
typedef short s16x16_t __attribute__((ext_vector_type(16)));
__device__ __forceinline__ v8i_t cat8(short __attribute__((ext_vector_type(8))) lo, short __attribute__((ext_vector_type(8))) hi) {
    const v4i_t a = __builtin_bit_cast(v4i_t, lo), b = __builtin_bit_cast(v4i_t, hi); return __builtin_shufflevector(a, b, 0, 1, 2, 3, 4, 5, 6, 7); }

struct StaticOrder {
    int nM, nN, nwg, G, c;
    __host__ __device__ void init(int M, int N, int G_, int c_) { nM = M / BM; nN = N / BM; nwg = nM * nN; G = G_; c = c_; }
    __host__ __device__ bool next(int i, Unit& u) const {
        const long L = (long)i * G + c; if (L >= nwg) return false;
        int wgid = (int)L; { const int q = nwg / NXCD, r = nwg % NXCD, xcd = wgid % NXCD, off = wgid / NXCD; wgid = (xcd < r ? xcd * (q + 1) : r * (q + 1) + (xcd - r) * q) + off; }
        const int nig = WGM * nN, gid = wgid / nig, fm = gid * WGM, gsz = (nM - fm) < WGM ? (nM - fm) : WGM;
        u.pm = fm + ((wgid % nig) % gsz); u.pn = (wgid % nig) / gsz; u.pb = u.pn; return true;
    }
    __device__ __forceinline__ void a_ready(const Unit&) const {}
    __device__ __forceinline__ void done(const Unit&) const {}
};

__device__ __forceinline__ unsigned cvt_pk_bf16(float lo, float hi) { unsigned r; asm volatile("v_cvt_pk_bf16_f32 %0, %1, %2" : "=v"(r) : "v"(lo), "v"(hi)); return r; }
template <class Epi, class Sched, bool ALIGN_EPI = false, bool SP2 = false>
__device__ __forceinline__ void gemm_phase(PG8_LAS unsigned char* lds, const Gemm g, const Sched& S, const Epi& E) {
    const int tid = threadIdx.x, wid = __builtin_amdgcn_readfirstlane(tid >> 6), lane = tid & 63, wr = wid >> 2, wc = wid & 3, fr = lane & 15, fq = lane >> 4;
    const int K = g.K, nt = K / BK;
    unsigned voffA[2], voffB[2];
    { int R, C; stage_rc(tid * 16, R, C); voffA[0] = (unsigned)(R * K + C) * 2u; voffA[1] = 0u; voffB[0] = voffA[0]; voffB[1] = 0u; }
    const size_t istep = (size_t)64 * K * 2;
    const unsigned ldsbase = (unsigned)__builtin_amdgcn_readfirstlane((int)(unsigned)(size_t)lds + (int)((unsigned)wid * 1024u));
    const size_t kstep = (size_t)(BK * 2);
    const size_t hstep = (size_t)HALF * K * 2;
    const size_t tstep = 2 * hstep;
    const unsigned ldsw = (unsigned)wid * 1024u;
    const int aoffk[2] = { Epi::FP8 ? lds_byte(wr * 64 + fr, fq * 16) : lds_byte(wr * 64 + fr, fq * 8), Epi::FP8 ? lds_byte(wr * 64 + fr, fq * 16 + 8) : lds_byte(wr * 64 + fr, fq * 8) + 1024 };
    const int boffk[2] = { Epi::FP8 ? lds_byte(wc * 32 + fr, fq * 16) : lds_byte(wc * 32 + fr, fq * 8), Epi::FP8 ? lds_byte(wc * 32 + fr, fq * 16 + 8) : lds_byte(wc * 32 + fr, fq * 8) + 1024 };
#define PG8_SA(b, h) (((b) * 2 + (h)) * HTB)
#define PG8_SB(b, h) ((4 + (b) * 2 + (h)) * HTB)
#define PG8_STAGE(bufoff, gbase, voff) do { _Pragma("unroll") for (int _i = 0; _i < 2; ++_i) \
        { if constexpr (Epi::FP8) { unsigned keep_; asm volatile("s_mov_b32 %0, m0\n\ts_mov_b32 m0, %2\n\ts_nop 0\n\tglobal_load_lds_dwordx4 %1, off\n\ts_mov_b32 m0, %0" : "=&s"(keep_) : "v"((const char*)(gbase) + _i * istep + (voff)[0]), "s"(ldsbase + (unsigned)((bufoff) + _i * 8192)) : "memory"); } \
          else __builtin_amdgcn_global_load_lds((const unsigned*)((const char*)(gbase) + _i * istep + (voff)[0]), (PG8_LAS unsigned*)(lds + (bufoff) + ldsw + _i * 8192), 16, 0, 0); } } while (0)
#define PG8_LDA(dst, b, h) do { if constexpr (Epi::FP8) { _Pragma("unroll") for (int m = 0; m < 4; ++m) dst##8[m] = *(const PG8_LAS v8i_t*)(lds + PG8_SA(b, h) + aoffk[0] + m * 2048); } \
        else { _Pragma("unroll") for (int m = 0; m < 4; ++m) _Pragma("unroll") for (int k = 0; k < 2; ++k) dst[m][k] = *(const PG8_LAS bf16x8*)(lds + PG8_SA(b, h) + aoffk[k] + m * 2048); } } while (0)
#define PG8_LDB(dst, b, h) do { if constexpr (Epi::FP8) { _Pragma("unroll") for (int n = 0; n < 2; ++n) dst##8[n] = *(const PG8_LAS v8i_t*)(lds + PG8_SB(b, h) + boffk[0] + n * 2048); } \
        else { _Pragma("unroll") for (int n = 0; n < 2; ++n) _Pragma("unroll") for (int k = 0; k < 2; ++k) dst[n][k] = *(const PG8_LAS bf16x8*)(lds + PG8_SB(b, h) + boffk[k] + n * 2048); } } while (0)
#define PG8_MMA(ai, bj, At, Bt) do { __builtin_amdgcn_s_setprio(1); _Pragma("unroll") for (int m = 0; m < 4; ++m) _Pragma("unroll") for (int n = 0; n < 2; ++n) { \
        if constexpr (Epi::FP8) { acc[ai][bj][m][n] = __builtin_amdgcn_mfma_scale_f32_16x16x128_f8f6f4(Bt##8[n], At##8[m], acc[ai][bj][m][n], 0, 0, 1, g.scaleA, 0, g.scaleA); } \
        else { _Pragma("unroll") for (int k = 0; k < 2; ++k) acc[ai][bj][m][n] = __builtin_amdgcn_mfma_f32_16x16x32_bf16(Bt[n][k], At[m][k], acc[ai][bj][m][n], 0, 0, 0); } } \
        __builtin_amdgcn_s_setprio(0); } while (0)
#define PG8_WAIT_V(n) asm volatile("s_waitcnt vmcnt(" #n ")" ::: "memory")
#define PG8_WAIT_L(n) asm volatile("s_waitcnt lgkmcnt(" #n ")" ::: "memory")
#define PG8_BAR __builtin_amdgcn_s_barrier()
#define PG8_SCHED __builtin_amdgcn_sched_barrier(0)
    Unit cur, nxt; int ui = 0;
    if (!S.next(0, cur)) return;
    f32x4 acc[2][2][4][2];
#pragma unroll
    for (int a = 0; a < 2; ++a)
#pragma unroll
        for (int b = 0; b < 2; ++b)
#pragma unroll
            for (int m = 0; m < 4; ++m)
#pragma unroll
                for (int n = 0; n < 2; ++n) acc[a][b][m][n] = (f32x4){0.f, 0.f, 0.f, 0.f};
    bf16x8 At[4][2], B0[2][2], B1[2][2];
    v8i_t At8[4], B08[2], B18[2];
    const char* cA = (const char*)g.A + (size_t)cur.pm * tstep; const char* cB = (const char*)g.Bt + (size_t)cur.pb * tstep;
    S.a_ready(cur);
    if constexpr (SP2) {
        PG8_STAGE(PG8_SB(0, 0), cB, voffB); PG8_STAGE(PG8_SB(0, 1), cB + hstep, voffB); PG8_STAGE(PG8_SA(0, 0), cA, voffA); PG8_STAGE(PG8_SA(0, 1), cA + hstep, voffA);
        if (wr == 1) PG8_BAR;
        PG8_WAIT_V(2); PG8_BAR;
        PG8_STAGE(PG8_SB(1, 0), cB + kstep, voffB); PG8_STAGE(PG8_SA(1, 0), cA + kstep, voffA); PG8_STAGE(PG8_SB(1, 1), cB + hstep + kstep, voffB);
        PG8_WAIT_V(6); PG8_BAR;
    } else {
        PG8_STAGE(PG8_SB(0, 0), cB, voffB); PG8_STAGE(PG8_SA(0, 0), cA, voffA); PG8_STAGE(PG8_SB(0, 1), cB + hstep, voffB); PG8_STAGE(PG8_SA(0, 1), cA + hstep, voffA);
        if (wr == 1) PG8_BAR;
        PG8_WAIT_V(4); PG8_BAR;
        PG8_STAGE(PG8_SB(1, 0), cB + kstep, voffB); PG8_STAGE(PG8_SA(1, 0), cA + kstep, voffA); PG8_STAGE(PG8_SB(1, 1), cB + hstep + kstep, voffB);
        PG8_WAIT_V(6); PG8_BAR;
    }
    for (;;) {
        const bool has_next = S.next(ui + 1, nxt);
        const char* nA = has_next ? (const char*)g.A + (size_t)nxt.pm * tstep : cA; const char* nB = has_next ? (const char*)g.Bt + (size_t)nxt.pb * tstep : cB;
#pragma unroll 1
        for (int t = 0; t < nt; t += 2) {
            const bool last = (t == nt - 2);
            const char* a1 = cA + (size_t)(t + 1) * kstep;
            const char* a2 = last ? nA : cA + (size_t)(t + 2) * kstep; const char* b2 = last ? nB : cB + (size_t)(t + 2) * kstep;
            const char* a3 = a2 + kstep; const char* b3 = b2 + kstep;
            if (last && has_next) S.a_ready(nxt);
            if constexpr (SP2) {
            PG8_LDB(B0, 0, 0); PG8_LDB(B1, 0, 1); PG8_SCHED; PG8_LDA(At, 0, 0); PG8_STAGE(PG8_SA(1, 1), a1 + hstep, voffA);
            PG8_WAIT_V(8); PG8_WAIT_L(0); PG8_BAR; PG8_MMA(0, 0, At, B0); PG8_MMA(0, 1, At, B1); PG8_BAR; PG8_SCHED;
            PG8_LDA(At, 0, 1); PG8_STAGE(PG8_SB(0, 0), b2, voffB); PG8_STAGE(PG8_SB(0, 1), b2 + hstep, voffB); PG8_STAGE(PG8_SA(0, 0), a2, voffA);
            PG8_WAIT_V(8); PG8_WAIT_L(0); PG8_BAR; PG8_MMA(1, 0, At, B0); PG8_MMA(1, 1, At, B1); PG8_BAR; PG8_SCHED;
            PG8_LDB(B0, 1, 0); PG8_LDB(B1, 1, 1); PG8_SCHED; PG8_LDA(At, 1, 0); PG8_STAGE(PG8_SA(0, 1), a2 + hstep, voffA);
            PG8_WAIT_V(8); PG8_WAIT_L(0); PG8_BAR; PG8_MMA(0, 0, At, B0); PG8_MMA(0, 1, At, B1); PG8_BAR; PG8_SCHED;
            PG8_LDA(At, 1, 1); PG8_STAGE(PG8_SB(1, 0), b3, voffB); PG8_STAGE(PG8_SB(1, 1), b3 + hstep, voffB); PG8_STAGE(PG8_SA(1, 0), a3, voffA);
            PG8_WAIT_V(8); PG8_WAIT_L(0); PG8_BAR; PG8_MMA(1, 0, At, B0); PG8_MMA(1, 1, At, B1); PG8_BAR; PG8_SCHED;
            } else {
            PG8_LDB(B0, 0, 0); PG8_SCHED; PG8_LDA(At, 0, 0); PG8_STAGE(PG8_SA(1, 1), a1 + hstep, voffA);
            PG8_WAIT_L(8); PG8_BAR; PG8_WAIT_L(0); PG8_MMA(0, 0, At, B0); PG8_BAR; PG8_SCHED;
            PG8_LDB(B1, 0, 1); PG8_STAGE(PG8_SB(0, 0), b2, voffB);
            PG8_BAR; PG8_WAIT_L(0); PG8_MMA(0, 1, At, B1); PG8_BAR;
            PG8_LDA(At, 0, 1); PG8_STAGE(PG8_SA(0, 0), a2, voffA);
            PG8_BAR; PG8_WAIT_L(0); PG8_MMA(1, 0, At, B0); PG8_BAR; PG8_SCHED;
            PG8_STAGE(PG8_SB(0, 1), b2 + hstep, voffB);
            PG8_WAIT_V(6); PG8_BAR; PG8_MMA(1, 1, At, B1); PG8_BAR;
            PG8_LDB(B0, 1, 0); PG8_SCHED; PG8_LDA(At, 1, 0); PG8_STAGE(PG8_SA(0, 1), a2 + hstep, voffA);
            PG8_WAIT_L(8); PG8_BAR; PG8_WAIT_L(0); PG8_MMA(0, 0, At, B0); PG8_BAR; PG8_SCHED;
            PG8_LDB(B1, 1, 1); PG8_STAGE(PG8_SB(1, 0), b3, voffB);
            PG8_BAR; PG8_WAIT_L(0); PG8_MMA(0, 1, At, B1); PG8_BAR;
            PG8_LDA(At, 1, 1); PG8_STAGE(PG8_SA(1, 0), a3, voffA);
            PG8_BAR; PG8_WAIT_L(0); PG8_MMA(1, 0, At, B0); PG8_BAR; PG8_SCHED;
            PG8_STAGE(PG8_SB(1, 1), b3 + hstep, voffB);
            PG8_WAIT_V(6); PG8_BAR; PG8_MMA(1, 1, At, B1); PG8_BAR;
            }
        }
        if constexpr (ALIGN_EPI) { if (wr == 0) PG8_BAR; }
        if constexpr (!Epi::AFTER_DRAIN) { E(acc, cur, wr, wc, fr, fq); S.done(cur); }
        if (!has_next) break;
#pragma unroll
        for (int a = 0; a < 2; ++a)
#pragma unroll
            for (int b = 0; b < 2; ++b)
#pragma unroll
                for (int m = 0; m < 4; ++m)
#pragma unroll
                    for (int n = 0; n < 2; ++n) acc[a][b][m][n] = (f32x4){0.f, 0.f, 0.f, 0.f};
        cur = nxt; cA = nA; cB = nB; ++ui;
        if constexpr (ALIGN_EPI) { if (wr == 1) PG8_BAR; }
    }
    PG8_WAIT_V(0);
    if constexpr (!ALIGN_EPI) { if (wr == 0) PG8_BAR; }
    PG8_BAR;
    if constexpr (Epi::AFTER_DRAIN) { E.fused(acc, cur, wr, wc, fr, fq, lds, wid, lane); S.done(cur); }
#undef PG8_SA
#undef PG8_SB
#undef PG8_STAGE
#undef PG8_LDA
#undef PG8_LDB
#undef PG8_MMA
#undef PG8_WAIT_V
#undef PG8_WAIT_L
#undef PG8_BAR
#undef PG8_SCHED
}
}
#define LAS __attribute__((address_space(3)))
typedef unsigned short bf16_t;
typedef short bf16x8 __attribute__((ext_vector_type(8)));
typedef float f32x4 __attribute__((ext_vector_type(4)));
typedef float f32x2 __attribute__((ext_vector_type(2)));
typedef unsigned u32x4 __attribute__((ext_vector_type(4)));
typedef unsigned u32x2 __attribute__((ext_vector_type(2)));

constexpr int DM = 2048, SEQ = 8192, CTXL = 256, MT = SEQ + CTXL, PW = 8192;
constexpr int NCH = MT / 64  , NXCH = SEQ / 64  , NCCH = CTXL / 64  ;
constexpr int NE = 32, DE = 1024, NGRP = 256  ;
constexpr float EPS = 1e-6f;
constexpr int NWAVES = 8, NTHREADS = 512;
constexpr int LDS_BYTES = 147456;

constexpr size_t MiB = 1u << 20;
constexpr size_t WS_WTGU = 0, WS_WTD = 256 * MiB, WS_CTL = 384 * MiB, WS_WTIN = 388 * MiB, WS_WTOUT = 420 * MiB;
constexpr size_t WS_H = 428 * MiB, WS_Q = 461 * MiB, WS_GF = 478 * MiB, WS_GB = 511 * MiB, WS_V = 544 * MiB, WS_HGATE = 561 * MiB;
constexpr size_t WS_RQ = 578 * MiB, WS_RK = 587 * MiB, WS_RV = 596 * MiB, WS_RGATE = 613 * MiB;
constexpr size_t WS_LOCAL = 630 * MiB, WS_DEC = 762 * MiB, WS_SST = 764 * MiB, WS_PREOUT = 892 * MiB, WS_END = 924 * MiB;
constexpr size_t WS_OUTX = 428 * MiB, WS_HX2 = 492 * MiB, WS_XS = 524 * MiB, WS_GACT = 620 * MiB, WS_YB = 668 * MiB;
constexpr size_t CTL_MODP = 0, CTL_LB = 256 * 1024, CTL_CNT = 272 * 1024, CTL_ROUTE = 304 * 1024, CTL_SLOT = 432 * 1024, CTL_TILES = 496 * 1024, CTL_WR = 512 * 1024, CTL_BAR = 1024 * 1024;
constexpr int MISC_OFF = LDS_BYTES - 256;
constexpr size_t LOCAL_RET_OFF = (size_t)2 * 8 * NCH * 128 * 128 * 2;
constexpr size_t SST_RET_OFF = (size_t)2 * 8 * NXCH * 128 * 128 * 2;
constexpr int DEC_RET_ITEM0 = 2 * 8 * NCH;

struct Params {
    const float *x, *c, *ctx, *c_ctx, *w_mod, *b_mod, *norm_w, *w_in, *hg_lb, *hg_nw, *ret_dl, *ret_nw, *w_out, *rgw, *rgb, *rew, *reb, *w_gate, *w_up, *w_down;
    float* out; unsigned char* ws;
    int ph_lo, ph_hi;
};

#define LDS_WAIT() asm volatile("s_waitcnt lgkmcnt(0)" ::: "memory")
__device__ __forceinline__ unsigned f2bf(float f) { unsigned u = __builtin_bit_cast(unsigned, f); return (u + 0x7fffu + ((u >> 16) & 1u)) >> 16; }
__device__ __forceinline__ unsigned pk2(float lo, float hi) { return f2bf(lo) | (f2bf(hi) << 16); }
__device__ __forceinline__ unsigned pk4_fp8(float a, float b, float c, float d) { int w = 0; w = __builtin_amdgcn_cvt_pk_fp8_f32(a, b, w, false); w = __builtin_amdgcn_cvt_pk_fp8_f32(c, d, w, true); return (unsigned)w; }
__device__ __forceinline__ float bflo(unsigned w) { return __builtin_bit_cast(float, w << 16); }
__device__ __forceinline__ float bfhi(unsigned w) { return __builtin_bit_cast(float, w & 0xffff0000u); }
__device__ __forceinline__ float silu_f(float z) { return z / (1.f + __expf(-z)); }
__device__ __forceinline__ float sigmoid_f(float z) { return 1.f / (1.f + __expf(-z)); }
__device__ __forceinline__ float wave_sum(float v) {
#pragma unroll
    for (int o = 1; o < 64; o <<= 1) v += __shfl_xor(v, o);
    return v;
}
__device__ __forceinline__ f32x4 mfma16(bf16x8 a, bf16x8 b, f32x4 c) { return __builtin_amdgcn_mfma_f32_16x16x32_bf16(a, b, c, 0, 0, 0); }
__device__ __forceinline__ float log_sigmoid_f(float z) { return fminf(z, 0.f) - log1pf(__expf(-fabsf(z))); }

__device__ __forceinline__ void p0_gemv(const Params& p, LAS unsigned char* lds) {
    const int tid = threadIdx.x, wave = tid >> 6, lane = tid & 63;
    float* modp = (float*)(p.ws + WS_CTL + CTL_MODP);
    LAS float* red = (LAS float*)lds;
    for (int it = blockIdx.x; it < 192; it += gridDim.x) {
        const int cb = it % 48, kq = it / 48;
        const int col = cb * 256 + lane * 4;
        const int r0 = kq * 512 + wave * 64;
        const bool hasc = cb < 16;
        f32x4 ax = {0.f, 0.f, 0.f, 0.f}, ac = {0.f, 0.f, 0.f, 0.f};
        for (int r = 0; r < 64; r += 16) {
            f32x4 w[16];
#pragma unroll
            for (int i = 0; i < 16; ++i) w[i] = *(const f32x4*)(p.w_mod + (size_t)(r0 + r + i) * 12288 + col);
#pragma unroll
            for (int i = 0; i < 16; ++i) {
                const float sx = silu_f(p.c[r0 + r + i]); ax += w[i] * sx;
                if (hasc) { const float sc = silu_f(p.c_ctx[r0 + r + i]); ac += w[i] * sc; }
            }
        }
        *(LAS f32x4*)(red + (wave * 2 + 0) * 256 + lane * 4) = ax;
        *(LAS f32x4*)(red + (wave * 2 + 1) * 256 + lane * 4) = ac;
        __syncthreads();
        const int vsel = tid >> 8, cc = tid & 255;
        float s = 0.f;
#pragma unroll
        for (int w8 = 0; w8 < 8; ++w8) s += red[(w8 * 2 + vsel) * 256 + cc];
        if (vsel == 0) modp[kq * 16384 + cb * 256 + cc] = s; else if (hasc) modp[kq * 16384 + 12288 + cb * 256 + cc] = s;
        __syncthreads();
    }
}
__device__ __forceinline__ void transpose_item(const float* W, int ldw, int K, int k0, int n0src, bf16_t* WT, size_t drow0, LAS float* scr, int lane) {
    f32x4 v[16];
    const int rr = lane >> 4, c4 = (lane & 15) * 4;
#pragma unroll
    for (int i = 0; i < 16; ++i) v[i] = *(const f32x4*)(W + (size_t)(k0 + rr + 4 * i) * ldw + n0src + c4);
#pragma unroll
    for (int i = 0; i < 16; ++i) { LAS float* d = scr + (rr + 4 * i) * 65 + c4; d[0] = v[i][0]; d[1] = v[i][1]; d[2] = v[i][2]; d[3] = v[i][3]; }
    LDS_WAIT(); asm volatile("" ::: "memory");
    const int c = lane & 7;
#pragma unroll
    for (int j = 0; j < 8; ++j) {
        const int n = (lane >> 3) + 8 * j; const LAS float* s = scr + (8 * c) * 65 + n;
        u32x4 o; o.x = pk2(s[0 * 65], s[1 * 65]); o.y = pk2(s[2 * 65], s[3 * 65]); o.z = pk2(s[4 * 65], s[5 * 65]); o.w = pk2(s[6 * 65], s[7 * 65]);
        *(u32x4*)(WT + (drow0 + n) * (size_t)K + k0 + 8 * c) = o;
    }
    LDS_WAIT(); asm volatile("" ::: "memory");
}
constexpr int TI_IN = 32 * 128, TI_OUT = 32 * 32, TI_G = 32 * 32 * 16, TI_D = 32 * 16 * 32;
#ifndef CONV_N5
#define CONV_N5 4
#endif
__device__ __forceinline__ void transpose_dispatch(const Params& p, LAS unsigned char* lds, int it, int wave, int lane) {
    LAS float* scr = (LAS float*)(lds + wave * 16640);
    bf16_t* WTIN = (bf16_t*)(p.ws + WS_WTIN); bf16_t* WTOUT = (bf16_t*)(p.ws + WS_WTOUT); bf16_t* WTGU = (bf16_t*)(p.ws + WS_WTGU); bf16_t* WTD = (bf16_t*)(p.ws + WS_WTD);
    int r = it;
    if (r < TI_IN) {
        const int kb = r / 128, nb = r % 128; const int drow = nb * 64, pn = drow >> 8;
        int src = drow;
        if (pn >= 20 && pn < 24) { const int q4 = (drow & 255) >> 6, bj = q4 >> 1, hl = q4 & 1; const int pn0 = pn >= 22 ? 22 : 20; src = (pn >= 22 ? 5632 : 5120) + ((pn - pn0) * 2 + hl) * 128 + bj * 64; }
        transpose_item(p.w_in, PW, DM, kb * 64, src, WTIN, (size_t)drow, scr, lane); return; }
    r -= TI_IN;
    if (r < TI_OUT) { const int kb = r / 32, nb = r % 32; transpose_item(p.w_out, DM, DM, kb * 64, nb * 64, WTOUT, (size_t)nb * 64, scr, lane); return; }
    r -= TI_OUT;
    if (r < 2 * TI_G) {
        const int isup = r >= TI_G; if (isup) r -= TI_G;
        const int e = r / 512, rem = r % 512, kb = rem / 16, nb = rem % 16, n0 = nb * 64;
        const float* W = (isup ? p.w_up : p.w_gate) + (size_t)e * DM * DE;
        transpose_item(W, DE, DM, kb * 64, n0, WTGU, (size_t)e * 2048 + (n0 >> 7) * 256 + isup * 128 + (n0 & 127), scr, lane); return; }
    r -= 2 * TI_G;
    { const int e = r / 512, rem = r % 512, kb = rem / 32, nb = rem % 32;
      transpose_item(p.w_down + (size_t)e * DE * DM, DM, DE, kb * 64, nb * 64, WTD, (size_t)e * 2048 + nb * 64, scr, lane); }
}
__device__ __forceinline__ void p0_prologue(const Params& p, LAS unsigned char* lds) {
    const int tid = threadIdx.x, wave = __builtin_amdgcn_readfirstlane(tid >> 6), lane = tid & 63;
    p0_gemv(p, lds);
    {
        float* LB = (float*)(p.ws + WS_CTL + CTL_LB); float* WR = (float*)(p.ws + WS_CTL + CTL_WR);
        const int gt = blockIdx.x * NTHREADS + tid, NT = gridDim.x * NTHREADS;
        for (int i = gt; i < 2048; i += NT) { const float l0 = p.hg_lb[i], l1 = p.hg_lb[2048 + i]; LB[i] = 1.f / (1.f + __expf(l1 - l0)); }
        for (int i = gt; i < 36 * 2048; i += NT) { const int o = i >> 11, k = i & 2047; WR[i] = (o < 4) ? p.rgw[k * 4 + o] : p.rew[k * 32 + (o - 4)]; }
    }
    const int gw = blockIdx.x * NWAVES + wave, NGW = gridDim.x * NWAVES;
    for (int it = gw; it < TI_IN + TI_OUT; it += NGW) transpose_dispatch(p, lds, it, wave, lane);
}
struct CvItem { const float* src; unsigned char* dst; int ldw, K; };
constexpr float W8_SCALE = 32.f;
__device__ __forceinline__ CvItem cv_item(const Params& p, int r) {
    CvItem c;
    if (r < 2 * TI_G) { const int isup = r >= TI_G; if (isup) r -= TI_G;
        const int e = r / 512, rem = r % 512, kb = rem / 32, nb = rem % 32, n0 = nb * 32;
        c.src = (isup ? p.w_up : p.w_gate) + (size_t)e * DM * DE + (size_t)(kb * 128) * DE + n0; c.ldw = DE; c.K = DM;
        c.dst = (unsigned char*)(p.ws + WS_WTGU) + ((size_t)e * 2048 + (n0 >> 7) * 256 + isup * 128 + (n0 & 127)) * DM + kb * 128; }
    else { r -= 2 * TI_G; const int e = r / 512, rem = r % 512, kb = rem / 64, nb = rem % 64;
        c.src = p.w_down + (size_t)e * DE * DM + (size_t)(kb * 128) * DM + nb * 32; c.ldw = DM; c.K = DE;
        c.dst = (unsigned char*)(p.ws + WS_WTD) + ((size_t)e * 2048 + nb * 32) * DE + kb * 128; }
    return c;
}
__device__ __forceinline__ void cv_load(const CvItem& c, f32x4 (&v)[16], int lane) {
    const float* s = c.src + (size_t)(lane >> 3) * c.ldw + (lane & 7) * 4;
#pragma unroll
    for (int i = 0; i < 16; ++i) v[i] = __builtin_nontemporal_load((const f32x4*)(s + (size_t)(8 * i) * c.ldw));
}
__device__ __forceinline__ void cv_store(const CvItem& c, const f32x4 (&v)[16], LAS float* scr, int lane) {
    const int rr = lane >> 3, c4 = (lane & 7) * 4;
#pragma unroll
    for (int i = 0; i < 16; ++i) { LAS float* d = scr + (rr + 8 * i) * 33 + c4; d[0] = v[i][0]; d[1] = v[i][1]; d[2] = v[i][2]; d[3] = v[i][3]; }
    LDS_WAIT(); asm volatile("" ::: "memory");
    const int cc = lane >> 3;
#pragma unroll
    for (int j = 0; j < 4; ++j) {
        const int n = (lane & 7) + 8 * j; const LAS float* s = scr + (16 * cc) * 33 + n;
        u32x4 o;
        o.x = pk4_fp8(s[0 * 33] * W8_SCALE, s[1 * 33] * W8_SCALE, s[2 * 33] * W8_SCALE, s[3 * 33] * W8_SCALE);
        o.y = pk4_fp8(s[4 * 33] * W8_SCALE, s[5 * 33] * W8_SCALE, s[6 * 33] * W8_SCALE, s[7 * 33] * W8_SCALE);
        o.z = pk4_fp8(s[8 * 33] * W8_SCALE, s[9 * 33] * W8_SCALE, s[10 * 33] * W8_SCALE, s[11 * 33] * W8_SCALE);
        o.w = pk4_fp8(s[12 * 33] * W8_SCALE, s[13 * 33] * W8_SCALE, s[14 * 33] * W8_SCALE, s[15 * 33] * W8_SCALE);
        __builtin_nontemporal_store(o, (u32x4*)(c.dst + (size_t)n * c.K + 16 * cc));
    }
    LDS_WAIT(); asm volatile("" ::: "memory");
}
__device__ __forceinline__ void p2_convert(const Params& p, LAS unsigned char* lds, int c, int G) {
    int tid_ = threadIdx.x; asm volatile("" : "+v"(tid_));
    const int wave = __builtin_amdgcn_readfirstlane(tid_ >> 6), lane = tid_ & 63;
    LAS float* scr = (LAS float*)(lds + wave * 16896);
    constexpr int NG = (2 * TI_G + TI_D) / 8;
    int g0, g1;
    if (G == 256) { if (c < 32) { g0 = CONV_N5 * c; g1 = g0 + CONV_N5; } else { const int q = c - 32; constexpr int n4 = (NG - 32 * CONV_N5) / 224, ex = (NG - 32 * CONV_N5) % 224; g0 = 32 * CONV_N5 + q * n4 + (q < ex ? q : ex); g1 = g0 + n4 + (q < ex ? 1 : 0); } }
    else { const int per = (NG + G - 1) / G; g0 = c * per; g1 = g0 + per; if (g1 > NG) g1 = NG; }
    if (g0 >= g1) return;
    f32x4 va[16], vb[16];
    int g = g0; CvItem ia = cv_item(p, g * 8 + wave), ib = ia; cv_load(ia, va, lane);
    for (;;) {
        bool has = g + 1 < g1; if (has) { ib = cv_item(p, (g + 1) * 8 + wave); cv_load(ib, vb, lane); }
        cv_store(ia, va, scr, lane);
        if (!has) break;
        ++g; has = g + 1 < g1; if (has) { ia = cv_item(p, (g + 1) * 8 + wave); cv_load(ia, va, lane); }
        cv_store(ib, vb, scr, lane);
        if (!has) break;
        ++g;
    }
    asm volatile("s_waitcnt vmcnt(0)" ::: "memory");
}

__device__ __forceinline__ void mod_reduce_to_lds(const Params& p, LAS float* dst, int j0, int n, bool ctxvec) {
    const float* modp = (const float*)(p.ws + WS_CTL + CTL_MODP);
    for (int i = threadIdx.x * 4; i < n; i += NTHREADS * 4) {
        const int j = j0 + i; const int jj = ctxvec ? 12288 + j : j;
        const f32x4 a = *(const f32x4*)(modp + jj), b = *(const f32x4*)(modp + 16384 + jj), c = *(const f32x4*)(modp + 2 * 16384 + jj), d = *(const f32x4*)(modp + 3 * 16384 + jj), e = *(const f32x4*)(p.b_mod + j);
        *(LAS f32x4*)(dst + i) = ((a + b) + (c + d)) + e;
    }
}
__device__ __forceinline__ void p1_hrows(const Params& p, LAS unsigned char* lds) {
    const int tid = threadIdx.x, wave = tid >> 6, lane = tid & 63;
    LAS float* SH = (LAS float*)lds; LAS float* SC = SH + 2048; LAS float* CSH = SC + 2048; LAS float* CSC = CSH + 2048;
    mod_reduce_to_lds(p, SH, 0, 2048, false); mod_reduce_to_lds(p, SC, 2048, 2048, false);
    mod_reduce_to_lds(p, CSH, 0, 2048, true); mod_reduce_to_lds(p, CSC, 2048, 2048, true);
    __syncthreads();
    bf16_t* H = (bf16_t*)(p.ws + WS_H);
    const int gw = blockIdx.x * NWAVES + wave, NGW = gridDim.x * NWAVES;
    for (int m = gw; m < MT; m += NGW) {
        const bool isc = m < CTXL;
        const float* xr = isc ? p.ctx + (size_t)m * DM : p.x + (size_t)(m - CTXL) * DM;
        const LAS float* sh = isc ? CSH : SH; const LAS float* sc = isc ? CSC : SC;
        f32x4 v[8]; float ss = 0.f;
#pragma unroll
        for (int j = 0; j < 8; ++j) { v[j] = *(const f32x4*)(xr + 4 * (lane + 64 * j)); ss += (v[j][0] * v[j][0] + v[j][1] * v[j][1]) + (v[j][2] * v[j][2] + v[j][3] * v[j][3]); }
        const float rstd = rsqrtf(wave_sum(ss) * (1.f / DM) + EPS);
#pragma unroll
        for (int j = 0; j < 8; ++j) {
            const int col = 4 * (lane + 64 * j);
            const f32x4 nw = *(const f32x4*)(p.norm_w + col); const f32x4 a = *(const LAS f32x4*)(sc + col); const f32x4 b = *(const LAS f32x4*)(sh + col);
            const f32x4 o = (v[j] * rstd * nw) * (a + 1.f) + b;
            u32x2 w; w.x = pk2(o[0], o[1]); w.y = pk2(o[2], o[3]);
            *(u32x2*)(H + (size_t)m * DM + col) = w;
        }
    }
}

struct EpiF32 {
    static constexpr bool PERM = false, AFTER_DRAIN = false, FP8 = false;
    float* C; int ldc;
    __device__ __forceinline__ void operator()(const f32x4 (&acc)[2][2][4][2], const pg8::Unit& u, int wr, int wc, int fr, int fq) const {
        const int row0 = u.pm * 256 + wr * 64 + fr, col0 = u.pn * 256 + wc * 32 + 4 * fq;
#pragma unroll
        for (int ai = 0; ai < 2; ++ai)
#pragma unroll
            for (int m = 0; m < 4; ++m) { float* rowp = C + (size_t)(row0 + ai * 128 + m * 16) * ldc + col0;
#pragma unroll
                for (int bj = 0; bj < 2; ++bj)
#pragma unroll
                    for (int n = 0; n < 2; ++n) *(f32x4*)(rowp + bj * 128 + n * 16) = acc[ai][bj][m][n]; }
    }
};
template <bool F8> struct EpiBf16P {
    static constexpr bool PERM = false, AFTER_DRAIN = false, FP8 = F8;
    bf16_t* C; int ldc;
    __device__ __forceinline__ void operator()(const f32x4 (&acc)[2][2][4][2], const pg8::Unit& u, int wr, int wc, int fr_, int fq_) const {
        int l_ = threadIdx.x; asm volatile("" : "+v"(l_)); const int fr = l_ & 15, fq = (l_ >> 4) & 3;
        const int row0 = u.pm * 256 + wr * 64 + fr, col0 = u.pn * 256 + wc * 32 + 4 * fq;
#pragma unroll
        for (int ai = 0; ai < 2; ++ai)
#pragma unroll
            for (int m = 0; m < 4; ++m) { bf16_t* rowp = C + (size_t)(row0 + ai * 128 + m * 16) * ldc + col0;
#pragma unroll
                for (int bj = 0; bj < 2; ++bj)
#pragma unroll
                    for (int n = 0; n < 2; ++n) { const f32x4 v = acc[ai][bj][m][n]; u32x2 w; w.x = pk2(v[0], v[1]); w.y = pk2(v[2], v[3]); *(u32x2*)(rowp + bj * 128 + n * 16) = w; } }
    }
};
struct EpiGateUp {
    static constexpr bool PERM = false, AFTER_DRAIN = false, FP8 = true;
    unsigned char* G;
    __device__ __forceinline__ void operator()(const f32x4 (&acc)[2][2][4][2], const pg8::Unit& u, int wr, int wc, int fr_, int fq_) const {
        int l_ = threadIdx.x; asm volatile("" : "+v"(l_)); const int fr = l_ & 15, fq = (l_ >> 4) & 3;
        const int row0 = u.pm * 256 + wr * 64 + fr, col0 = u.pn * 128 + wc * 32 + 4 * fq;
#pragma unroll
        for (int ai = 0; ai < 2; ++ai)
#pragma unroll
            for (int m = 0; m < 4; ++m) { unsigned char* rowp = G + (size_t)(row0 + ai * 128 + m * 16) * DE + col0;
#pragma unroll
                for (int n = 0; n < 2; ++n) { const f32x4 g = acc[ai][0][m][n], up = acc[ai][1][m][n];
                    *(unsigned*)(rowp + n * 16) = pk4_fp8(silu_f(g[0]) * up[0], silu_f(g[1]) * up[1], silu_f(g[2]) * up[2], silu_f(g[3]) * up[3]); } }
    }
};
struct EpiProj {
    static constexpr bool PERM = false, AFTER_DRAIN = false, FP8 = false;
    unsigned char* ws;
    __device__ __forceinline__ void store_bf16(bf16_t* base, int ld, int colt, int mode, const f32x4 (&acc)[2][2][4][2], int row0, int wc, int fq) const {
#pragma unroll
        for (int ai = 0; ai < 2; ++ai)
#pragma unroll
            for (int m = 0; m < 4; ++m) { bf16_t* rowp = base + (size_t)(row0 + ai * 128 + m * 16) * ld + colt + wc * 32 + 4 * fq;
#pragma unroll
                for (int bj = 0; bj < 2; ++bj)
#pragma unroll
                    for (int n = 0; n < 2; ++n) { f32x4 v = acc[ai][bj][m][n];
                        if (mode == 1) { v[0] = silu_f(v[0]); v[1] = silu_f(v[1]); v[2] = silu_f(v[2]); v[3] = silu_f(v[3]); }
                        u32x2 w; w.x = pk2(v[0], v[1]); w.y = pk2(v[2], v[3]);
                        *(u32x2*)(rowp + bj * 128 + n * 16) = w; } }
    }
    __device__ __forceinline__ void operator()(const f32x4 (&acc)[2][2][4][2], const pg8::Unit& u, int wr, int wc, int fr, int fq) const {
        const int pn = u.pn, row0 = u.pm * 256 + wr * 64 + fr;
        if (pn < 4) { store_bf16((bf16_t*)(ws + WS_Q), 1024, pn * 256, 1, acc, row0, wc, fq); return; }
        if (pn < 12) {
            const int d = pn >= 8; float* Gp = (float*)(ws + (d ? WS_GB : WS_GF)); const float* LB = (const float*)(ws + WS_CTL + CTL_LB) + d * 1024;
            const int colt = (pn - (d ? 8 : 4)) * 256 + wc * 32 + 4 * fq;
#pragma unroll
            for (int bj = 0; bj < 2; ++bj)
#pragma unroll
                for (int n = 0; n < 2; ++n) { const int col = colt + bj * 128 + n * 16; const f32x4 lb = *(const f32x4*)(LB + col);
#pragma unroll
                    for (int ai = 0; ai < 2; ++ai)
#pragma unroll
                        for (int m = 0; m < 4; ++m) { const f32x4 z = acc[ai][bj][m][n]; f32x4 g;
#pragma unroll
                            for (int j = 0; j < 4; ++j) g[j] = __logf(lb[j] + (1.f - lb[j]) * sigmoid_f(z[j]));
                            *(f32x4*)(Gp + (size_t)(row0 + ai * 128 + m * 16) * 1024 + col) = g; } }
            return; }
        if (pn < 16) { store_bf16((bf16_t*)(ws + WS_V), 1024, (pn - 12) * 256, 0, acc, row0, wc, fq); return; }
        if (pn < 20) { store_bf16((bf16_t*)(ws + WS_HGATE), 1024, (pn - 16) * 256, 1, acc, row0, wc, fq); return; }
        if (pn < 24) {
            const bool isk = pn >= 22; bf16_t* O = (bf16_t*)(ws + (isk ? WS_RK : WS_RQ)); const float scl = isk ? 0.08838834764831845f : 1.f;
            const int head = (pn - (isk ? 22 : 20)) * 2 + (wc >> 1); const bool colang = (wc & 1) != 0; const bool ropeon = u.pm > 0;
#pragma unroll
            for (int ai = 0; ai < 2; ++ai)
#pragma unroll
                for (int m = 0; m < 4; ++m) { const int row = row0 + ai * 128 + m * 16; const int t = row - CTXL; const float pos = (float)(colang ? (t & 63) : (t >> 6));
#pragma unroll
                    for (int n = 0; n < 2; ++n) { const int i0 = 16 * n + 4 * fq; const f32x4 x1 = acc[ai][0][m][n], x2 = acc[ai][1][m][n]; f32x4 o1, o2;
#pragma unroll
                        for (int j = 0; j < 4; ++j) { float cs = 1.f, sn = 0.f;
                            if (ropeon) { const float ang = pos * exp2f(-(float)(i0 + j) * 0.41524101186092029f); cs = __cosf(ang); sn = __sinf(ang); }
                            o1[j] = (x1[j] * cs - x2[j] * sn) * scl; o2[j] = (x1[j] * sn + x2[j] * cs) * scl; }
                        bf16_t* dp = O + (size_t)row * 512 + head * 128 + 32 * (wc & 1) + i0;
                        u32x2 w; w.x = pk2(o1[0], o1[1]); w.y = pk2(o1[2], o1[3]); *(u32x2*)dp = w;
                        w.x = pk2(o2[0], o2[1]); w.y = pk2(o2[2], o2[3]); *(u32x2*)(dp + 64) = w; } }
            return; }
        if (pn < 28) { store_bf16((bf16_t*)(ws + WS_RV), 1024, (pn - 24) * 256, 0, acc, row0, wc, fq); return; }
        store_bf16((bf16_t*)(ws + WS_RGATE), 1024, (pn - 28) * 256, 1, acc, row0, wc, fq);
    }
};
struct MoeOrder {
    const int* tiles; int G, c;
    __device__ __forceinline__ bool next(int i, pg8::Unit& u) const {
        const int nt = tiles[0]; const int L = i * G + c; if (L >= nt * 8) return false;
        const int t = L >> 3, pn = L & 7; u.pm = t; u.pn = pn; u.pb = tiles[1 + t] * 8 + pn; return true;
    }
    __device__ __forceinline__ void a_ready(const pg8::Unit&) const {}
    __device__ __forceinline__ void done(const pg8::Unit&) const {}
};

__device__ __forceinline__ void vt_write2(LAS unsigned char* VT, const unsigned (&w)[8], int lane, int sg) {
    u32x4 a, b;
    a.x = (w[0] & 0xffffu) | (w[1] << 16); a.y = (w[2] & 0xffffu) | (w[3] << 16); a.z = (w[4] & 0xffffu) | (w[5] << 16); a.w = (w[6] & 0xffffu) | (w[7] << 16);
    b.x = (w[0] >> 16) | (w[1] & 0xffff0000u); b.y = (w[2] >> 16) | (w[3] & 0xffff0000u); b.z = (w[4] >> 16) | (w[5] & 0xffff0000u); b.w = (w[6] >> 16) | (w[7] & 0xffff0000u);
    *(LAS u32x4*)(VT + (2 * lane) * 144 + sg * 16) = a; *(LAS u32x4*)(VT + (2 * lane + 1) * 144 + sg * 16) = b;
}
__device__ __forceinline__ void vt_write4(LAS unsigned char* VT, const u32x2 (&w)[8], int lane, int sg) {
    u32x4 a, b, c, d;
    a.x = (w[0].x & 0xffffu) | (w[1].x << 16); a.y = (w[2].x & 0xffffu) | (w[3].x << 16); a.z = (w[4].x & 0xffffu) | (w[5].x << 16); a.w = (w[6].x & 0xffffu) | (w[7].x << 16);
    b.x = (w[0].x >> 16) | (w[1].x & 0xffff0000u); b.y = (w[2].x >> 16) | (w[3].x & 0xffff0000u); b.z = (w[4].x >> 16) | (w[5].x & 0xffff0000u); b.w = (w[6].x >> 16) | (w[7].x & 0xffff0000u);
    c.x = (w[0].y & 0xffffu) | (w[1].y << 16); c.y = (w[2].y & 0xffffu) | (w[3].y << 16); c.z = (w[4].y & 0xffffu) | (w[5].y << 16); c.w = (w[6].y & 0xffffu) | (w[7].y << 16);
    d.x = (w[0].y >> 16) | (w[1].y & 0xffff0000u); d.y = (w[2].y >> 16) | (w[3].y & 0xffff0000u); d.z = (w[4].y >> 16) | (w[5].y & 0xffff0000u); d.w = (w[6].y >> 16) | (w[7].y & 0xffff0000u);
    *(LAS u32x4*)(VT + (4 * lane) * 144 + sg * 16) = a; *(LAS u32x4*)(VT + (4 * lane + 1) * 144 + sg * 16) = b;
    *(LAS u32x4*)(VT + (4 * lane + 2) * 144 + sg * 16) = c; *(LAS u32x4*)(VT + (4 * lane + 3) * 144 + sg * 16) = d;
}
template <bool RET> struct S1Raw { f32x2 g[8]; unsigned kw[8]; unsigned w2[8]; u32x2 w4[8]; };
template <bool RET>
__device__ __forceinline__ void s1_load(const Params& p, int it, int sg, int lane, S1Raw<RET>& R) {
    const int cc = it % NCH, dh = it / NCH; const int dir = RET ? dh >> 2 : dh >> 3, h = RET ? dh & 3 : dh & 7;
    const size_t row0 = (size_t)cc * 64 + 8 * sg;
    if (!RET) {
        const float* G = (const float*)(p.ws + (dir ? WS_GB : WS_GF)) + row0 * 1024 + h * 128 + 2 * lane;
        const bf16_t* V = (const bf16_t*)(p.ws + WS_V) + row0 * 1024 + h * 128 + 2 * lane;
#pragma unroll
        for (int i = 0; i < 8; ++i) { R.g[i] = *(const f32x2*)(G + (size_t)i * 1024); R.w2[i] = *(const unsigned*)(V + (size_t)i * 1024); }
    } else {
        const bf16_t* K = (const bf16_t*)(p.ws + WS_RK) + row0 * 512 + h * 128 + 2 * lane;
        const bf16_t* V = (const bf16_t*)(p.ws + WS_RV) + row0 * 1024 + h * 256 + 4 * lane;
#pragma unroll
        for (int i = 0; i < 8; ++i) { R.kw[i] = *(const unsigned*)(K + (size_t)i * 512); R.w4[i] = *(const u32x2*)(V + (size_t)i * 1024); }
    }
}
template <bool RET>
__device__ __forceinline__ void s1_process(const Params& p, LAS unsigned char* lds, int it, int sg, int lane, const S1Raw<RET>& R) {
    constexpr int DV = RET ? 256 : 128;
    const int cc = it % NCH, dh = it / NCH; const int dir = RET ? dh >> 2 : dh >> 3, h = RET ? dh & 3 : dh & 7; const int kp = lane;
    LAS unsigned char* KT = lds;
    LAS unsigned char* VT = lds + 18432;
    LAS float* TOT = (LAS float*)(lds + 18432 + 36864);
    float* DEC = (float*)(p.ws + WS_DEC) + (size_t)((RET ? DEC_RET_ITEM0 : 0) + it) * 128;
    float kx[8], ky[8]; float decx, decy;
    if (!RET) {
        f32x2 cs[8];
        cs[0] = R.g[0];
#pragma unroll
        for (int i = 1; i < 8; ++i) cs[i] = cs[i - 1] + R.g[i];
        *(LAS f32x2*)(TOT + sg * 128 + 2 * kp) = cs[7];
        __syncthreads();
        f32x2 pre = {0.f, 0.f}, T = {0.f, 0.f};
#pragma unroll
        for (int s8 = 0; s8 < 8; ++s8) { const f32x2 t = *(const LAS f32x2*)(TOT + s8 * 128 + 2 * kp); if (s8 < sg) pre += t; T += t; }
#pragma unroll
        for (int i = 0; i < 8; ++i) { f32x2 b = pre + cs[i]; if (dir) b = T - b + R.g[i];
            kx[i] = (1.f - __expf(R.g[i].x)) * __expf(-b.x); ky[i] = (1.f - __expf(R.g[i].y)) * __expf(-b.y); }
        decx = __expf(T.x); decy = __expf(T.y);
    } else {
        const float lg = log_sigmoid_f(p.ret_dl[dir * 4 + h]);
#pragma unroll
        for (int i = 0; i < 8; ++i) { const int s = 8 * sg + i; const float e = dir ? (float)(64 - s) : (float)(s + 1);
            const float sc = __expf(-lg * e); kx[i] = bflo(R.kw[i]) * sc; ky[i] = bfhi(R.kw[i]) * sc; }
        decx = decy = __expf(64.f * lg);
    }
    { u32x4 a, b; a.x = pk2(kx[0], kx[1]); a.y = pk2(kx[2], kx[3]); a.z = pk2(kx[4], kx[5]); a.w = pk2(kx[6], kx[7]);
      b.x = pk2(ky[0], ky[1]); b.y = pk2(ky[2], ky[3]); b.z = pk2(ky[4], ky[5]); b.w = pk2(ky[6], ky[7]);
      *(LAS u32x4*)(KT + (2 * kp) * 144 + sg * 16) = a; *(LAS u32x4*)(KT + (2 * kp + 1) * 144 + sg * 16) = b; }
    if (sg == 0) { f32x2 d = {decx, decy}; *(f32x2*)(DEC + 2 * kp) = d; }
    if (!RET) vt_write2(VT, R.w2, lane, sg); else vt_write4(VT, R.w4, lane, sg);
    __syncthreads();
    const int fr = lane & 15, fq = lane >> 4;
    const bf16x8 a0 = *(const LAS bf16x8*)(KT + (16 * sg + fr) * 144 + 16 * fq), a1 = *(const LAS bf16x8*)(KT + (16 * sg + fr) * 144 + 64 + 16 * fq);
    bf16_t* LOC = (bf16_t*)(p.ws + WS_LOCAL + (RET ? LOCAL_RET_OFF : 0)) + (size_t)it * DV * 128 + (size_t)sg * DV * 16;
#pragma unroll
    for (int vt = 0; vt < DV / 16; ++vt) {
        const bf16x8 b0 = *(const LAS bf16x8*)(VT + (16 * vt + fr) * 144 + 16 * fq), b1 = *(const LAS bf16x8*)(VT + (16 * vt + fr) * 144 + 64 + 16 * fq);
        f32x4 acc = {0.f, 0.f, 0.f, 0.f};
        acc = mfma16(a0, b0, acc); acc = mfma16(a1, b1, acc);
        u32x2 w; w.x = pk2(acc[0], acc[1]); w.y = pk2(acc[2], acc[3]);
        *(u32x2*)(LOC + (16 * vt + fr) * 16 + 4 * fq) = w;
    }
}
template <bool RET>
__device__ __forceinline__ void p3_loop(const Params& p, LAS unsigned char* lds, int nitems) {
    const int sg = __builtin_amdgcn_readfirstlane(threadIdx.x >> 6), lane = threadIdx.x & 63, G = gridDim.x;
    int it = blockIdx.x; if (it >= nitems) return;
    S1Raw<RET> A, B; s1_load<RET>(p, it, sg, lane, A);
    for (;;) {
        int nx = it + G; bool has = nx < nitems;
        if (has) s1_load<RET>(p, nx, sg, lane, B);
        s1_process<RET>(p, lds, it, sg, lane, A);
        if (!has) break;
        it = nx; nx = it + G; has = nx < nitems;
        if (has) s1_load<RET>(p, nx, sg, lane, A);
        s1_process<RET>(p, lds + 65536, it, sg, lane, B);
        if (!has) break;
        it = nx;
    }
}
__device__ __forceinline__ void p3_local(const Params& p, LAS unsigned char* lds) {
    p3_loop<true>(p, lds, 2 * 4 * NCH);
    __syncthreads();
    p3_loop<false>(p, lds, 2 * 8 * NCH);
}
__device__ __forceinline__ void p4_scan(const Params& p) {
    const int NTOT = 131072;
    for (int e = blockIdx.x * NTHREADS + threadIdx.x; e < NTOT; e += gridDim.x * NTHREADS) {
        const bool ret = e >= 65536; const int e2 = ret ? e - 65536 : e;
        const int dh = ret ? e2 >> 13 : e2 >> 12; const int rem = ret ? e2 & 8191 : e2 & 4095;
        const int DV = ret ? 256 : 128; const int off = rem * 4; const int k = (off / (DV * 16)) * 16 + (off & 15);
        const int dir = ret ? dh >> 2 : dh >> 3;
        const bf16_t* loc = (const bf16_t*)(p.ws + WS_LOCAL + (ret ? LOCAL_RET_OFF : 0)) + (size_t)dh * NCH * DV * 128 + off;
        const float* dec = (const float*)(p.ws + WS_DEC) + (size_t)((ret ? DEC_RET_ITEM0 : 0) + dh * NCH) * 128 + k;
        bf16_t* sst = (bf16_t*)(p.ws + WS_SST + (ret ? SST_RET_OFF : 0)) + (size_t)dh * NXCH * DV * 128 + off;
        const size_t cstride = (size_t)DV * 128;
        f32x4 S = {0.f, 0.f, 0.f, 0.f};
        for (int i0 = 0; i0 < NCH; i0 += 12) {
            u32x2 lw[12]; f32x4 dc[12]; int ccs[12];
#pragma unroll
            for (int j = 0; j < 12; ++j) { const int i = i0 + j; const int cc = dir ? (i < NCCH ? NCCH - 1 - i : NCH + NCCH - 1 - i) : i; ccs[j] = cc;
                lw[j] = __builtin_nontemporal_load((const u32x2*)(loc + (size_t)cc * cstride)); dc[j] = *(const f32x4*)(dec + (size_t)cc * 128); }
#pragma unroll
            for (int j = 0; j < 12; ++j) {
                if (ccs[j] >= NCCH) { u32x2 w; w.x = pk2(S[0], S[1]); w.y = pk2(S[2], S[3]); *(u32x2*)(sst + (size_t)(ccs[j] - NCCH) * cstride) = w; }
                const f32x4 l = {bflo(lw[j].x), bfhi(lw[j].x), bflo(lw[j].y), bfhi(lw[j].y)};
                S = (S + l) * dc[j];
            }
        }
    }
}
template <bool RET>
__device__ __forceinline__ void s3_item(const Params& p, LAS unsigned char* lds, int h, int xc) {
    constexpr int DV = RET ? 256 : 128, NVW = DV / 128;
    const int tid = threadIdx.x, sg = __builtin_amdgcn_readfirstlane(tid >> 6), lane = tid & 63, kp = lane, fr = lane & 15, fq = lane >> 4;
    LAS unsigned char* QF = lds; LAS unsigned char* QB = lds + 17408; LAS unsigned char* KF = lds + 2 * 17408; LAS unsigned char* KB = lds + 3 * 17408;
    LAS unsigned char* VT = lds + 69632;
    LAS unsigned char* PP = lds + 106496;
    LAS float* TOT = (LAS float*)(lds + 115712);
    LAS float* RS = (LAS float*)(lds + 123904);
    const size_t row0 = (size_t)CTXL + (size_t)xc * 64;
    const bf16_t* SF = (const bf16_t*)(p.ws + WS_SST + (RET ? SST_RET_OFF : 0)) + ((size_t)(0 * (RET ? 4 : 8) + h) * NXCH + xc) * DV * 128;
    const bf16_t* SB = (const bf16_t*)(p.ws + WS_SST + (RET ? SST_RET_OFF : 0)) + ((size_t)(1 * (RET ? 4 : 8) + h) * NXCH + xc) * DV * 128;
    bf16x8 sf[NVW][4], sb[NVW][4];
#pragma unroll
    for (int vi = 0; vi < NVW; ++vi)
#pragma unroll
        for (int ks = 0; ks < 4; ++ks) { const size_t o = ((size_t)(2 * ks + (fq >> 1)) * DV + 16 * (sg * NVW + vi) + fr) * 16 + 8 * (fq & 1);
            sf[vi][ks] = *(const bf16x8*)(SF + o); sb[vi][ks] = *(const bf16x8*)(SB + o); }
    const bf16_t* GT = (const bf16_t*)(p.ws + (RET ? WS_RGATE : WS_HGATE)) + (row0 + fr) * 1024 + h * DV + 4 * fq;
    u32x2 gtv[4][NVW]; f32x4 nwv[NVW];
#pragma unroll
    for (int vi = 0; vi < NVW; ++vi) { nwv[vi] = *(const f32x4*)((RET ? p.ret_nw : p.hg_nw) + h * DV + 16 * (sg * NVW + vi) + 4 * fq);
#pragma unroll
        for (int tt = 0; tt < 4; ++tt) gtv[tt][vi] = *(const u32x2*)(GT + (size_t)(16 * tt) * 1024 + 16 * (sg * NVW + vi)); }
    if (!RET) {
        const float* GFp = (const float*)(p.ws + WS_GF) + (row0 + 8 * sg) * 1024 + h * 128 + 2 * kp;
        const float* GBp = (const float*)(p.ws + WS_GB) + (row0 + 8 * sg) * 1024 + h * 128 + 2 * kp;
        const bf16_t* Qp = (const bf16_t*)(p.ws + WS_Q) + (row0 + 8 * sg) * 1024 + h * 128 + 2 * kp;
        const bf16_t* V = (const bf16_t*)(p.ws + WS_V) + (row0 + 8 * sg) * 1024 + h * 128 + 2 * lane;
        f32x2 gf[8], gb[8], cf[8], cb[8]; unsigned qw[8], vw[8];
#pragma unroll
        for (int i = 0; i < 8; ++i) { gf[i] = *(const f32x2*)(GFp + (size_t)i * 1024); gb[i] = *(const f32x2*)(GBp + (size_t)i * 1024); qw[i] = *(const unsigned*)(Qp + (size_t)i * 1024); vw[i] = *(const unsigned*)(V + (size_t)i * 1024); }
        cf[0] = gf[0]; cb[0] = gb[0];
#pragma unroll
        for (int i = 1; i < 8; ++i) { cf[i] = cf[i - 1] + gf[i]; cb[i] = cb[i - 1] + gb[i]; }
        *(LAS f32x2*)(TOT + sg * 128 + 2 * kp) = cf[7]; *(LAS f32x2*)(TOT + 1024 + sg * 128 + 2 * kp) = cb[7];
        vt_write2(VT, vw, lane, sg);
        __syncthreads();
        f32x2 pf = {0.f, 0.f}, pb = {0.f, 0.f}, Tb = {0.f, 0.f};
#pragma unroll
        for (int s8 = 0; s8 < 8; ++s8) { const f32x2 t = *(const LAS f32x2*)(TOT + s8 * 128 + 2 * kp), t2 = *(const LAS f32x2*)(TOT + 1024 + s8 * 128 + 2 * kp);
            if (s8 < sg) { pf += t; pb += t2; } Tb += t2; }
#pragma unroll
        for (int i = 0; i < 8; ++i) {
            const f32x2 bf = pf + cf[i]; const f32x2 bb = Tb - (pb + cb[i]) + gb[i];
            const float qx = bflo(qw[i]), qy = bfhi(qw[i]); const int s = 8 * sg + i;
            *(LAS unsigned*)(QF + s * 272 + kp * 4) = pk2(qx * __expf(bf.x), qy * __expf(bf.y));
            *(LAS unsigned*)(KF + s * 272 + kp * 4) = pk2((1.f - __expf(gf[i].x)) * __expf(-bf.x), (1.f - __expf(gf[i].y)) * __expf(-bf.y));
            *(LAS unsigned*)(QB + s * 272 + kp * 4) = pk2(qx * __expf(bb.x), qy * __expf(bb.y));
            *(LAS unsigned*)(KB + s * 272 + kp * 4) = pk2((1.f - __expf(gb[i].x)) * __expf(-bb.x), (1.f - __expf(gb[i].y)) * __expf(-bb.y));
        }
    } else {
        const bf16_t* Qp = (const bf16_t*)(p.ws + WS_RQ) + (row0 + 8 * sg) * 512 + h * 128 + 2 * kp;
        const bf16_t* Kp = (const bf16_t*)(p.ws + WS_RK) + (row0 + 8 * sg) * 512 + h * 128 + 2 * kp;
        const bf16_t* V = (const bf16_t*)(p.ws + WS_RV) + (row0 + 8 * sg) * 1024 + h * 256 + 4 * lane;
        const float lgf = log_sigmoid_f(p.ret_dl[h]), lgb = log_sigmoid_f(p.ret_dl[4 + h]);
        unsigned qw[8], kw[8]; u32x2 vw[8];
#pragma unroll
        for (int i = 0; i < 8; ++i) { qw[i] = *(const unsigned*)(Qp + (size_t)i * 512); kw[i] = *(const unsigned*)(Kp + (size_t)i * 512); vw[i] = *(const u32x2*)(V + (size_t)i * 1024); }
        vt_write4(VT, vw, lane, sg);
#pragma unroll
        for (int i = 0; i < 8; ++i) {
            const int s = 8 * sg + i;
            const float bf = (float)(s + 1) * lgf, bb = (float)(64 - s) * lgb;
            const float ef = __expf(bf), eb = __expf(bb), nf = __expf(-bf), nb = __expf(-bb);
            *(LAS unsigned*)(QF + s * 272 + kp * 4) = pk2(bflo(qw[i]) * ef, bfhi(qw[i]) * ef);
            *(LAS unsigned*)(KF + s * 272 + kp * 4) = pk2(bflo(kw[i]) * nf, bfhi(kw[i]) * nf);
            *(LAS unsigned*)(QB + s * 272 + kp * 4) = pk2(bflo(qw[i]) * eb, bfhi(qw[i]) * eb);
            *(LAS unsigned*)(KB + s * 272 + kp * 4) = pk2(bflo(kw[i]) * nb, bfhi(kw[i]) * nb);
        }
    }
    __syncthreads();
    {
        const int tt = sg >> 1;
#pragma unroll
        for (int sti = 0; sti < 2; ++sti) {
            const int st = (sg & 1) * 2 + sti;
            f32x4 af = {0.f, 0.f, 0.f, 0.f}, ab = {0.f, 0.f, 0.f, 0.f};
            if (st <= tt) {
#pragma unroll
                for (int ks = 0; ks < 4; ++ks) { const bf16x8 a = *(const LAS bf16x8*)(KF + (16 * st + fr) * 272 + ks * 64 + 16 * fq), b = *(const LAS bf16x8*)(QF + (16 * tt + fr) * 272 + ks * 64 + 16 * fq); af = mfma16(a, b, af); }
            }
            if (st >= tt) {
#pragma unroll
                for (int ks = 0; ks < 4; ++ks) { const bf16x8 a = *(const LAS bf16x8*)(KB + (16 * st + fr) * 272 + ks * 64 + 16 * fq), b = *(const LAS bf16x8*)(QB + (16 * tt + fr) * 272 + ks * 64 + 16 * fq); ab = mfma16(a, b, ab); }
            }
            f32x4 r;
#pragma unroll
            for (int j = 0; j < 4; ++j) { const int sl = 16 * st + 4 * fq + j, tl = 16 * tt + fr; r[j] = (sl <= tl ? af[j] : 0.f) + (sl >= tl ? ab[j] : 0.f); }
            u32x2 w; w.x = pk2(r[0], r[1]); w.y = pk2(r[2], r[3]);
            *(LAS u32x2*)(PP + (16 * tt + fr) * 144 + (16 * st + 4 * fq) * 2) = w;
        }
    }
    __syncthreads();
    f32x4 o[4][NVW];
#pragma unroll
    for (int tt = 0; tt < 4; ++tt) {
        bf16x8 pb[2], qfb[4], qbb[4];
#pragma unroll
        for (int ks = 0; ks < 2; ++ks) pb[ks] = *(const LAS bf16x8*)(PP + (16 * tt + fr) * 144 + ks * 64 + 16 * fq);
#pragma unroll
        for (int ks = 0; ks < 4; ++ks) { qfb[ks] = *(const LAS bf16x8*)(QF + (16 * tt + fr) * 272 + ks * 64 + 16 * fq); qbb[ks] = *(const LAS bf16x8*)(QB + (16 * tt + fr) * 272 + ks * 64 + 16 * fq); }
        float ss = 0.f;
#pragma unroll
        for (int vi = 0; vi < NVW; ++vi) {
            const int vt = sg * NVW + vi; f32x4 acc = {0.f, 0.f, 0.f, 0.f};
#pragma unroll
            for (int ks = 0; ks < 2; ++ks) { const bf16x8 a = *(const LAS bf16x8*)(VT + (16 * vt + fr) * 144 + ks * 64 + 16 * fq); acc = mfma16(a, pb[ks], acc); }
#pragma unroll
            for (int ks = 0; ks < 4; ++ks) acc = mfma16(sf[vi][ks], qfb[ks], acc);
#pragma unroll
            for (int ks = 0; ks < 4; ++ks) acc = mfma16(sb[vi][ks], qbb[ks], acc);
            o[tt][vi] = acc; ss += (acc[0] * acc[0] + acc[1] * acc[1]) + (acc[2] * acc[2] + acc[3] * acc[3]);
        }
        ss += __shfl_xor(ss, 16); ss += __shfl_xor(ss, 32);
        if (fq == 0) RS[sg * 64 + 16 * tt + fr] = ss;
    }
    __syncthreads();
    bf16_t* PO = (bf16_t*)(p.ws + WS_PREOUT) + ((size_t)xc * 64 + fr) * DM + (RET ? 1024 : 0) + h * DV + 4 * fq;
#pragma unroll
    for (int tt = 0; tt < 4; ++tt) {
        float tot = 0.f;
#pragma unroll
        for (int w8 = 0; w8 < 8; ++w8) tot += RS[w8 * 64 + 16 * tt + fr];
        const float rstd = rsqrtf(tot * (1.f / DV) + EPS);
#pragma unroll
        for (int vi = 0; vi < NVW; ++vi) {
            const u32x2 gw = gtv[tt][vi]; const f32x4 nw = nwv[vi]; const f32x4 a = o[tt][vi];
            u32x2 w; w.x = pk2(a[0] * rstd * nw[0] * bflo(gw.x), a[1] * rstd * nw[1] * bfhi(gw.x)); w.y = pk2(a[2] * rstd * nw[2] * bflo(gw.y), a[3] * rstd * nw[3] * bfhi(gw.y));
            *(u32x2*)(PO + (size_t)(16 * tt) * DM + 16 * (sg * NVW + vi)) = w;
        }
    }
    __syncthreads();
}
__device__ __forceinline__ void p5_out(const Params& p, LAS unsigned char* lds) {
    constexpr int NR = 4 * NXCH, NH = 8 * NXCH;
    for (int it = blockIdx.x; it < NR + NH; it += gridDim.x) {
        if (it < NR) s3_item<true>(p, lds, it / NXCH, it % NXCH);
        else { const int r = it - NR; s3_item<false>(p, lds, r / NXCH, r % NXCH); }
    }
}

__device__ __forceinline__ void p7_norm_route(const Params& p, LAS unsigned char* lds) {
    const int tid = threadIdx.x, wave = tid >> 6, lane = tid & 63;
    LAS float* G1 = (LAS float*)lds; LAS float* SH2 = G1 + 2048; LAS float* SC2 = SH2 + 2048; LAS int* CNTL = (LAS int*)(SC2 + 2048);
    mod_reduce_to_lds(p, G1, 4096, 2048, false); mod_reduce_to_lds(p, SH2, 6144, 2048, false); mod_reduce_to_lds(p, SC2, 8192, 2048, false);
    const bf16_t* OX = (const bf16_t*)(p.ws + WS_OUTX); unsigned char* HX2 = (unsigned char*)(p.ws + WS_HX2);
    const float* WR = (const float*)(p.ws + WS_CTL + CTL_WR);
    int* CNT = (int*)(p.ws + WS_CTL + CTL_CNT); f32x4* ROUTE = (f32x4*)(p.ws + WS_CTL + CTL_ROUTE);
    for (int grp = blockIdx.x; grp < NGRP; grp += gridDim.x) {
        if (tid < 32) CNTL[tid] = 0;
        __syncthreads();
        LAS float* LG = (LAS float*)(lds + 32768) + wave * 160;
        LAS float* WL = (LAS float*)(lds + 40960);
        f32x4 hv[4][8];
#pragma unroll
        for (int r = 0; r < 4; ++r) {
            const int t = grp * 32 + wave * 4 + r;
            f32x4 ov[8]; float ss = 0.f;
#pragma unroll
            for (int j = 0; j < 8; ++j) { const u32x2 ow = *(const u32x2*)(OX + (size_t)t * DM + 4 * (lane + 64 * j)); ov[j] = (f32x4){bflo(ow.x), bfhi(ow.x), bflo(ow.y), bfhi(ow.y)}; ss += (ov[j][0] * ov[j][0] + ov[j][1] * ov[j][1]) + (ov[j][2] * ov[j][2] + ov[j][3] * ov[j][3]); }
            const float rstd = rsqrtf(wave_sum(ss) * (1.f / DM) + EPS); float ss2 = 0.f;
#pragma unroll
            for (int j = 0; j < 8; ++j) { const int col = 4 * (lane + 64 * j);
                const f32x4 xv = *(const f32x4*)(p.x + (size_t)t * DM + col), nw = *(const f32x4*)(p.norm_w + DM + col), g1 = *(const LAS f32x4*)(G1 + col);
                const f32x4 x1 = xv + g1 * (ov[j] * rstd * nw);
                *(f32x4*)(p.out + (size_t)t * DM + col) = x1; hv[r][j] = x1;
                ss2 += (x1[0] * x1[0] + x1[1] * x1[1]) + (x1[2] * x1[2] + x1[3] * x1[3]); }
            const float rstd2 = rsqrtf(wave_sum(ss2) * (1.f / DM) + EPS);
#pragma unroll
            for (int j = 0; j < 8; ++j) { const int col = 4 * (lane + 64 * j);
                const f32x4 nw = *(const f32x4*)(p.norm_w + 2 * DM + col), a = *(const LAS f32x4*)(SC2 + col), b = *(const LAS f32x4*)(SH2 + col);
                const f32x4 hx = (hv[r][j] * rstd2 * nw) * (a + 1.f) + b; hv[r][j] = hx;
                *(unsigned*)(HX2 + (size_t)t * DM + col) = pk4_fp8(hx[0], hx[1], hx[2], hx[3]); }
            asm volatile("" ::: "memory");
        }
        const int rsel = 2 * (lane & 1) + ((lane >> 1) & 1);
#pragma unroll 1
        for (int rd = 0; rd < 3; ++rd) {
            __syncthreads();
            {
                const float* src = WR + (size_t)rd * 12 * 2048 + 4 * tid;
#pragma unroll
                for (int q = 0; q < 12; ++q) { const f32x4 v = *(const f32x4*)(src + q * 2048); *(LAS f32x4*)(WL + q * 2048 + 4 * tid) = v; }
            }
            __syncthreads();
#pragma unroll 1
            for (int oo = 0; oo < 12; ++oo) {
                const LAS float* wl = WL + oo * 2048 + 4 * lane;
                float a0 = 0.f, a1 = 0.f, a2 = 0.f, a3 = 0.f;
#pragma unroll
                for (int j = 0; j < 8; ++j) { const f32x4 w = *(const LAS f32x4*)(wl + 256 * j);
                    a0 += (hv[0][j][0] * w[0] + hv[0][j][1] * w[1]) + (hv[0][j][2] * w[2] + hv[0][j][3] * w[3]);
                    a1 += (hv[1][j][0] * w[0] + hv[1][j][1] * w[1]) + (hv[1][j][2] * w[2] + hv[1][j][3] * w[3]);
                    a2 += (hv[2][j][0] * w[0] + hv[2][j][1] * w[1]) + (hv[2][j][2] * w[2] + hv[2][j][3] * w[3]);
                    a3 += (hv[3][j][0] * w[0] + hv[3][j][1] * w[1]) + (hv[3][j][2] * w[2] + hv[3][j][3] * w[3]); }
                const bool b0 = (lane & 1) != 0, b1 = (lane & 2) != 0;
                float x0 = b0 ? a2 : a0, y0 = b0 ? a0 : a2, x1 = b0 ? a3 : a1, y1 = b0 ? a1 : a3;
                x0 += __shfl_xor(y0, 1); x1 += __shfl_xor(y1, 1);
                float z = b1 ? x1 : x0, sn = b1 ? x0 : x1; z += __shfl_xor(sn, 2);
                z += __shfl_xor(z, 4); z += __shfl_xor(z, 8); z += __shfl_xor(z, 16); z += __shfl_xor(z, 32);
                if (lane < 4) LG[rsel * 40 + rd * 12 + oo] = z;
            }
        }
        {
            LDS_WAIT(); asm volatile("" ::: "memory");
            const LAS float* Lr = LG + (lane & 3) * 40;
            const float L0 = Lr[0] + p.rgb[0], L1 = Lr[1] + p.rgb[1], L2 = Lr[2] + p.rgb[2], L3 = Lr[3] + p.rgb[3];
            int grpi = 0; float gmax = L0;
            if (L1 > gmax) { gmax = L1; grpi = 1; }
            if (L2 > gmax) { gmax = L2; grpi = 2; }
            if (L3 > gmax) { gmax = L3; grpi = 3; }
            const float psel = 1.f / ((__expf(L0 - gmax) + __expf(L1 - gmax)) + (__expf(L2 - gmax) + __expf(L3 - gmax)));
            float le[8];
#pragma unroll
            for (int j = 0; j < 8; ++j) le[j] = Lr[4 + grpi * 8 + j] + p.reb[grpi * 8 + j];
            int i1 = 0; float v1 = le[0];
#pragma unroll
            for (int j = 1; j < 8; ++j) if (le[j] > v1) { v1 = le[j]; i1 = j; }
            int i2 = -1; float v2 = -3.0e38f;
#pragma unroll
            for (int j = 0; j < 8; ++j) if (j != i1 && le[j] > v2) { v2 = le[j]; i2 = j; }
            const float e2 = __expf(v2 - v1); const float ga = psel / (1.f + e2), gb2 = psel * e2 / (1.f + e2);
            if (lane < 4) {
                const int t = grp * 32 + wave * 4 + lane; const int ea = grpi * 8 + i1, eb = grpi * 8 + i2;
                f32x4 rt; rt[0] = __builtin_bit_cast(float, ea); rt[1] = __builtin_bit_cast(float, eb); rt[2] = ga; rt[3] = gb2; ROUTE[t] = rt;
                atomicAdd((int*)&CNTL[ea], 1); atomicAdd((int*)&CNTL[eb], 1);
            }
        }
        __syncthreads();
        if (tid < 32) CNT[grp * 32 + tid] = CNTL[tid];
        __syncthreads();
    }
}
__device__ __forceinline__ void p8_slots(const Params& p, LAS unsigned char* lds) {
    const int tid = threadIdx.x, wave = tid >> 6, lane = tid & 63;
    LAS int* PT = (LAS int*)lds;
    LAS int* PP = PT + 512;
    LAS int* TOTE = PP + 512;
    LAS int* BASE = TOTE + 32;
    LAS int* SLOTL = BASE + 32;
    const int* CNT = (const int*)(p.ws + WS_CTL + CTL_CNT); const f32x4* ROUTE = (const f32x4*)(p.ws + WS_CTL + CTL_ROUTE);
    int* SLOT = (int*)(p.ws + WS_CTL + CTL_SLOT); int* TILES = (int*)(p.ws + WS_CTL + CTL_TILES);
    const unsigned char* HX2 = (const unsigned char*)(p.ws + WS_HX2); unsigned char* XS = (unsigned char*)(p.ws + WS_XS);
    for (int grp = blockIdx.x; grp < NGRP; grp += gridDim.x) {
        { const int e = tid & 31, part = tid >> 5; int t = 0, pr = 0;
          for (int g = part * 16; g < part * 16 + 16; ++g) { const int c = CNT[g * 32 + e]; t += c; if (g < grp) pr += c; }
          PT[part * 32 + e] = t; PP[part * 32 + e] = pr; }
        __syncthreads();
        if (tid < 32) { int t = 0, pr = 0; for (int q = 0; q < 16; ++q) { t += PT[q * 32 + tid]; pr += PP[q * 32 + tid]; } TOTE[tid] = t; BASE[tid] = pr; }
        __syncthreads();
        if (tid == 0) { int st = 0; for (int e = 0; e < 32; ++e) { const int t = TOTE[e]; BASE[e] += st;
                if (grp == 0) { const int nt = (t + 255) >> 8; for (int q = 0; q < nt; ++q) TILES[1 + (st >> 8) + q] = e; }
                st += ((t + 255) >> 8) << 8; }
            if (grp == 0) TILES[0] = st >> 8; }
        __syncthreads();
        if (wave == 0) {
            const int t = grp * 32 + (lane >> 1); const f32x4 rt = ROUTE[t]; const int e = __builtin_bit_cast(int, (lane & 1) ? rt[1] : rt[0]);
            int rank = 0; const unsigned long long ltmask = (1ull << lane) - 1ull;
            for (int q = 0; q < 32; ++q) { const unsigned long long m = __ballot(e == q); if (e == q) rank = __popcll(m & ltmask); }
            const int slot = BASE[e] + rank; SLOTL[lane] = slot; SLOT[grp * 64 + lane] = slot;
        }
        __syncthreads();
        for (int a = wave * 8; a < wave * 8 + 8; ++a) {
            const int t = grp * 32 + (a >> 1); const int slot = SLOTL[a];
            const u32x4* src = (const u32x4*)(HX2 + (size_t)t * DM); u32x4* dst = (u32x4*)(XS + (size_t)slot * DM);
#pragma unroll
            for (int j = 0; j < 2; ++j) dst[lane + 64 * j] = src[lane + 64 * j];
        }
        __syncthreads();
    }
}
__device__ __forceinline__ void p11_final(const Params& p, LAS unsigned char* lds) {
    const int tid = threadIdx.x, wave = tid >> 6, lane = tid & 63;
    LAS float* G2 = (LAS float*)lds;
    mod_reduce_to_lds(p, G2, 10240, 2048, false);
    __syncthreads();
    const bf16_t* YB = (const bf16_t*)(p.ws + WS_YB); const int* SLOT = (const int*)(p.ws + WS_CTL + CTL_SLOT); const f32x4* ROUTE = (const f32x4*)(p.ws + WS_CTL + CTL_ROUTE);
    const int gw = blockIdx.x * NWAVES + wave, NGW = gridDim.x * NWAVES;
    for (int t = gw; t < SEQ; t += NGW) {
        const int sa = SLOT[2 * t], sb = SLOT[2 * t + 1]; const f32x4 rt = ROUTE[t]; const float ga = rt[2], gb = rt[3];
        f32x4 y[8]; float ss = 0.f;
#pragma unroll
        for (int j = 0; j < 8; ++j) { const int col = 4 * (lane + 64 * j);
            const u32x2 wa = *(const u32x2*)(YB + (size_t)sa * DM + col), wb = *(const u32x2*)(YB + (size_t)sb * DM + col);
            const f32x4 ya = {bflo(wa.x), bfhi(wa.x), bflo(wa.y), bfhi(wa.y)}, yb = {bflo(wb.x), bfhi(wb.x), bflo(wb.y), bfhi(wb.y)};
            y[j] = ya * ga + yb * gb; ss += (y[j][0] * y[j][0] + y[j][1] * y[j][1]) + (y[j][2] * y[j][2] + y[j][3] * y[j][3]); }
        const float rstd = rsqrtf(wave_sum(ss) * (1.f / DM) + EPS);
#pragma unroll
        for (int j = 0; j < 8; ++j) { const int col = 4 * (lane + 64 * j);
            const f32x4 nw = *(const f32x4*)(p.norm_w + 3 * DM + col), g2 = *(const LAS f32x4*)(G2 + col);
            f32x4* op = (f32x4*)(p.out + (size_t)t * DM + col); *op = *op + g2 * (y[j] * rstd * nw); }
    }
}

#define XB_TMO      128
#define XB_XCNT(j)  (256  + 64 * (j))
#define XB_XSUB(j)  (1280 + 64 * (j))
#define XB_XGEN(j)  (2304 + 64 * (j))
#define XB_TOP      3328
#define XB_TOPGEN   3392
#define XCD_BAR_WORDS 3456
#define XB_SPIN_CAP (1u << 18)

__device__ __forceinline__ unsigned xb_ld(unsigned* p)              { return __hip_atomic_load(p, __ATOMIC_RELAXED, __HIP_MEMORY_SCOPE_AGENT); }
__device__ __forceinline__ unsigned xb_add(unsigned* p, unsigned v) { return __hip_atomic_fetch_add(p, v, __ATOMIC_RELAXED, __HIP_MEMORY_SCOPE_AGENT); }
__device__ __forceinline__ unsigned xb_xcc_id() { return (unsigned)__builtin_amdgcn_s_getreg((3 << 11) | 20) & 0xFu; }
#define XB_SPIN(cond, bar) do { unsigned _sp = 0; while (cond) { __builtin_amdgcn_s_sleep(1); \
    if ((++_sp & 255u) == 0u) { if (xb_ld(&(bar)[XB_TMO])) break; if (_sp > XB_SPIN_CAP) { atomicAdd(&(bar)[XB_TMO], 1u); break; } } } } while (0)

struct XcdBarrier {
    unsigned* bar; unsigned x;
    volatile LAS unsigned* st;
};

__device__ __forceinline__ XcdBarrier xcd_barrier_post(unsigned* bar, volatile LAS unsigned* st) {
    XcdBarrier b; b.bar = bar; b.x = xb_xcc_id(); b.st = st;
    if (threadIdx.x == 0) (void)xb_add(&bar[XB_XCNT(b.x)], 1u);
    return b;
}
__device__ __forceinline__ void xcd_barrier_complete(unsigned* bar, unsigned x, unsigned& nloc, unsigned& nx) {
    const unsigned G = gridDim.x * gridDim.y * gridDim.z;
    unsigned sum, cnt, mine, sp = 0u;
    for (;;) {
        sum = 0u; cnt = 0u; mine = 0u;
#pragma unroll
        for (unsigned j = 0; j < 16; ++j) { const unsigned c = xb_ld(&bar[XB_XCNT(j)]); sum += c; cnt += (c > 0u) ? 1u : 0u; mine = (j == x) ? c : mine; }
        if (sum == G) break;
        __builtin_amdgcn_s_sleep(1);
        if ((++sp & 255u) == 0u) { if (xb_ld(&bar[XB_TMO])) break; if (sp > XB_SPIN_CAP) { atomicAdd(&bar[XB_TMO], 1u); break; } }
    }
    nloc = mine > 0u ? mine : 1u; nx = cnt > 0u ? cnt : 1u;
}

__device__ __forceinline__ void xcd_barrier(const XcdBarrier& b) {
    asm volatile("s_waitcnt vmcnt(0)" ::: "memory");
    __syncthreads();
    if (threadIdx.x == 0) {
        unsigned* bar = b.bar;
        __builtin_amdgcn_s_waitcnt(0);
        unsigned nloc = b.st[0], nx = b.st[1];
        if (nloc == 0u) { xcd_barrier_complete(bar, b.x, nloc, nx); b.st[0] = nloc; b.st[1] = nx; }
        const unsigned old = xb_add(&bar[XB_XSUB(b.x)], 1u);
        const unsigned gen = old / nloc;
        if (old + 1u == (gen + 1u) * nloc) {
            __builtin_amdgcn_fence(__ATOMIC_RELEASE, "agent");
            asm volatile("s_waitcnt vmcnt(0)" ::: "memory");
            const unsigned og = xb_add(&bar[XB_TOP], 1u);
            const unsigned tg = og / nx;
            if (og + 1u == (tg + 1u) * nx) xb_add(&bar[XB_TOPGEN], 1u);
            else XB_SPIN(xb_ld(&bar[XB_TOPGEN]) == tg, bar);
            __builtin_amdgcn_fence(__ATOMIC_ACQUIRE, "agent");
            xb_add(&bar[XB_XGEN(b.x)], 1u);
            asm volatile("s_waitcnt vmcnt(0)" ::: "memory");
        } else {
            XB_SPIN(xb_ld(&bar[XB_XGEN(b.x)]) == gen, bar);
            __builtin_amdgcn_fence(__ATOMIC_ACQUIRE, "agent");
            asm volatile("s_waitcnt vmcnt(0)" ::: "memory");
        }
    }
    __syncthreads();
}

constexpr int NPHASE = 12;
__global__ void __launch_bounds__(NTHREADS, 2) fwd_kernel(Params p) {
    extern __shared__ __attribute__((aligned(16))) unsigned char lds_raw[];
    LAS unsigned char* lds = (LAS unsigned char*)lds_raw;
    cg::grid_group grid = cg::this_grid();
    const int lo = p.ph_lo, hi = p.ph_hi;
    volatile LAS unsigned* MISC = (volatile LAS unsigned*)(lds + MISC_OFF);
    if (threadIdx.x < 64) MISC[threadIdx.x] = 0u;
    __syncthreads();
    XcdBarrier bar; bar.bar = (unsigned*)(p.ws + WS_CTL + CTL_BAR); bar.x = 0; bar.st = nullptr;
    if (hi - lo > 1) bar = xcd_barrier_post((unsigned*)(p.ws + WS_CTL + CTL_BAR), MISC + 8);
    if (lo < 0) grid.sync();
    const int G = gridDim.x, bx = blockIdx.x;
    const int vcu = (G % 8 == 0) ? (bx % 8) * (G / 8) + bx / 8 : bx;
#ifndef PHM
#define PHM 0xfff
#endif
#define IN(k) (((PHM >> (k)) & 1) && lo <= (k) && (k) < hi)
#ifndef REPM
#define REPM 0
#endif
#define SEAM(k) do { if (IN(k) && IN((k) + 1)) xcd_barrier(bar); } while (0)
    if (IN(0)) for (int rep_ = 0; rep_ <= ((REPM >> 0) & 1); ++rep_) { if (rep_) xcd_barrier(bar); p0_prologue(p, lds); } SEAM(0);
    if (IN(1)) for (int rep_ = 0; rep_ <= ((REPM >> 1) & 1); ++rep_) { if (rep_) xcd_barrier(bar); p1_hrows(p, lds); } SEAM(1);
    if (IN(2)) for (int rep_ = 0; rep_ <= ((REPM >> 2) & 1); ++rep_) { if (rep_) xcd_barrier(bar);
        pg8::Gemm g{(const bf16_t*)(p.ws + WS_H), (const bf16_t*)(p.ws + WS_WTIN), MT, PW, DM, 0, 0}; pg8::StaticOrder S; S.init(MT, PW, G, bx);
        EpiProj E{p.ws};
        const bool convfirst = ((bx >> 3) & 1) == 0;
#pragma unroll 1
        for (int step = 0; step < 2; ++step) {
            if ((step == 0) == convfirst) p2_convert(p, lds, bx, G);
            else pg8::gemm_phase<EpiProj, pg8::StaticOrder, true, true>(lds, g, S, E);
            __syncthreads();
        }
    } SEAM(2);
    if (IN(3)) for (int rep_ = 0; rep_ <= ((REPM >> 3) & 1); ++rep_) { if (rep_) xcd_barrier(bar); p3_local(p, lds); } SEAM(3);
    if (IN(4)) for (int rep_ = 0; rep_ <= ((REPM >> 4) & 1); ++rep_) { if (rep_) xcd_barrier(bar); p4_scan(p); } SEAM(4);
    if (IN(5)) for (int rep_ = 0; rep_ <= ((REPM >> 5) & 1); ++rep_) { if (rep_) xcd_barrier(bar); p5_out(p, lds); } SEAM(5);
    if (IN(6)) for (int rep_ = 0; rep_ <= ((REPM >> 6) & 1); ++rep_) { if (rep_) xcd_barrier(bar);
        pg8::Gemm g{(const bf16_t*)(p.ws + WS_PREOUT), (const bf16_t*)(p.ws + WS_WTOUT), SEQ, DM, DM, 0, 0}; pg8::StaticOrder S; S.init(SEQ, DM, G, bx);
        EpiBf16P<false> E{(bf16_t*)(p.ws + WS_OUTX), DM};
        pg8::gemm_phase<EpiBf16P<false>, pg8::StaticOrder, true, true>(lds, g, S, E);
    } SEAM(6);
    if (IN(7)) for (int rep_ = 0; rep_ <= ((REPM >> 7) & 1); ++rep_) { if (rep_) xcd_barrier(bar); p7_norm_route(p, lds); } SEAM(7);
    if (IN(8)) for (int rep_ = 0; rep_ <= ((REPM >> 8) & 1); ++rep_) { if (rep_) xcd_barrier(bar); p8_slots(p, lds); } SEAM(8);
    if (IN(9)) for (int rep_ = 0; rep_ <= ((REPM >> 9) & 1); ++rep_) { if (rep_) xcd_barrier(bar);
        pg8::Gemm g{(const bf16_t*)(p.ws + WS_XS), (const bf16_t*)(p.ws + WS_WTGU), 0, 0, DM / 2, 0x7A7A7A7F, 0}; MoeOrder S{(const int*)(p.ws + WS_CTL + CTL_TILES), G, vcu};
        EpiGateUp E{(unsigned char*)(p.ws + WS_GACT)};
        pg8::gemm_phase<EpiGateUp, MoeOrder, true, true>(lds, g, S, E);
    } SEAM(9);
    if (IN(10)) for (int rep_ = 0; rep_ <= ((REPM >> 10) & 1); ++rep_) { if (rep_) xcd_barrier(bar);
        pg8::Gemm g{(const bf16_t*)(p.ws + WS_GACT), (const bf16_t*)(p.ws + WS_WTD), 0, 0, DE / 2, 0x7A7A7A7F, 0}; MoeOrder S{(const int*)(p.ws + WS_CTL + CTL_TILES), G, vcu};
        EpiBf16P<true> E{(bf16_t*)(p.ws + WS_YB), DM};
        pg8::gemm_phase<EpiBf16P<true>, MoeOrder, true, true>(lds, g, S, E);
    } SEAM(10);
    if (IN(11)) for (int rep_ = 0; rep_ <= ((REPM >> 11) & 1); ++rep_) { if (rep_) xcd_barrier(bar); p11_final(p, lds); }
#undef IN
#undef SEAM
}

#ifndef MK_ONE_LAUNCH
#define MK_ONE_LAUNCH 1
#endif
extern "C" void kernel_launch(void* const* d_in, const int* in_sizes, int n_in, void* d_out, int out_size, void* d_ws, size_t ws_size, hipStream_t stream) {
    static int grid = 0;
    if (grid == 0) {
        if (n_in != 20 || ws_size < WS_END) { fprintf(stderr, "kernel_launch: unexpected n_in %d or ws_size %zu (< %zu)\n", n_in, ws_size, (size_t)WS_END); grid = -1; return; }
        int dev = 0, cus = 0, per_cu = 0;
        if (hipGetDevice(&dev) != hipSuccess || hipDeviceGetAttribute(&cus, hipDeviceAttributeMultiprocessorCount, dev) != hipSuccess) { grid = -1; return; }
        if (hipFuncSetAttribute((const void*)fwd_kernel, hipFuncAttributeMaxDynamicSharedMemorySize, LDS_BYTES) != hipSuccess) { fprintf(stderr, "kernel_launch: hipFuncSetAttribute failed\n"); grid = -1; return; }
        if (hipOccupancyMaxActiveBlocksPerMultiprocessor(&per_cu, (const void*)fwd_kernel, NTHREADS, LDS_BYTES) != hipSuccess || per_cu < 1) { fprintf(stderr, "kernel_launch: occupancy query says %d blocks per CU\n", per_cu); (void)hipGetLastError(); grid = -1; return; }
        grid = cus;
    }
    if (grid < 0) return;
    Params p{};
    const float* const* in = (const float* const*)d_in;
    p.x = in[0]; p.c = in[1]; p.ctx = in[2]; p.c_ctx = in[3]; p.w_mod = in[4]; p.b_mod = in[5]; p.norm_w = in[6]; p.w_in = in[7]; p.hg_lb = in[8]; p.hg_nw = in[9];
    p.ret_dl = in[10]; p.ret_nw = in[11]; p.w_out = in[12]; p.rgw = in[13]; p.rgb = in[14]; p.rew = in[15]; p.reb = in[16]; p.w_gate = in[17]; p.w_up = in[18]; p.w_down = in[19];
    p.out = (float*)d_out; p.ws = (unsigned char*)d_ws;
#if MK_ONE_LAUNCH
    (void)hipMemsetAsync((char*)d_ws + WS_CTL + CTL_BAR, 0, XCD_BAR_WORDS * 4, stream);
    p.ph_lo = 0; p.ph_hi = NPHASE;
    void* args[] = {&p};
    hipError_t e = hipLaunchCooperativeKernel((const void*)fwd_kernel, dim3(grid), dim3(NTHREADS), args, LDS_BYTES, stream);
    if (e != hipSuccess) fprintf(stderr, "cooperative launch failed: %s (grid %d)\n", hipGetErrorString(e), grid);
#else
    for (int k = 0; k < NPHASE; ++k) { p.ph_lo = k; p.ph_hi = k + 1; hipLaunchKernelGGL(fwd_kernel, dim3(grid), dim3(NTHREADS), LDS_BYTES, stream, p); }
#endif
}
```

```cpp
#include <hip/hip_runtime.h>
#include <hip/hip_cooperative_groups.h>
#include <cstdio>
#include <cstdint>
namespace cg = cooperative_groups;

namespace pg8 {
#define PG8_LAS __attribute__((address_space(3)))
typedef unsigned short bf16_t;
typedef short bf16x8 __attribute__((ext_vector_type(8)));
typedef float f32x4 __attribute__((ext_vector_type(4)));
typedef unsigned u32x4 __attribute__((ext_vector_type(4)));
constexpr int BM = 256, BK = 64, HALF = 128, HTB = HALF * BK * 2  , STAGE_BYTES = 8 * HTB, NXCD = 8, WGM = 8;

__host__ __device__ __forceinline__ int lds_byte(int r, int c) { const int st = (r >> 4) * 2 + (c >> 5), rr = r & 15, cc = c & 31, ob = rr * 64 + cc * 2; return st * 1024 + (ob ^ (((ob >> 9) & 1) << 5)); }
__host__ __device__ __forceinline__ void stage_rc(int b, int& R, int& C) { const int st = b / 1024, sb = b % 1024, swz = sb ^ (((sb >> 9) & 1) << 5); R = (st >> 1) * 16 + swz / 64; C = (st & 1) * 32 + (swz % 64) / 2; }
__host__ __device__ __forceinline__ int perm32(int rho) { const int n = rho >> 4, i = rho & 15; return 8 * (i >> 2) + 4 * n + (i & 3); }

struct Unit { int pm, pn, pb; };
struct Gemm { const bf16_t* A; const bf16_t* Bt; int M, N, K; int scaleA, scaleB; };
typedef int v8i_t __attribute__((ext_vector_type(8)));
typedef int v4i_t __attribute__((ext_vector_type(4)));
typedef short s16x16_t __attribute__((ext_vector_type(16)));
__device__ __forceinline__ v8i_t cat8(short __attribute__((ext_vector_type(8))) lo, short __attribute__((ext_vector_type(8))) hi) {
    const v4i_t a = __builtin_bit_cast(v4i_t, lo), b = __builtin_bit_cast(v4i_t, hi); return __builtin_shufflevector(a, b, 0, 1, 2, 3, 4, 5, 6, 7); }

struct StaticOrder {
    int nM, nN, nwg, G, c;
    __host__ __device__ void init(int M, int N, int G_, int c_) { nM = M / BM; nN = N / BM; nwg = nM * nN; G = G_; c = c_; }
    __host__ __device__ bool next(int i, Unit& u) const {
        const long L = (long)i * G + c; if (L >= nwg) return false;
        int wgid = (int)L; { const int q = nwg / NXCD, r = nwg % NXCD, xcd = wgid % NXCD, off = wgid / NXCD; wgid = (xcd < r ? xcd * (q + 1) : r * (q + 1) + (xcd - r) * q) + off; }
        const int nig = WGM * nN, gid = wgid / nig, fm = gid * WGM, gsz = (nM - fm) < WGM ? (nM - fm) : WGM;
        u.pm = fm + ((wgid % nig) % gsz); u.pn = (wgid % nig) / gsz; u.pb = u.pn; return true;
    }
    __device__ __forceinline__ void a_ready(const Unit&) const {}
    __device__ __forceinline__ void done(const Unit&) const {}
};

__device__ __forceinline__ unsigned cvt_pk_bf16(float lo, float hi) { unsigned r; asm volatile("v_cvt_pk_bf16_f32 %0, %1, %2" : "=v"(r) : "v"(lo), "v"(hi)); return r; }
template <class Epi, class Sched, bool ALIGN_EPI = false, bool SP2 = false>
__device__ __forceinline__ void gemm_phase(PG8_LAS unsigned char* lds, const Gemm g, const Sched& S, const Epi& E) {
    const int tid = threadIdx.x, wid = __builtin_amdgcn_readfirstlane(tid >> 6), lane = tid & 63, wr = wid >> 2, wc = wid & 3, fr = lane & 15, fq = lane >> 4;
    const int K = g.K, nt = K / BK;
    unsigned voffA[2], voffB[2];
    { int R, C; stage_rc(tid * 16, R, C); voffA[0] = (unsigned)(R * K + C) * 2u; voffA[1] = 0u; voffB[0] = voffA[0]; voffB[1] = 0u; }
    const size_t istep = (size_t)64 * K * 2;
    const unsigned ldsbase = (unsigned)__builtin_amdgcn_readfirstlane((int)(unsigned)(size_t)lds + (int)((unsigned)wid * 1024u));
    const size_t kstep = (size_t)(BK * 2);
    const size_t hstep = (size_t)HALF * K * 2;
    const size_t tstep = 2 * hstep;
    const unsigned ldsw = (unsigned)wid * 1024u;
    const int aoffk[2] = { Epi::FP8 ? lds_byte(wr * 64 + fr, fq * 16) : lds_byte(wr * 64 + fr, fq * 8), Epi::FP8 ? lds_byte(wr * 64 + fr, fq * 16 + 8) : lds_byte(wr * 64 + fr, fq * 8) + 1024 };
    const int boffk[2] = { Epi::FP8 ? lds_byte(wc * 32 + fr, fq * 16) : lds_byte(wc * 32 + fr, fq * 8), Epi::FP8 ? lds_byte(wc * 32 + fr, fq * 16 + 8) : lds_byte(wc * 32 + fr, fq * 8) + 1024 };
#define PG8_SA(b, h) (((b) * 2 + (h)) * HTB)
#define PG8_SB(b, h) ((4 + (b) * 2 + (h)) * HTB)
#define PG8_STAGE(bufoff, gbase, voff) do { _Pragma("unroll") for (int _i = 0; _i < 2; ++_i) \
        { if constexpr (Epi::FP8) { unsigned keep_; asm volatile("s_mov_b32 %0, m0\n\ts_mov_b32 m0, %2\n\ts_nop 0\n\tglobal_load_lds_dwordx4 %1, %3\n\ts_mov_b32 m0, %0" : "=&s"(keep_) : "v"((voff)[0]), "s"(ldsbase + (unsigned)((bufoff) + _i * 8192)), "s"((const char*)(gbase) + _i * istep) : "memory"); } \
          else __builtin_amdgcn_global_load_lds((const unsigned*)((const char*)(gbase) + _i * istep + (voff)[0]), (PG8_LAS unsigned*)(lds + (bufoff) + ldsw + _i * 8192), 16, 0, 0); } } while (0)
#define PG8_LDA(dst, b, h) do { if constexpr (Epi::FP8) { _Pragma("unroll") for (int m = 0; m < 4; ++m) dst##8[m] = *(const PG8_LAS v8i_t*)(lds + PG8_SA(b, h) + aoffk[0] + m * 2048); } \
        else { _Pragma("unroll") for (int m = 0; m < 4; ++m) _Pragma("unroll") for (int k = 0; k < 2; ++k) dst[m][k] = *(const PG8_LAS bf16x8*)(lds + PG8_SA(b, h) + aoffk[k] + m * 2048); } } while (0)
#define PG8_LDB(dst, b, h) do { if constexpr (Epi::FP8) { _Pragma("unroll") for (int n = 0; n < 2; ++n) dst##8[n] = *(const PG8_LAS v8i_t*)(lds + PG8_SB(b, h) + boffk[0] + n * 2048); } \
        else { _Pragma("unroll") for (int n = 0; n < 2; ++n) _Pragma("unroll") for (int k = 0; k < 2; ++k) dst[n][k] = *(const PG8_LAS bf16x8*)(lds + PG8_SB(b, h) + boffk[k] + n * 2048); } } while (0)
#define PG8_MMA(ai, bj, At, Bt) do { __builtin_amdgcn_s_setprio(1); _Pragma("unroll") for (int m = 0; m < 4; ++m) _Pragma("unroll") for (int n = 0; n < 2; ++n) { \
        if constexpr (Epi::FP8) { acc[ai][bj][m][n] = __builtin_amdgcn_mfma_scale_f32_16x16x128_f8f6f4(Bt##8[n], At##8[m], acc[ai][bj][m][n], 0, 0, 1, g.scaleA, 0, g.scaleA); } \
        else { _Pragma("unroll") for (int k = 0; k < 2; ++k) acc[ai][bj][m][n] = __builtin_amdgcn_mfma_f32_16x16x32_bf16(Bt[n][k], At[m][k], acc[ai][bj][m][n], 0, 0, 0); } } \
        __builtin_amdgcn_s_setprio(0); } while (0)
#define PG8_WAIT_V(n) asm volatile("s_waitcnt vmcnt(" #n ")" ::: "memory")
#define PG8_WAIT_L(n) asm volatile("s_waitcnt lgkmcnt(" #n ")" ::: "memory")
#define PG8_BAR __builtin_amdgcn_s_barrier()
#define PG8_SCHED __builtin_amdgcn_sched_barrier(0)
    Unit cur, nxt; int ui = 0;
    if (!S.next(0, cur)) return;
    f32x4 acc[2][2][4][2];
#pragma unroll
    for (int a = 0; a < 2; ++a)
#pragma unroll
        for (int b = 0; b < 2; ++b)
#pragma unroll
            for (int m = 0; m < 4; ++m)
#pragma unroll
                for (int n = 0; n < 2; ++n) acc[a][b][m][n] = (f32x4){0.f, 0.f, 0.f, 0.f};
    bf16x8 At[4][2], B0[2][2], B1[2][2];
    v8i_t At8[4], B08[2], B18[2];
    const char* cA = (const char*)g.A + (size_t)cur.pm * tstep; const char* cB = (const char*)g.Bt + (size_t)cur.pb * tstep;
    S.a_ready(cur);
    if constexpr (SP2) {
        PG8_STAGE(PG8_SB(0, 0), cB, voffB); PG8_STAGE(PG8_SB(0, 1), cB + hstep, voffB); PG8_STAGE(PG8_SA(0, 0), cA, voffA); PG8_STAGE(PG8_SA(0, 1), cA + hstep, voffA);
        if (wr == 1) PG8_BAR;
        PG8_WAIT_V(2); PG8_BAR;
        PG8_STAGE(PG8_SB(1, 0), cB + kstep, voffB); PG8_STAGE(PG8_SA(1, 0), cA + kstep, voffA); PG8_STAGE(PG8_SB(1, 1), cB + hstep + kstep, voffB);
        PG8_WAIT_V(6); PG8_BAR;
    } else {
        PG8_STAGE(PG8_SB(0, 0), cB, voffB); PG8_STAGE(PG8_SA(0, 0), cA, voffA); PG8_STAGE(PG8_SB(0, 1), cB + hstep, voffB); PG8_STAGE(PG8_SA(0, 1), cA + hstep, voffA);
        if (wr == 1) PG8_BAR;
        PG8_WAIT_V(4); PG8_BAR;
        PG8_STAGE(PG8_SB(1, 0), cB + kstep, voffB); PG8_STAGE(PG8_SA(1, 0), cA + kstep, voffA); PG8_STAGE(PG8_SB(1, 1), cB + hstep + kstep, voffB);
        PG8_WAIT_V(6); PG8_BAR;
    }
    for (;;) {
        const bool has_next = S.next(ui + 1, nxt);
        const char* nA = has_next ? (const char*)g.A + (size_t)nxt.pm * tstep : cA; const char* nB = has_next ? (const char*)g.Bt + (size_t)nxt.pb * tstep : cB;
#pragma unroll 1
        for (int t = 0; t < nt; t += 2) {
            const bool last = (t == nt - 2);
            const char* a1 = cA + (size_t)(t + 1) * kstep;
            const char* a2 = last ? nA : cA + (size_t)(t + 2) * kstep; const char* b2 = last ? nB : cB + (size_t)(t + 2) * kstep;
            const char* a3 = a2 + kstep; const char* b3 = b2 + kstep;
            if (last && has_next) S.a_ready(nxt);
            if constexpr (SP2) {
            PG8_LDB(B0, 0, 0); PG8_LDB(B1, 0, 1); PG8_SCHED; PG8_LDA(At, 0, 0); PG8_STAGE(PG8_SA(1, 1), a1 + hstep, voffA);
            PG8_WAIT_V(8); PG8_WAIT_L(0); PG8_BAR; PG8_MMA(0, 0, At, B0); PG8_MMA(0, 1, At, B1); PG8_BAR; PG8_SCHED;
            PG8_LDA(At, 0, 1); PG8_STAGE(PG8_SB(0, 0), b2, voffB); PG8_STAGE(PG8_SB(0, 1), b2 + hstep, voffB); PG8_STAGE(PG8_SA(0, 0), a2, voffA);
            PG8_WAIT_V(8); PG8_WAIT_L(0); PG8_BAR; PG8_MMA(1, 0, At, B0); PG8_MMA(1, 1, At, B1); PG8_BAR; PG8_SCHED;
            PG8_LDB(B0, 1, 0); PG8_LDB(B1, 1, 1); PG8_SCHED; PG8_LDA(At, 1, 0); PG8_STAGE(PG8_SA(0, 1), a2 + hstep, voffA);
            PG8_WAIT_V(8); PG8_WAIT_L(0); PG8_BAR; PG8_MMA(0, 0, At, B0); PG8_MMA(0, 1, At, B1); PG8_BAR; PG8_SCHED;
            PG8_LDA(At, 1, 1); PG8_STAGE(PG8_SB(1, 0), b3, voffB); PG8_STAGE(PG8_SB(1, 1), b3 + hstep, voffB); PG8_STAGE(PG8_SA(1, 0), a3, voffA);
            PG8_WAIT_V(8); PG8_WAIT_L(0); PG8_BAR; PG8_MMA(1, 0, At, B0); PG8_MMA(1, 1, At, B1); PG8_BAR; PG8_SCHED;
            } else {
            PG8_LDB(B0, 0, 0); PG8_SCHED; PG8_LDA(At, 0, 0); PG8_STAGE(PG8_SA(1, 1), a1 + hstep, voffA);
            PG8_WAIT_L(8); PG8_BAR; PG8_WAIT_L(0); PG8_MMA(0, 0, At, B0); PG8_BAR; PG8_SCHED;
            PG8_LDB(B1, 0, 1); PG8_STAGE(PG8_SB(0, 0), b2, voffB);
            PG8_BAR; PG8_WAIT_L(0); PG8_MMA(0, 1, At, B1); PG8_BAR;
            PG8_LDA(At, 0, 1); PG8_STAGE(PG8_SA(0, 0), a2, voffA);
            PG8_BAR; PG8_WAIT_L(0); PG8_MMA(1, 0, At, B0); PG8_BAR; PG8_SCHED;
            PG8_STAGE(PG8_SB(0, 1), b2 + hstep, voffB);
            PG8_WAIT_V(6); PG8_BAR; PG8_MMA(1, 1, At, B1); PG8_BAR;
            PG8_LDB(B0, 1, 0); PG8_SCHED; PG8_LDA(At, 1, 0); PG8_STAGE(PG8_SA(0, 1), a2 + hstep, voffA);
            PG8_WAIT_L(8); PG8_BAR; PG8_WAIT_L(0); PG8_MMA(0, 0, At, B0); PG8_BAR; PG8_SCHED;
            PG8_LDB(B1, 1, 1); PG8_STAGE(PG8_SB(1, 0), b3, voffB);
            PG8_BAR; PG8_WAIT_L(0); PG8_MMA(0, 1, At, B1); PG8_BAR;
            PG8_LDA(At, 1, 1); PG8_STAGE(PG8_SA(1, 0), a3, voffA);
            PG8_BAR; PG8_WAIT_L(0); PG8_MMA(1, 0, At, B0); PG8_BAR; PG8_SCHED;
            PG8_STAGE(PG8_SB(1, 1), b3 + hstep, voffB);
            PG8_WAIT_V(6); PG8_BAR; PG8_MMA(1, 1, At, B1); PG8_BAR;
            }
        }
        if constexpr (ALIGN_EPI) { if (wr == 0) PG8_BAR; }
        if constexpr (!Epi::AFTER_DRAIN) { E(acc, cur, wr, wc, fr, fq); S.done(cur); }
        if (!has_next) break;
#pragma unroll
        for (int a = 0; a < 2; ++a)
#pragma unroll
            for (int b = 0; b < 2; ++b)
#pragma unroll
                for (int m = 0; m < 4; ++m)
#pragma unroll
                    for (int n = 0; n < 2; ++n) acc[a][b][m][n] = (f32x4){0.f, 0.f, 0.f, 0.f};
        cur = nxt; cA = nA; cB = nB; ++ui;
        if constexpr (ALIGN_EPI) { if (wr == 1) PG8_BAR; }
    }
    PG8_WAIT_V(0);
    if constexpr (!ALIGN_EPI) { if (wr == 0) PG8_BAR; }
    PG8_BAR;
    if constexpr (Epi::AFTER_DRAIN) { E.fused(acc, cur, wr, wc, fr, fq, lds, wid, lane); S.done(cur); }
#undef PG8_SA
#undef PG8_SB
#undef PG8_STAGE
#undef PG8_LDA
#undef PG8_LDB
#undef PG8_MMA
#undef PG8_WAIT_V
#undef PG8_WAIT_L
#undef PG8_BAR
#undef PG8_SCHED
}
}
#define LAS __attribute__((address_space(3)))
typedef unsigned short bf16_t;
typedef short bf16x8 __attribute__((ext_vector_type(8)));
typedef float f32x4 __attribute__((ext_vector_type(4)));
typedef float f32x2 __attribute__((ext_vector_type(2)));
typedef unsigned u32x4 __attribute__((ext_vector_type(4)));
typedef unsigned u32x2 __attribute__((ext_vector_type(2)));

constexpr int DM = 2048, SEQ = 8192, CTXL = 256, MT = SEQ + CTXL, PW = 8192;
constexpr int NCH = MT / 64  , NXCH = SEQ / 64  , NCCH = CTXL / 64  ;
constexpr int NE = 32, DE = 1024, NGRP = 256  ;
constexpr float EPS = 1e-6f;
constexpr int NWAVES = 8, NTHREADS = 512;
constexpr int LDS_BYTES = 147456;

constexpr size_t MiB = 1u << 20;
constexpr size_t WS_WTGU = 0, WS_WTD = 256 * MiB, WS_CTL = 384 * MiB, WS_WTIN = 388 * MiB, WS_WTOUT = 420 * MiB;
constexpr size_t WS_H = 428 * MiB, WS_Q = 461 * MiB, WS_GF = 478 * MiB, WS_GB = 511 * MiB, WS_V = 544 * MiB, WS_HGATE = 561 * MiB;
constexpr size_t WS_RQ = 578 * MiB, WS_RK = 587 * MiB, WS_RV = 596 * MiB, WS_RGATE = 613 * MiB;
constexpr size_t WS_LOCAL = 630 * MiB, WS_DEC = 762 * MiB, WS_SST = 764 * MiB, WS_PREOUT = 892 * MiB, WS_END = 924 * MiB;
constexpr size_t WS_OUTX = 428 * MiB, WS_HX2 = 492 * MiB, WS_XS = 524 * MiB, WS_GACT = 620 * MiB, WS_YB = 668 * MiB;
constexpr size_t CTL_MODP = 0, CTL_LB = 256 * 1024, CTL_CNT = 272 * 1024, CTL_ROUTE = 304 * 1024, CTL_SLOT = 432 * 1024, CTL_TILES = 496 * 1024, CTL_WR = 512 * 1024, CTL_BAR = 1024 * 1024;
constexpr int MISC_OFF = LDS_BYTES - 256;
constexpr size_t LOCAL_RET_OFF = (size_t)2 * 8 * NCH * 128 * 128 * 2;
constexpr size_t SST_RET_OFF = (size_t)2 * 8 * NXCH * 128 * 128 * 2;
constexpr int DEC_RET_ITEM0 = 2 * 8 * NCH;

struct Params {
    const float *x, *c, *ctx, *c_ctx, *w_mod, *b_mod, *norm_w, *w_in, *hg_lb, *hg_nw, *ret_dl, *ret_nw, *w_out, *rgw, *rgb, *rew, *reb, *w_gate, *w_up, *w_down;
    float* out; unsigned char* ws;
    int ph_lo, ph_hi;
};

#define LDS_WAIT() asm volatile("s_waitcnt lgkmcnt(0)" ::: "memory")
__device__ __forceinline__ unsigned f2bf(float f) { unsigned u = __builtin_bit_cast(unsigned, f); return (u + 0x7fffu + ((u >> 16) & 1u)) >> 16; }
typedef __bf16 bf16x2_hw __attribute__((ext_vector_type(2)));
__device__ __forceinline__ unsigned pk2(float lo, float hi) { const f32x2 v = {lo, hi}; return __builtin_bit_cast(unsigned, __builtin_convertvector(v, bf16x2_hw)); }
__device__ __forceinline__ unsigned pk4_fp8(float a, float b, float c, float d) { int w = 0; w = __builtin_amdgcn_cvt_pk_fp8_f32(a, b, w, false); w = __builtin_amdgcn_cvt_pk_fp8_f32(c, d, w, true); return (unsigned)w; }
typedef _Float16 h16x2 __attribute__((ext_vector_type(2)));
__device__ __forceinline__ unsigned pk2h(float a, float b) { const f32x2 v = {a, b}; return __builtin_bit_cast(unsigned, __builtin_convertvector(v, h16x2)); }
__device__ __forceinline__ f32x2 unpk2h(unsigned w) { return __builtin_convertvector(__builtin_bit_cast(h16x2, w), f32x2); }
__device__ __forceinline__ float bflo(unsigned w) { return __builtin_bit_cast(float, w << 16); }
__device__ __forceinline__ float bfhi(unsigned w) { return __builtin_bit_cast(float, w & 0xffff0000u); }
__device__ __forceinline__ float silu_f(float z) { return z * __builtin_amdgcn_rcpf(1.f + __expf(-z)); }
__device__ __forceinline__ float sigmoid_f(float z) { return __builtin_amdgcn_rcpf(1.f + __expf(-z)); }
__device__ __forceinline__ float wave_sum(float v) {
#pragma unroll
    for (int o = 1; o < 64; o <<= 1) v += __shfl_xor(v, o);
    return v;
}
__device__ __forceinline__ f32x4 mfma16(bf16x8 a, bf16x8 b, f32x4 c) { return __builtin_amdgcn_mfma_f32_16x16x32_bf16(a, b, c, 0, 0, 0); }
__device__ __forceinline__ float log_sigmoid_f(float z) { return fminf(z, 0.f) - log1pf(__expf(-fabsf(z))); }

__device__ __forceinline__ void p0_gemv(const Params& p, LAS unsigned char* lds) {
    const int tid = threadIdx.x, wave = tid >> 6, lane = tid & 63;
    float* modp = (float*)(p.ws + WS_CTL + CTL_MODP);
    LAS float* red = (LAS float*)lds;
    for (int it = blockIdx.x; it < 192; it += gridDim.x) {
        const int cb = it % 48, kq = it / 48;
        const int col = cb * 256 + lane * 4;
        const int r0 = kq * 512 + wave * 64;
        const bool hasc = cb < 16;
        f32x4 ax = {0.f, 0.f, 0.f, 0.f}, ac = {0.f, 0.f, 0.f, 0.f};
        for (int r = 0; r < 64; r += 16) {
            f32x4 w[16];
#pragma unroll
            for (int i = 0; i < 16; ++i) w[i] = *(const f32x4*)(p.w_mod + (size_t)(r0 + r + i) * 12288 + col);
#pragma unroll
            for (int i = 0; i < 16; ++i) {
                const float sx = silu_f(p.c[r0 + r + i]); ax += w[i] * sx;
                if (hasc) { const float sc = silu_f(p.c_ctx[r0 + r + i]); ac += w[i] * sc; }
            }
        }
        *(LAS f32x4*)(red + (wave * 2 + 0) * 256 + lane * 4) = ax;
        *(LAS f32x4*)(red + (wave * 2 + 1) * 256 + lane * 4) = ac;
        __syncthreads();
        const int vsel = tid >> 8, cc = tid & 255;
        float s = 0.f;
#pragma unroll
        for (int w8 = 0; w8 < 8; ++w8) s += red[(w8 * 2 + vsel) * 256 + cc];
        if (vsel == 0) modp[kq * 16384 + cb * 256 + cc] = s; else if (hasc) modp[kq * 16384 + 12288 + cb * 256 + cc] = s;
        __syncthreads();
    }
}
__device__ __forceinline__ void transpose_item(const float* W, int ldw, int K, int k0, int n0src, bf16_t* WT, size_t drow0, LAS float* scr, int lane) {
    f32x4 v[16];
    const int rr = lane >> 4, c4 = (lane & 15) * 4;
#pragma unroll
    for (int i = 0; i < 16; ++i) v[i] = *(const f32x4*)(W + (size_t)(k0 + rr + 4 * i) * ldw + n0src + c4);
#pragma unroll
    for (int i = 0; i < 16; ++i) { LAS float* d = scr + (rr + 4 * i) * 65 + c4; d[0] = v[i][0]; d[1] = v[i][1]; d[2] = v[i][2]; d[3] = v[i][3]; }
    LDS_WAIT(); asm volatile("" ::: "memory");
    const int c = lane & 7;
#pragma unroll
    for (int j = 0; j < 8; ++j) {
        const int n = (lane >> 3) + 8 * j; const LAS float* s = scr + (8 * c) * 65 + n;
        u32x4 o; o.x = pk2(s[0 * 65], s[1 * 65]); o.y = pk2(s[2 * 65], s[3 * 65]); o.z = pk2(s[4 * 65], s[5 * 65]); o.w = pk2(s[6 * 65], s[7 * 65]);
        *(u32x4*)(WT + (drow0 + n) * (size_t)K + k0 + 8 * c) = o;
    }
    LDS_WAIT(); asm volatile("" ::: "memory");
}
constexpr int TI_IN = 32 * 128, TI_OUT = 32 * 32, TI_G = 32 * 32 * 16, TI_D = 32 * 16 * 32;
#ifndef CONV_N5
#define CONV_N5 4
#endif
__device__ __forceinline__ void transpose_dispatch(const Params& p, LAS unsigned char* lds, int it, int wave, int lane) {
    LAS float* scr = (LAS float*)(lds + wave * 16640);
    bf16_t* WTIN = (bf16_t*)(p.ws + WS_WTIN); bf16_t* WTOUT = (bf16_t*)(p.ws + WS_WTOUT); bf16_t* WTGU = (bf16_t*)(p.ws + WS_WTGU); bf16_t* WTD = (bf16_t*)(p.ws + WS_WTD);
    int r = it;
    if (r < TI_IN) {
        const int kb = r / 128, nb = r % 128; const int drow = nb * 64, pn = drow >> 8;
        int src = drow;
        if (pn >= 20 && pn < 24) { const int q4 = (drow & 255) >> 6, bj = q4 >> 1, hl = q4 & 1; const int pn0 = pn >= 22 ? 22 : 20; src = (pn >= 22 ? 5632 : 5120) + ((pn - pn0) * 2 + hl) * 128 + bj * 64; }
        transpose_item(p.w_in, PW, DM, kb * 64, src, WTIN, (size_t)drow, scr, lane); return; }
    r -= TI_IN;
    if (r < TI_OUT) { const int kb = r / 32, nb = r % 32; transpose_item(p.w_out, DM, DM, kb * 64, nb * 64, WTOUT, (size_t)nb * 64, scr, lane); return; }
    r -= TI_OUT;
    if (r < 2 * TI_G) {
        const int isup = r >= TI_G; if (isup) r -= TI_G;
        const int e = r / 512, rem = r % 512, kb = rem / 16, nb = rem % 16, n0 = nb * 64;
        const float* W = (isup ? p.w_up : p.w_gate) + (size_t)e * DM * DE;
        transpose_item(W, DE, DM, kb * 64, n0, WTGU, (size_t)e * 2048 + (n0 >> 7) * 256 + isup * 128 + (n0 & 127), scr, lane); return; }
    r -= 2 * TI_G;
    { const int e = r / 512, rem = r % 512, kb = rem / 32, nb = rem % 32;
      transpose_item(p.w_down + (size_t)e * DE * DM, DM, DE, kb * 64, nb * 64, WTD, (size_t)e * 2048 + nb * 64, scr, lane); }
}
__device__ __forceinline__ void p0_prologue(const Params& p, LAS unsigned char* lds) {
    const int tid = threadIdx.x, wave = __builtin_amdgcn_readfirstlane(tid >> 6), lane = tid & 63;
    p0_gemv(p, lds);
    {
        float* LB = (float*)(p.ws + WS_CTL + CTL_LB); float* WR = (float*)(p.ws + WS_CTL + CTL_WR);
        const int gt = blockIdx.x * NTHREADS + tid, NT = gridDim.x * NTHREADS;
        for (int i = gt; i < 2048; i += NT) { const float l0 = p.hg_lb[i], l1 = p.hg_lb[2048 + i]; LB[i] = 1.f / (1.f + __expf(l1 - l0)); }
        for (int i = gt; i < 36 * 2048; i += NT) { const int o = i >> 11, k = i & 2047; WR[i] = (o < 4) ? p.rgw[k * 4 + o] : p.rew[k * 32 + (o - 4)]; }
    }
    const int gw = blockIdx.x * NWAVES + wave, NGW = gridDim.x * NWAVES;
    for (int it = gw; it < TI_IN + TI_OUT; it += NGW) transpose_dispatch(p, lds, it, wave, lane);
}
struct CvItem { const float* src; unsigned char* dst; int ldw, K; };
constexpr float W8_SCALE = 32.f;
__device__ __forceinline__ CvItem cv_item(const Params& p, int r) {
    CvItem c;
    if (r < 2 * TI_G) { const int isup = r >= TI_G; if (isup) r -= TI_G;
        const int e = r / 512, rem = r % 512, kb = rem / 32, nb = rem % 32, n0 = nb * 32;
        c.src = (isup ? p.w_up : p.w_gate) + (size_t)e * DM * DE + (size_t)(kb * 128) * DE + n0; c.ldw = DE; c.K = DM;
        c.dst = (unsigned char*)(p.ws + WS_WTGU) + ((size_t)e * 2048 + (n0 >> 7) * 256 + isup * 128 + (n0 & 127)) * DM + kb * 128; }
    else { r -= 2 * TI_G; const int e = r / 512, rem = r % 512, kb = rem / 64, nb = rem % 64;
        c.src = p.w_down + (size_t)e * DE * DM + (size_t)(kb * 128) * DM + nb * 32; c.ldw = DM; c.K = DE;
        c.dst = (unsigned char*)(p.ws + WS_WTD) + ((size_t)e * 2048 + nb * 32) * DE + kb * 128; }
    return c;
}
__device__ __forceinline__ void cv_load(const CvItem& c, f32x4 (&v)[16], int lane) {
    const float* s = c.src + (size_t)(4 * (lane >> 3)) * c.ldw + (lane & 7) * 4;
#pragma unroll
    for (int i = 0; i < 16; ++i) v[i] = __builtin_nontemporal_load((const f32x4*)(s + (size_t)(32 * (i >> 2) + (i & 3)) * c.ldw));
}
__device__ __forceinline__ void cv_store(const CvItem& c, const f32x4 (&v)[16], LAS float* scr, int lane) {
    LAS unsigned char* img = (LAS unsigned char*)scr;
    const int kq = lane >> 3, nq = lane & 7;
#pragma unroll
    for (int gi = 0; gi < 4; ++gi) {
        unsigned q[4];
#pragma unroll
        for (int sub = 0; sub < 4; ++sub) { const f32x4 x = v[4 * gi + sub] * W8_SCALE; q[sub] = pk4_fp8(x[0], x[1], x[2], x[3]); }
        const unsigned t0 = __builtin_amdgcn_perm(q[1], q[0], 0x05010400u), t1 = __builtin_amdgcn_perm(q[1], q[0], 0x07030602u);
        const unsigned t2 = __builtin_amdgcn_perm(q[3], q[2], 0x05010400u), t3 = __builtin_amdgcn_perm(q[3], q[2], 0x07030602u);
        const unsigned w0 = __builtin_amdgcn_perm(t2, t0, 0x05040100u), w1 = __builtin_amdgcn_perm(t2, t0, 0x07060302u);
        const unsigned w2 = __builtin_amdgcn_perm(t3, t1, 0x05040100u), w3 = __builtin_amdgcn_perm(t3, t1, 0x07060302u);
        LAS unsigned char* d = img + (4 * nq) * 144 + 32 * gi + 4 * kq;
        *(LAS unsigned*)(d) = w0; *(LAS unsigned*)(d + 144) = w1; *(LAS unsigned*)(d + 288) = w2; *(LAS unsigned*)(d + 432) = w3;
    }
    LDS_WAIT(); asm volatile("" ::: "memory");
#pragma unroll
    for (int j = 0; j < 4; ++j) {
        const int n = (lane >> 3) + 8 * j, cc = lane & 7;
        const u32x4 o = *(const LAS u32x4*)(img + n * 144 + 16 * cc);
        __builtin_nontemporal_store(o, (u32x4*)(c.dst + (size_t)n * c.K + 16 * cc));
    }
    LDS_WAIT(); asm volatile("" ::: "memory");
}
__device__ __forceinline__ void p2_convert(const Params& p, LAS unsigned char* lds, int c, int G) {
    int tid_ = threadIdx.x; asm volatile("" : "+v"(tid_));
    const int wave = __builtin_amdgcn_readfirstlane(tid_ >> 6), lane = tid_ & 63;
    LAS float* scr = (LAS float*)(lds + wave * 4608);
    constexpr int NG = (2 * TI_G + TI_D) / 8;
    int g0, g1;
    if (G == 256) { if (c < 32) { g0 = CONV_N5 * c; g1 = g0 + CONV_N5; } else { const int q = c - 32; constexpr int n4 = (NG - 32 * CONV_N5) / 224, ex = (NG - 32 * CONV_N5) % 224; g0 = 32 * CONV_N5 + q * n4 + (q < ex ? q : ex); g1 = g0 + n4 + (q < ex ? 1 : 0); } }
    else { const int per = (NG + G - 1) / G; g0 = c * per; g1 = g0 + per; if (g1 > NG) g1 = NG; }
    if (g0 >= g1) return;
    f32x4 va[16], vb[16];
    int g = g0; CvItem ia = cv_item(p, g * 8 + wave), ib = ia; cv_load(ia, va, lane);
    for (;;) {
        bool has = g + 1 < g1; if (has) { ib = cv_item(p, (g + 1) * 8 + wave); cv_load(ib, vb, lane); }
        cv_store(ia, va, scr, lane);
        if (!has) break;
        ++g; has = g + 1 < g1; if (has) { ia = cv_item(p, (g + 1) * 8 + wave); cv_load(ia, va, lane); }
        cv_store(ib, vb, scr, lane);
        if (!has) break;
        ++g;
    }
    asm volatile("s_waitcnt vmcnt(0)" ::: "memory");
}

__device__ __forceinline__ void mod_reduce_to_lds(const Params& p, LAS float* dst, int j0, int n, bool ctxvec) {
    const float* modp = (const float*)(p.ws + WS_CTL + CTL_MODP);
    for (int i = threadIdx.x * 4; i < n; i += NTHREADS * 4) {
        const int j = j0 + i; const int jj = ctxvec ? 12288 + j : j;
        const f32x4 a = *(const f32x4*)(modp + jj), b = *(const f32x4*)(modp + 16384 + jj), c = *(const f32x4*)(modp + 2 * 16384 + jj), d = *(const f32x4*)(modp + 3 * 16384 + jj), e = *(const f32x4*)(p.b_mod + j);
        *(LAS f32x4*)(dst + i) = ((a + b) + (c + d)) + e;
    }
}
__device__ __forceinline__ void p1_hrows(const Params& p, LAS unsigned char* lds) {
    const int tid = threadIdx.x, wave = tid >> 6, lane = tid & 63;
    LAS float* SH = (LAS float*)lds; LAS float* SC = SH + 2048; LAS float* CSH = SC + 2048; LAS float* CSC = CSH + 2048;
    mod_reduce_to_lds(p, SH, 0, 2048, false); mod_reduce_to_lds(p, SC, 2048, 2048, false);
    mod_reduce_to_lds(p, CSH, 0, 2048, true); mod_reduce_to_lds(p, CSC, 2048, 2048, true);
    __syncthreads();
    bf16_t* H = (bf16_t*)(p.ws + WS_H);
    const int gw = blockIdx.x * NWAVES + wave, NGW = gridDim.x * NWAVES;
    for (int m = gw; m < MT; m += NGW) {
        const bool isc = m < CTXL;
        const float* xr = isc ? p.ctx + (size_t)m * DM : p.x + (size_t)(m - CTXL) * DM;
        const LAS float* sh = isc ? CSH : SH; const LAS float* sc = isc ? CSC : SC;
        f32x4 v[8]; float ss = 0.f;
#pragma unroll
        for (int j = 0; j < 8; ++j) { v[j] = *(const f32x4*)(xr + 4 * (lane + 64 * j)); ss += (v[j][0] * v[j][0] + v[j][1] * v[j][1]) + (v[j][2] * v[j][2] + v[j][3] * v[j][3]); }
        const float rstd = rsqrtf(wave_sum(ss) * (1.f / DM) + EPS);
#pragma unroll
        for (int j = 0; j < 8; ++j) {
            const int col = 4 * (lane + 64 * j);
            const f32x4 nw = *(const f32x4*)(p.norm_w + col); const f32x4 a = *(const LAS f32x4*)(sc + col); const f32x4 b = *(const LAS f32x4*)(sh + col);
            const f32x4 o = (v[j] * rstd * nw) * (a + 1.f) + b;
            u32x2 w; w.x = pk2(o[0], o[1]); w.y = pk2(o[2], o[3]);
            *(u32x2*)(H + (size_t)m * DM + col) = w;
        }
    }
}

struct EpiF32 {
    static constexpr bool PERM = false, AFTER_DRAIN = false, FP8 = false;
    float* C; int ldc;
    __device__ __forceinline__ void operator()(const f32x4 (&acc)[2][2][4][2], const pg8::Unit& u, int wr, int wc, int fr, int fq) const {
        const int row0 = u.pm * 256 + wr * 64 + fr, col0 = u.pn * 256 + wc * 32 + 4 * fq;
#pragma unroll
        for (int ai = 0; ai < 2; ++ai)
#pragma unroll
            for (int m = 0; m < 4; ++m) { float* rowp = C + (size_t)(row0 + ai * 128 + m * 16) * ldc + col0;
#pragma unroll
                for (int bj = 0; bj < 2; ++bj)
#pragma unroll
                    for (int n = 0; n < 2; ++n) *(f32x4*)(rowp + bj * 128 + n * 16) = acc[ai][bj][m][n]; }
    }
};
template <bool F8> struct EpiBf16P {
    static constexpr bool PERM = false, AFTER_DRAIN = false, FP8 = F8;
    bf16_t* C; int ldc;
    __device__ __forceinline__ void operator()(const f32x4 (&acc)[2][2][4][2], const pg8::Unit& u, int wr, int wc, int fr_, int fq_) const {
        int l_ = threadIdx.x; asm volatile("" : "+v"(l_)); const int fr = l_ & 15, fq = (l_ >> 4) & 3;
        const int row0 = u.pm * 256 + wr * 64 + fr, col0 = u.pn * 256 + wc * 32 + 4 * fq;
#pragma unroll
        for (int ai = 0; ai < 2; ++ai)
#pragma unroll
            for (int m = 0; m < 4; ++m) { bf16_t* rowp = C + (size_t)(row0 + ai * 128 + m * 16) * ldc + col0;
#pragma unroll
                for (int bj = 0; bj < 2; ++bj)
#pragma unroll
                    for (int n = 0; n < 2; ++n) { const f32x4 v = acc[ai][bj][m][n]; u32x2 w; w.x = pk2(v[0], v[1]); w.y = pk2(v[2], v[3]); *(u32x2*)(rowp + bj * 128 + n * 16) = w; } }
    }
};
struct EpiGateUp {
    static constexpr bool PERM = false, AFTER_DRAIN = false, FP8 = true;
    unsigned char* G;
    __device__ __forceinline__ void operator()(const f32x4 (&acc)[2][2][4][2], const pg8::Unit& u, int wr, int wc, int fr_, int fq_) const {
        int l_ = threadIdx.x; asm volatile("" : "+v"(l_)); const int fr = l_ & 15, fq = (l_ >> 4) & 3;
        const int row0 = u.pm * 256 + wr * 64 + fr, col0 = u.pn * 128 + wc * 32 + 4 * fq;
#pragma unroll
        for (int ai = 0; ai < 2; ++ai)
#pragma unroll
            for (int m = 0; m < 4; ++m) { unsigned char* rowp = G + (size_t)(row0 + ai * 128 + m * 16) * DE + col0;
#pragma unroll
                for (int n = 0; n < 2; ++n) { const f32x4 g = acc[ai][0][m][n], up = acc[ai][1][m][n];
                    *(unsigned*)(rowp + n * 16) = pk4_fp8(silu_f(g[0]) * up[0], silu_f(g[1]) * up[1], silu_f(g[2]) * up[2], silu_f(g[3]) * up[3]); } }
    }
};
struct EpiProj {
    static constexpr bool PERM = false, AFTER_DRAIN = false, FP8 = false;
    unsigned char* ws;
    __device__ __forceinline__ void store_bf16(bf16_t* base, int ld, int colt, int mode, const f32x4 (&acc)[2][2][4][2], int row0, int wc, int fq) const {
#pragma unroll
        for (int ai = 0; ai < 2; ++ai)
#pragma unroll
            for (int m = 0; m < 4; ++m) { bf16_t* rowp = base + (size_t)(row0 + ai * 128 + m * 16) * ld + colt + wc * 32 + 4 * fq;
#pragma unroll
                for (int bj = 0; bj < 2; ++bj)
#pragma unroll
                    for (int n = 0; n < 2; ++n) { f32x4 v = acc[ai][bj][m][n];
                        if (mode == 1) { v[0] = silu_f(v[0]); v[1] = silu_f(v[1]); v[2] = silu_f(v[2]); v[3] = silu_f(v[3]); }
                        u32x2 w; w.x = pk2(v[0], v[1]); w.y = pk2(v[2], v[3]);
                        *(u32x2*)(rowp + bj * 128 + n * 16) = w; } }
    }
    __device__ __forceinline__ void operator()(const f32x4 (&acc)[2][2][4][2], const pg8::Unit& u, int wr, int wc, int fr, int fq) const {
        const int pn = u.pn, row0 = u.pm * 256 + wr * 64 + fr;
        if (pn < 4) { store_bf16((bf16_t*)(ws + WS_Q), 1024, pn * 256, 1, acc, row0, wc, fq); return; }
        if (pn < 12) {
            const int d = pn >= 8; _Float16* Gp = (_Float16*)(ws + (d ? WS_GB : WS_GF)); const float* LB = (const float*)(ws + WS_CTL + CTL_LB) + d * 1024;
            const int colt = (pn - (d ? 8 : 4)) * 256 + wc * 32 + 4 * fq;
#pragma unroll
            for (int bj = 0; bj < 2; ++bj)
#pragma unroll
                for (int n = 0; n < 2; ++n) { const int col = colt + bj * 128 + n * 16; const f32x4 lb = *(const f32x4*)(LB + col);
#pragma unroll
                    for (int ai = 0; ai < 2; ++ai)
#pragma unroll
                        for (int m = 0; m < 4; ++m) { const f32x4 z = acc[ai][bj][m][n]; f32x4 g;
#pragma unroll
                            for (int j = 0; j < 4; ++j) g[j] = __logf(lb[j] + (1.f - lb[j]) * sigmoid_f(z[j]));
                            u32x2 w; w.x = pk2h(g[0], g[1]); w.y = pk2h(g[2], g[3]); *(u32x2*)(Gp + (size_t)(row0 + ai * 128 + m * 16) * 1024 + col) = w; } }
            return; }
        if (pn < 16) { store_bf16((bf16_t*)(ws + WS_V), 1024, (pn - 12) * 256, 0, acc, row0, wc, fq); return; }
        if (pn < 20) { store_bf16((bf16_t*)(ws + WS_HGATE), 1024, (pn - 16) * 256, 1, acc, row0, wc, fq); return; }
        if (pn < 24) {
            const bool isk = pn >= 22; bf16_t* O = (bf16_t*)(ws + (isk ? WS_RK : WS_RQ)); const float scl = isk ? 0.08838834764831845f : 1.f;
            const int head = (pn - (isk ? 22 : 20)) * 2 + (wc >> 1); const bool colang = (wc & 1) != 0; const bool ropeon = u.pm > 0;
#pragma unroll
            for (int ai = 0; ai < 2; ++ai)
#pragma unroll
                for (int m = 0; m < 4; ++m) { const int row = row0 + ai * 128 + m * 16; const int t = row - CTXL; const float pos = (float)(colang ? (t & 63) : (t >> 6));
#pragma unroll
                    for (int n = 0; n < 2; ++n) { const int i0 = 16 * n + 4 * fq; const f32x4 x1 = acc[ai][0][m][n], x2 = acc[ai][1][m][n]; f32x4 o1, o2;
#pragma unroll
                        for (int j = 0; j < 4; ++j) { float cs = 1.f, sn = 0.f;
                            if (ropeon) { const float ang = pos * exp2f(-(float)(i0 + j) * 0.41524101186092029f); cs = __cosf(ang); sn = __sinf(ang); }
                            o1[j] = (x1[j] * cs - x2[j] * sn) * scl; o2[j] = (x1[j] * sn + x2[j] * cs) * scl; }
                        bf16_t* dp = O + (size_t)row * 512 + head * 128 + 32 * (wc & 1) + i0;
                        u32x2 w; w.x = pk2(o1[0], o1[1]); w.y = pk2(o1[2], o1[3]); *(u32x2*)dp = w;
                        w.x = pk2(o2[0], o2[1]); w.y = pk2(o2[2], o2[3]); *(u32x2*)(dp + 64) = w; } }
            return; }
        if (pn < 28) { store_bf16((bf16_t*)(ws + WS_RV), 1024, (pn - 24) * 256, 0, acc, row0, wc, fq); return; }
        store_bf16((bf16_t*)(ws + WS_RGATE), 1024, (pn - 28) * 256, 1, acc, row0, wc, fq);
    }
};
struct MoeOrder {
    const int* tiles; int G, c;
    __device__ __forceinline__ bool next(int i, pg8::Unit& u) const {
        const int nt = tiles[0]; const int L = i * G + c; if (L >= nt * 8) return false;
        const int t = L >> 3, pn = L & 7; u.pm = t; u.pn = pn; u.pb = tiles[1 + t] * 8 + pn; return true;
    }
    __device__ __forceinline__ void a_ready(const pg8::Unit&) const {}
    __device__ __forceinline__ void done(const pg8::Unit&) const {}
};

__device__ __forceinline__ void vt_write2(LAS unsigned char* VT, const unsigned (&w)[8], int lane, int sg) {
    u32x4 a, b;
    a.x = (w[0] & 0xffffu) | (w[1] << 16); a.y = (w[2] & 0xffffu) | (w[3] << 16); a.z = (w[4] & 0xffffu) | (w[5] << 16); a.w = (w[6] & 0xffffu) | (w[7] << 16);
    b.x = (w[0] >> 16) | (w[1] & 0xffff0000u); b.y = (w[2] >> 16) | (w[3] & 0xffff0000u); b.z = (w[4] >> 16) | (w[5] & 0xffff0000u); b.w = (w[6] >> 16) | (w[7] & 0xffff0000u);
    *(LAS u32x4*)(VT + (2 * lane) * 144 + sg * 16) = a; *(LAS u32x4*)(VT + (2 * lane + 1) * 144 + sg * 16) = b;
}
__device__ __forceinline__ void vt_write4(LAS unsigned char* VT, const u32x2 (&w)[8], int lane, int sg) {
    u32x4 a, b, c, d;
    a.x = (w[0].x & 0xffffu) | (w[1].x << 16); a.y = (w[2].x & 0xffffu) | (w[3].x << 16); a.z = (w[4].x & 0xffffu) | (w[5].x << 16); a.w = (w[6].x & 0xffffu) | (w[7].x << 16);
    b.x = (w[0].x >> 16) | (w[1].x & 0xffff0000u); b.y = (w[2].x >> 16) | (w[3].x & 0xffff0000u); b.z = (w[4].x >> 16) | (w[5].x & 0xffff0000u); b.w = (w[6].x >> 16) | (w[7].x & 0xffff0000u);
    c.x = (w[0].y & 0xffffu) | (w[1].y << 16); c.y = (w[2].y & 0xffffu) | (w[3].y << 16); c.z = (w[4].y & 0xffffu) | (w[5].y << 16); c.w = (w[6].y & 0xffffu) | (w[7].y << 16);
    d.x = (w[0].y >> 16) | (w[1].y & 0xffff0000u); d.y = (w[2].y >> 16) | (w[3].y & 0xffff0000u); d.z = (w[4].y >> 16) | (w[5].y & 0xffff0000u); d.w = (w[6].y >> 16) | (w[7].y & 0xffff0000u);
    *(LAS u32x4*)(VT + (4 * lane) * 144 + sg * 16) = a; *(LAS u32x4*)(VT + (4 * lane + 1) * 144 + sg * 16) = b;
    *(LAS u32x4*)(VT + (4 * lane + 2) * 144 + sg * 16) = c; *(LAS u32x4*)(VT + (4 * lane + 3) * 144 + sg * 16) = d;
}
template <bool RET> struct S1Raw { f32x2 g[8]; unsigned kw[8]; unsigned w2[8]; u32x2 w4[8]; };
template <bool RET>
__device__ __forceinline__ void s1_load(const Params& p, int it, int sg, int lane, S1Raw<RET>& R) {
    const int cc = it % NCH, dh = it / NCH; const int dir = RET ? dh >> 2 : dh >> 3, h = RET ? dh & 3 : dh & 7;
    const size_t row0 = (size_t)cc * 64 + 8 * sg;
    if (!RET) {
        const _Float16* G = (const _Float16*)(p.ws + (dir ? WS_GB : WS_GF)) + row0 * 1024 + h * 128 + 2 * lane;
        const bf16_t* V = (const bf16_t*)(p.ws + WS_V) + row0 * 1024 + h * 128 + 2 * lane;
#pragma unroll
        for (int i = 0; i < 8; ++i) { R.g[i] = unpk2h(*(const unsigned*)(G + (size_t)i * 1024)); R.w2[i] = *(const unsigned*)(V + (size_t)i * 1024); }
    } else {
        const bf16_t* K = (const bf16_t*)(p.ws + WS_RK) + row0 * 512 + h * 128 + 2 * lane;
        const bf16_t* V = (const bf16_t*)(p.ws + WS_RV) + row0 * 1024 + h * 256 + 4 * lane;
#pragma unroll
        for (int i = 0; i < 8; ++i) { R.kw[i] = *(const unsigned*)(K + (size_t)i * 512); R.w4[i] = *(const u32x2*)(V + (size_t)i * 1024); }
    }
}
template <bool RET>
__device__ __forceinline__ void s1_process(const Params& p, LAS unsigned char* lds, int it, int sg, int lane, const S1Raw<RET>& R) {
    constexpr int DV = RET ? 256 : 128;
    const int cc = it % NCH, dh = it / NCH; const int dir = RET ? dh >> 2 : dh >> 3, h = RET ? dh & 3 : dh & 7; const int kp = lane;
    LAS unsigned char* KT = lds;
    LAS unsigned char* VT = lds + 18432;
    LAS float* TOT = (LAS float*)(lds + 18432 + 36864);
    float* DEC = (float*)(p.ws + WS_DEC) + (size_t)((RET ? DEC_RET_ITEM0 : 0) + it) * 128;
    float kx[8], ky[8]; float decx, decy;
    if (!RET) {
        f32x2 cs[8];
        cs[0] = R.g[0];
#pragma unroll
        for (int i = 1; i < 8; ++i) cs[i] = cs[i - 1] + R.g[i];
        *(LAS f32x2*)(TOT + sg * 128 + 2 * kp) = cs[7];
        __syncthreads();
        f32x2 pre = {0.f, 0.f}, T = {0.f, 0.f};
#pragma unroll
        for (int s8 = 0; s8 < 8; ++s8) { const f32x2 t = *(const LAS f32x2*)(TOT + s8 * 128 + 2 * kp); if (s8 < sg) pre += t; T += t; }
#pragma unroll
        for (int i = 0; i < 8; ++i) { f32x2 b = pre + cs[i]; if (dir) b = T - b + R.g[i];
            kx[i] = (1.f - __expf(R.g[i].x)) * __expf(-b.x); ky[i] = (1.f - __expf(R.g[i].y)) * __expf(-b.y); }
        decx = __expf(T.x); decy = __expf(T.y);
    } else {
        const float lg = log_sigmoid_f(p.ret_dl[dir * 4 + h]);
#pragma unroll
        for (int i = 0; i < 8; ++i) { const int s = 8 * sg + i; const float e = dir ? (float)(64 - s) : (float)(s + 1);
            const float sc = __expf(-lg * e); kx[i] = bflo(R.kw[i]) * sc; ky[i] = bfhi(R.kw[i]) * sc; }
        decx = decy = __expf(64.f * lg);
    }
    { u32x4 a, b; a.x = pk2(kx[0], kx[1]); a.y = pk2(kx[2], kx[3]); a.z = pk2(kx[4], kx[5]); a.w = pk2(kx[6], kx[7]);
      b.x = pk2(ky[0], ky[1]); b.y = pk2(ky[2], ky[3]); b.z = pk2(ky[4], ky[5]); b.w = pk2(ky[6], ky[7]);
      *(LAS u32x4*)(KT + (2 * kp) * 144 + sg * 16) = a; *(LAS u32x4*)(KT + (2 * kp + 1) * 144 + sg * 16) = b; }
    if (sg == 0) { f32x2 d = {decx, decy}; *(f32x2*)(DEC + 2 * kp) = d; }
    if (!RET) vt_write2(VT, R.w2, lane, sg); else vt_write4(VT, R.w4, lane, sg);
    __syncthreads();
    const int fr = lane & 15, fq = lane >> 4;
    const bf16x8 a0 = *(const LAS bf16x8*)(KT + (16 * sg + fr) * 144 + 16 * fq), a1 = *(const LAS bf16x8*)(KT + (16 * sg + fr) * 144 + 64 + 16 * fq);
    bf16_t* LOC = (bf16_t*)(p.ws + WS_LOCAL + (RET ? LOCAL_RET_OFF : 0)) + (size_t)it * DV * 128 + (size_t)sg * DV * 16;
#pragma unroll
    for (int vt = 0; vt < DV / 16; ++vt) {
        const bf16x8 b0 = *(const LAS bf16x8*)(VT + (16 * vt + fr) * 144 + 16 * fq), b1 = *(const LAS bf16x8*)(VT + (16 * vt + fr) * 144 + 64 + 16 * fq);
        f32x4 acc = {0.f, 0.f, 0.f, 0.f};
        acc = mfma16(a0, b0, acc); acc = mfma16(a1, b1, acc);
        u32x2 w; w.x = pk2(acc[0], acc[1]); w.y = pk2(acc[2], acc[3]);
        *(u32x2*)(LOC + (16 * vt + fr) * 16 + 4 * fq) = w;
    }
}
template <bool RET>
__device__ __forceinline__ void p3_loop(const Params& p, LAS unsigned char* lds, int nitems) {
    const int sg = __builtin_amdgcn_readfirstlane(threadIdx.x >> 6), lane = threadIdx.x & 63, G = gridDim.x;
    int it = blockIdx.x; if (it >= nitems) return;
    S1Raw<RET> A, B; s1_load<RET>(p, it, sg, lane, A);
    for (;;) {
        int nx = it + G; bool has = nx < nitems;
        if (has) s1_load<RET>(p, nx, sg, lane, B);
        s1_process<RET>(p, lds, it, sg, lane, A);
        if (!has) break;
        it = nx; nx = it + G; has = nx < nitems;
        if (has) s1_load<RET>(p, nx, sg, lane, A);
        s1_process<RET>(p, lds + 65536, it, sg, lane, B);
        if (!has) break;
        it = nx;
    }
}
__device__ __forceinline__ void p3_local(const Params& p, LAS unsigned char* lds) {
    p3_loop<true>(p, lds, 2 * 4 * NCH);
    __syncthreads();
    p3_loop<false>(p, lds, 2 * 8 * NCH);
}
__device__ __forceinline__ void p4_scan(const Params& p) {
    const int NTOT = 131072;
    for (int e = blockIdx.x * NTHREADS + threadIdx.x; e < NTOT; e += gridDim.x * NTHREADS) {
        const bool ret = e >= 65536; const int e2 = ret ? e - 65536 : e;
        const int dh = ret ? e2 >> 13 : e2 >> 12; const int rem = ret ? e2 & 8191 : e2 & 4095;
        const int DV = ret ? 256 : 128; const int off = rem * 4; const int k = (off / (DV * 16)) * 16 + (off & 15);
        const int dir = ret ? dh >> 2 : dh >> 3;
        const bf16_t* loc = (const bf16_t*)(p.ws + WS_LOCAL + (ret ? LOCAL_RET_OFF : 0)) + (size_t)dh * NCH * DV * 128 + off;
        const float* dec = (const float*)(p.ws + WS_DEC) + (size_t)((ret ? DEC_RET_ITEM0 : 0) + dh * NCH) * 128 + k;
        bf16_t* sst = (bf16_t*)(p.ws + WS_SST + (ret ? SST_RET_OFF : 0)) + (size_t)dh * NXCH * DV * 128 + off;
        const size_t cstride = (size_t)DV * 128;
        f32x4 S = {0.f, 0.f, 0.f, 0.f};
        for (int i0 = 0; i0 < NCH; i0 += 12) {
            u32x2 lw[12]; f32x4 dc[12]; int ccs[12];
#pragma unroll
            for (int j = 0; j < 12; ++j) { const int i = i0 + j; const int cc = dir ? (i < NCCH ? NCCH - 1 - i : NCH + NCCH - 1 - i) : i; ccs[j] = cc;
                lw[j] = __builtin_nontemporal_load((const u32x2*)(loc + (size_t)cc * cstride)); dc[j] = *(const f32x4*)(dec + (size_t)cc * 128); }
#pragma unroll
            for (int j = 0; j < 12; ++j) {
                if (ccs[j] >= NCCH) { u32x2 w; w.x = pk2(S[0], S[1]); w.y = pk2(S[2], S[3]); *(u32x2*)(sst + (size_t)(ccs[j] - NCCH) * cstride) = w; }
                const f32x4 l = {bflo(lw[j].x), bfhi(lw[j].x), bflo(lw[j].y), bfhi(lw[j].y)};
                S = (S + l) * dc[j];
            }
        }
    }
}
struct S3Raw { unsigned a[8], b[8], c[8], v2[8]; u32x2 v4[8]; };
template <bool RET>
__device__ __forceinline__ void s3_load(const Params& p, int it, int sg, int lane, S3Raw& R) {
    const int h = it / NXCH, xc = it % NXCH; const size_t row0 = (size_t)CTXL + (size_t)xc * 64 + 8 * sg;
    if (!RET) {
        const _Float16* GFp = (const _Float16*)(p.ws + WS_GF) + row0 * 1024 + h * 128 + 2 * lane;
        const _Float16* GBp = (const _Float16*)(p.ws + WS_GB) + row0 * 1024 + h * 128 + 2 * lane;
        const bf16_t* Qp = (const bf16_t*)(p.ws + WS_Q) + row0 * 1024 + h * 128 + 2 * lane;
        const bf16_t* V = (const bf16_t*)(p.ws + WS_V) + row0 * 1024 + h * 128 + 2 * lane;
#pragma unroll
        for (int i = 0; i < 8; ++i) { R.a[i] = *(const unsigned*)(GFp + (size_t)i * 1024); R.b[i] = *(const unsigned*)(GBp + (size_t)i * 1024); R.c[i] = *(const unsigned*)(Qp + (size_t)i * 1024); R.v2[i] = *(const unsigned*)(V + (size_t)i * 1024); }
    } else {
        const bf16_t* Qp = (const bf16_t*)(p.ws + WS_RQ) + row0 * 512 + h * 128 + 2 * lane;
        const bf16_t* Kp = (const bf16_t*)(p.ws + WS_RK) + row0 * 512 + h * 128 + 2 * lane;
        const bf16_t* V = (const bf16_t*)(p.ws + WS_RV) + row0 * 1024 + h * 256 + 4 * lane;
#pragma unroll
        for (int i = 0; i < 8; ++i) { R.a[i] = *(const unsigned*)(Qp + (size_t)i * 512); R.b[i] = *(const unsigned*)(Kp + (size_t)i * 512); R.v4[i] = *(const u32x2*)(V + (size_t)i * 1024); }
    }
}
template <bool RET>
__device__ __forceinline__ void s3_item(const Params& p, LAS unsigned char* lds, int h, int xc, const S3Raw& R) {
    constexpr int DV = RET ? 256 : 128, NVW = DV / 128;
    const int tid = threadIdx.x, sg = __builtin_amdgcn_readfirstlane(tid >> 6), lane = tid & 63, kp = lane, fr = lane & 15, fq = lane >> 4;
    LAS unsigned char* QF = lds; LAS unsigned char* QB = lds + 17408; LAS unsigned char* KF = lds + 2 * 17408; LAS unsigned char* KB = lds + 3 * 17408;
    LAS unsigned char* VT = lds + 69632;
    LAS unsigned char* PP = lds + 106496;
    LAS float* TOT = (LAS float*)(lds + 115712);
    LAS float* RS = (LAS float*)(lds + 123904);
    const size_t row0 = (size_t)CTXL + (size_t)xc * 64;
    const bf16_t* SF = (const bf16_t*)(p.ws + WS_SST + (RET ? SST_RET_OFF : 0)) + ((size_t)(0 * (RET ? 4 : 8) + h) * NXCH + xc) * DV * 128;
    const bf16_t* SB = (const bf16_t*)(p.ws + WS_SST + (RET ? SST_RET_OFF : 0)) + ((size_t)(1 * (RET ? 4 : 8) + h) * NXCH + xc) * DV * 128;
    bf16x8 sf[NVW][4], sb[NVW][4];
#pragma unroll
    for (int vi = 0; vi < NVW; ++vi)
#pragma unroll
        for (int ks = 0; ks < 4; ++ks) { const size_t o = ((size_t)(2 * ks + (fq >> 1)) * DV + 16 * (sg * NVW + vi) + fr) * 16 + 8 * (fq & 1);
            sf[vi][ks] = *(const bf16x8*)(SF + o); sb[vi][ks] = *(const bf16x8*)(SB + o); }
    const bf16_t* GT = (const bf16_t*)(p.ws + (RET ? WS_RGATE : WS_HGATE)) + (row0 + fr) * 1024 + h * DV + 4 * fq;
    u32x2 gtv[4][NVW]; f32x4 nwv[NVW];
#pragma unroll
    for (int vi = 0; vi < NVW; ++vi) { nwv[vi] = *(const f32x4*)((RET ? p.ret_nw : p.hg_nw) + h * DV + 16 * (sg * NVW + vi) + 4 * fq);
#pragma unroll
        for (int tt = 0; tt < 4; ++tt) gtv[tt][vi] = *(const u32x2*)(GT + (size_t)(16 * tt) * 1024 + 16 * (sg * NVW + vi)); }
    if (!RET) {
        f32x2 gf[8], gb[8], cf[8], cb[8]; unsigned qw[8];
#pragma unroll
        for (int i = 0; i < 8; ++i) { gf[i] = unpk2h(R.a[i]); gb[i] = unpk2h(R.b[i]); qw[i] = R.c[i]; }
        cf[0] = gf[0]; cb[0] = gb[0];
#pragma unroll
        for (int i = 1; i < 8; ++i) { cf[i] = cf[i - 1] + gf[i]; cb[i] = cb[i - 1] + gb[i]; }
        *(LAS f32x2*)(TOT + sg * 128 + 2 * kp) = cf[7]; *(LAS f32x2*)(TOT + 1024 + sg * 128 + 2 * kp) = cb[7];
        vt_write2(VT, R.v2, lane, sg);
        __syncthreads();
        f32x2 pf = {0.f, 0.f}, pb = {0.f, 0.f}, Tb = {0.f, 0.f};
#pragma unroll
        for (int s8 = 0; s8 < 8; ++s8) { const f32x2 t = *(const LAS f32x2*)(TOT + s8 * 128 + 2 * kp), t2 = *(const LAS f32x2*)(TOT + 1024 + s8 * 128 + 2 * kp);
            if (s8 < sg) { pf += t; pb += t2; } Tb += t2; }
#pragma unroll
        for (int i = 0; i < 8; ++i) {
            const f32x2 bf = pf + cf[i]; const f32x2 bb = Tb - (pb + cb[i]) + gb[i];
            const float qx = bflo(qw[i]), qy = bfhi(qw[i]); const int s = 8 * sg + i;
            *(LAS unsigned*)(QF + s * 272 + kp * 4) = pk2(qx * __expf(bf.x), qy * __expf(bf.y));
            *(LAS unsigned*)(KF + s * 272 + kp * 4) = pk2((1.f - __expf(gf[i].x)) * __expf(-bf.x), (1.f - __expf(gf[i].y)) * __expf(-bf.y));
            *(LAS unsigned*)(QB + s * 272 + kp * 4) = pk2(qx * __expf(bb.x), qy * __expf(bb.y));
            *(LAS unsigned*)(KB + s * 272 + kp * 4) = pk2((1.f - __expf(gb[i].x)) * __expf(-bb.x), (1.f - __expf(gb[i].y)) * __expf(-bb.y));
        }
    } else {
        const float lgf = log_sigmoid_f(p.ret_dl[h]), lgb = log_sigmoid_f(p.ret_dl[4 + h]);
        unsigned qw[8], kw[8];
#pragma unroll
        for (int i = 0; i < 8; ++i) { qw[i] = R.a[i]; kw[i] = R.b[i]; }
        vt_write4(VT, R.v4, lane, sg);
#pragma unroll
        for (int i = 0; i < 8; ++i) {
            const int s = 8 * sg + i;
            const float bf = (float)(s + 1) * lgf, bb = (float)(64 - s) * lgb;
            const float ef = __expf(bf), eb = __expf(bb), nf = __expf(-bf), nb = __expf(-bb);
            *(LAS unsigned*)(QF + s * 272 + kp * 4) = pk2(bflo(qw[i]) * ef, bfhi(qw[i]) * ef);
            *(LAS unsigned*)(KF + s * 272 + kp * 4) = pk2(bflo(kw[i]) * nf, bfhi(kw[i]) * nf);
            *(LAS unsigned*)(QB + s * 272 + kp * 4) = pk2(bflo(qw[i]) * eb, bfhi(qw[i]) * eb);
            *(LAS unsigned*)(KB + s * 272 + kp * 4) = pk2(bflo(kw[i]) * nb, bfhi(kw[i]) * nb);
        }
    }
    __syncthreads();
    {
        const int tt = sg >> 1;
#pragma unroll
        for (int sti = 0; sti < 2; ++sti) {
            const int st = (sg & 1) * 2 + sti;
            f32x4 af = {0.f, 0.f, 0.f, 0.f}, ab = {0.f, 0.f, 0.f, 0.f};
            if (st <= tt) {
#pragma unroll
                for (int ks = 0; ks < 4; ++ks) { const bf16x8 a = *(const LAS bf16x8*)(KF + (16 * st + fr) * 272 + ks * 64 + 16 * fq), b = *(const LAS bf16x8*)(QF + (16 * tt + fr) * 272 + ks * 64 + 16 * fq); af = mfma16(a, b, af); }
            }
            if (st >= tt) {
#pragma unroll
                for (int ks = 0; ks < 4; ++ks) { const bf16x8 a = *(const LAS bf16x8*)(KB + (16 * st + fr) * 272 + ks * 64 + 16 * fq), b = *(const LAS bf16x8*)(QB + (16 * tt + fr) * 272 + ks * 64 + 16 * fq); ab = mfma16(a, b, ab); }
            }
            f32x4 r;
#pragma unroll
            for (int j = 0; j < 4; ++j) { const int sl = 16 * st + 4 * fq + j, tl = 16 * tt + fr; r[j] = (sl <= tl ? af[j] : 0.f) + (sl >= tl ? ab[j] : 0.f); }
            u32x2 w; w.x = pk2(r[0], r[1]); w.y = pk2(r[2], r[3]);
            *(LAS u32x2*)(PP + (16 * tt + fr) * 144 + (16 * st + 4 * fq) * 2) = w;
        }
    }
    __syncthreads();
    f32x4 o[4][NVW];
#pragma unroll
    for (int tt = 0; tt < 4; ++tt) {
        bf16x8 pb[2], qfb[4], qbb[4];
#pragma unroll
        for (int ks = 0; ks < 2; ++ks) pb[ks] = *(const LAS bf16x8*)(PP + (16 * tt + fr) * 144 + ks * 64 + 16 * fq);
#pragma unroll
        for (int ks = 0; ks < 4; ++ks) { qfb[ks] = *(const LAS bf16x8*)(QF + (16 * tt + fr) * 272 + ks * 64 + 16 * fq); qbb[ks] = *(const LAS bf16x8*)(QB + (16 * tt + fr) * 272 + ks * 64 + 16 * fq); }
        float ss = 0.f;
#pragma unroll
        for (int vi = 0; vi < NVW; ++vi) {
            const int vt = sg * NVW + vi; f32x4 acc = {0.f, 0.f, 0.f, 0.f};
#pragma unroll
            for (int ks = 0; ks < 2; ++ks) { const bf16x8 a = *(const LAS bf16x8*)(VT + (16 * vt + fr) * 144 + ks * 64 + 16 * fq); acc = mfma16(a, pb[ks], acc); }
#pragma unroll
            for (int ks = 0; ks < 4; ++ks) acc = mfma16(sf[vi][ks], qfb[ks], acc);
#pragma unroll
            for (int ks = 0; ks < 4; ++ks) acc = mfma16(sb[vi][ks], qbb[ks], acc);
            o[tt][vi] = acc; ss += (acc[0] * acc[0] + acc[1] * acc[1]) + (acc[2] * acc[2] + acc[3] * acc[3]);
        }
        ss += __shfl_xor(ss, 16); ss += __shfl_xor(ss, 32);
        if (fq == 0) RS[sg * 64 + 16 * tt + fr] = ss;
    }
    __syncthreads();
    bf16_t* PO = (bf16_t*)(p.ws + WS_PREOUT) + ((size_t)xc * 64 + fr) * DM + (RET ? 1024 : 0) + h * DV + 4 * fq;
#pragma unroll
    for (int tt = 0; tt < 4; ++tt) {
        float tot = 0.f;
#pragma unroll
        for (int w8 = 0; w8 < 8; ++w8) tot += RS[w8 * 64 + 16 * tt + fr];
        const float rstd = rsqrtf(tot * (1.f / DV) + EPS);
#pragma unroll
        for (int vi = 0; vi < NVW; ++vi) {
            const u32x2 gw = gtv[tt][vi]; const f32x4 nw = nwv[vi]; const f32x4 a = o[tt][vi];
            u32x2 w; w.x = pk2(a[0] * rstd * nw[0] * bflo(gw.x), a[1] * rstd * nw[1] * bfhi(gw.x)); w.y = pk2(a[2] * rstd * nw[2] * bflo(gw.y), a[3] * rstd * nw[3] * bfhi(gw.y));
            *(u32x2*)(PO + (size_t)(16 * tt) * DM + 16 * (sg * NVW + vi)) = w;
        }
    }
    __syncthreads();
}
template <bool RET>
__device__ __forceinline__ void p5_loop(const Params& p, LAS unsigned char* lds, int nitems) {
    const int sg = __builtin_amdgcn_readfirstlane(threadIdx.x >> 6), lane = threadIdx.x & 63, G = gridDim.x;
    int it = blockIdx.x; if (it >= nitems) return;
    S3Raw A, B; s3_load<RET>(p, it, sg, lane, A);
    for (;;) {
        int nx = it + G; bool has = nx < nitems;
        if (has) s3_load<RET>(p, nx, sg, lane, B);
        s3_item<RET>(p, lds, it / NXCH, it % NXCH, A);
        if (!has) break;
        it = nx; nx = it + G; has = nx < nitems;
        if (has) s3_load<RET>(p, nx, sg, lane, A);
        s3_item<RET>(p, lds, it / NXCH, it % NXCH, B);
        if (!has) break;
        it = nx;
    }
}
__device__ __forceinline__ void p5_out(const Params& p, LAS unsigned char* lds) {
    {
        const int sg = __builtin_amdgcn_readfirstlane(threadIdx.x >> 6), lane = threadIdx.x & 63;
        for (int it = blockIdx.x; it < 4 * NXCH; it += gridDim.x) { S3Raw R; s3_load<true>(p, it, sg, lane, R); s3_item<true>(p, lds, it / NXCH, it % NXCH, R); }
    }
    p5_loop<false>(p, lds, 8 * NXCH);
}

__device__ __forceinline__ void p7_norm_route(const Params& p, LAS unsigned char* lds) {
    const int tid = threadIdx.x, wave = tid >> 6, lane = tid & 63;
    LAS float* G1 = (LAS float*)lds; LAS float* SH2 = G1 + 2048; LAS float* SC2 = SH2 + 2048; LAS int* CNTL = (LAS int*)(SC2 + 2048);
    mod_reduce_to_lds(p, G1, 4096, 2048, false); mod_reduce_to_lds(p, SH2, 6144, 2048, false); mod_reduce_to_lds(p, SC2, 8192, 2048, false);
    const bf16_t* OX = (const bf16_t*)(p.ws + WS_OUTX); unsigned char* HX2 = (unsigned char*)(p.ws + WS_HX2);
    const float* WR = (const float*)(p.ws + WS_CTL + CTL_WR);
    int* CNT = (int*)(p.ws + WS_CTL + CTL_CNT); f32x4* ROUTE = (f32x4*)(p.ws + WS_CTL + CTL_ROUTE);
    for (int grp = blockIdx.x; grp < NGRP; grp += gridDim.x) {
        if (tid < 32) CNTL[tid] = 0;
        __syncthreads();
        LAS float* LG = (LAS float*)(lds + 32768) + wave * 160;
        LAS float* WL = (LAS float*)(lds + 40960);
        f32x4 hv[4][8];
#pragma unroll
        for (int r = 0; r < 4; ++r) {
            const int t = grp * 32 + wave * 4 + r;
            f32x4 ov[8]; float ss = 0.f;
#pragma unroll
            for (int j = 0; j < 8; ++j) { const u32x2 ow = *(const u32x2*)(OX + (size_t)t * DM + 4 * (lane + 64 * j)); ov[j] = (f32x4){bflo(ow.x), bfhi(ow.x), bflo(ow.y), bfhi(ow.y)}; ss += (ov[j][0] * ov[j][0] + ov[j][1] * ov[j][1]) + (ov[j][2] * ov[j][2] + ov[j][3] * ov[j][3]); }
            const float rstd = rsqrtf(wave_sum(ss) * (1.f / DM) + EPS); float ss2 = 0.f;
#pragma unroll
            for (int j = 0; j < 8; ++j) { const int col = 4 * (lane + 64 * j);
                const f32x4 xv = *(const f32x4*)(p.x + (size_t)t * DM + col), nw = *(const f32x4*)(p.norm_w + DM + col), g1 = *(const LAS f32x4*)(G1 + col);
                const f32x4 x1 = xv + g1 * (ov[j] * rstd * nw);
                *(f32x4*)(p.out + (size_t)t * DM + col) = x1; hv[r][j] = x1;
                ss2 += (x1[0] * x1[0] + x1[1] * x1[1]) + (x1[2] * x1[2] + x1[3] * x1[3]); }
            const float rstd2 = rsqrtf(wave_sum(ss2) * (1.f / DM) + EPS);
#pragma unroll
            for (int j = 0; j < 8; ++j) { const int col = 4 * (lane + 64 * j);
                const f32x4 nw = *(const f32x4*)(p.norm_w + 2 * DM + col), a = *(const LAS f32x4*)(SC2 + col), b = *(const LAS f32x4*)(SH2 + col);
                const f32x4 hx = (hv[r][j] * rstd2 * nw) * (a + 1.f) + b; hv[r][j] = hx;
                *(unsigned*)(HX2 + (size_t)t * DM + col) = pk4_fp8(hx[0], hx[1], hx[2], hx[3]); }
            asm volatile("" ::: "memory");
        }
        const int rsel = 2 * (lane & 1) + ((lane >> 1) & 1);
#pragma unroll 1
        for (int rd = 0; rd < 3; ++rd) {
            __syncthreads();
            {
                const float* src = WR + (size_t)rd * 12 * 2048 + 4 * tid;
#pragma unroll
                for (int q = 0; q < 12; ++q) { const f32x4 v = *(const f32x4*)(src + q * 2048); *(LAS f32x4*)(WL + q * 2048 + 4 * tid) = v; }
            }
            __syncthreads();
#pragma unroll 1
            for (int oo = 0; oo < 12; ++oo) {
                const LAS float* wl = WL + oo * 2048 + 4 * lane;
                float a0 = 0.f, a1 = 0.f, a2 = 0.f, a3 = 0.f;
#pragma unroll
                for (int j = 0; j < 8; ++j) { const f32x4 w = *(const LAS f32x4*)(wl + 256 * j);
                    a0 += (hv[0][j][0] * w[0] + hv[0][j][1] * w[1]) + (hv[0][j][2] * w[2] + hv[0][j][3] * w[3]);
                    a1 += (hv[1][j][0] * w[0] + hv[1][j][1] * w[1]) + (hv[1][j][2] * w[2] + hv[1][j][3] * w[3]);
                    a2 += (hv[2][j][0] * w[0] + hv[2][j][1] * w[1]) + (hv[2][j][2] * w[2] + hv[2][j][3] * w[3]);
                    a3 += (hv[3][j][0] * w[0] + hv[3][j][1] * w[1]) + (hv[3][j][2] * w[2] + hv[3][j][3] * w[3]); }
                const bool b0 = (lane & 1) != 0, b1 = (lane & 2) != 0;
                float x0 = b0 ? a2 : a0, y0 = b0 ? a0 : a2, x1 = b0 ? a3 : a1, y1 = b0 ? a1 : a3;
                x0 += __shfl_xor(y0, 1); x1 += __shfl_xor(y1, 1);
                float z = b1 ? x1 : x0, sn = b1 ? x0 : x1; z += __shfl_xor(sn, 2);
                z += __shfl_xor(z, 4); z += __shfl_xor(z, 8); z += __shfl_xor(z, 16); z += __shfl_xor(z, 32);
                if (lane < 4) LG[rsel * 40 + rd * 12 + oo] = z;
            }
        }
        {
            LDS_WAIT(); asm volatile("" ::: "memory");
            const LAS float* Lr = LG + (lane & 3) * 40;
            const float L0 = Lr[0] + p.rgb[0], L1 = Lr[1] + p.rgb[1], L2 = Lr[2] + p.rgb[2], L3 = Lr[3] + p.rgb[3];
            int grpi = 0; float gmax = L0;
            if (L1 > gmax) { gmax = L1; grpi = 1; }
            if (L2 > gmax) { gmax = L2; grpi = 2; }
            if (L3 > gmax) { gmax = L3; grpi = 3; }
            const float psel = 1.f / ((__expf(L0 - gmax) + __expf(L1 - gmax)) + (__expf(L2 - gmax) + __expf(L3 - gmax)));
            float le[8];
#pragma unroll
            for (int j = 0; j < 8; ++j) le[j] = Lr[4 + grpi * 8 + j] + p.reb[grpi * 8 + j];
            int i1 = 0; float v1 = le[0];
#pragma unroll
            for (int j = 1; j < 8; ++j) if (le[j] > v1) { v1 = le[j]; i1 = j; }
            int i2 = -1; float v2 = -3.0e38f;
#pragma unroll
            for (int j = 0; j < 8; ++j) if (j != i1 && le[j] > v2) { v2 = le[j]; i2 = j; }
            const float e2 = __expf(v2 - v1); const float ga = psel / (1.f + e2), gb2 = psel * e2 / (1.f + e2);
            if (lane < 4) {
                const int t = grp * 32 + wave * 4 + lane; const int ea = grpi * 8 + i1, eb = grpi * 8 + i2;
                f32x4 rt; rt[0] = __builtin_bit_cast(float, ea); rt[1] = __builtin_bit_cast(float, eb); rt[2] = ga; rt[3] = gb2; ROUTE[t] = rt;
                atomicAdd((int*)&CNTL[ea], 1); atomicAdd((int*)&CNTL[eb], 1);
            }
        }
        __syncthreads();
        if (tid < 32) CNT[grp * 32 + tid] = CNTL[tid];
        __syncthreads();
    }
}
__device__ __forceinline__ void p8_slots(const Params& p, LAS unsigned char* lds) {
    const int tid = threadIdx.x, wave = tid >> 6, lane = tid & 63;
    LAS int* PT = (LAS int*)lds;
    LAS int* PP = PT + 512;
    LAS int* TOTE = PP + 512;
    LAS int* BASE = TOTE + 32;
    LAS int* SLOTL = BASE + 32;
    const int* CNT = (const int*)(p.ws + WS_CTL + CTL_CNT); const f32x4* ROUTE = (const f32x4*)(p.ws + WS_CTL + CTL_ROUTE);
    int* SLOT = (int*)(p.ws + WS_CTL + CTL_SLOT); int* TILES = (int*)(p.ws + WS_CTL + CTL_TILES);
    const unsigned char* HX2 = (const unsigned char*)(p.ws + WS_HX2); unsigned char* XS = (unsigned char*)(p.ws + WS_XS);
    for (int grp = blockIdx.x; grp < NGRP; grp += gridDim.x) {
        { const int e = tid & 31, part = tid >> 5; int t = 0, pr = 0;
          for (int g = part * 16; g < part * 16 + 16; ++g) { const int c = CNT[g * 32 + e]; t += c; if (g < grp) pr += c; }
          PT[part * 32 + e] = t; PP[part * 32 + e] = pr; }
        __syncthreads();
        if (tid < 32) { int t = 0, pr = 0; for (int q = 0; q < 16; ++q) { t += PT[q * 32 + tid]; pr += PP[q * 32 + tid]; } TOTE[tid] = t; BASE[tid] = pr; }
        __syncthreads();
        if (tid == 0) { int st = 0; for (int e = 0; e < 32; ++e) { const int t = TOTE[e]; BASE[e] += st;
                if (grp == 0) { const int nt = (t + 255) >> 8; for (int q = 0; q < nt; ++q) TILES[1 + (st >> 8) + q] = e; }
                st += ((t + 255) >> 8) << 8; }
            if (grp == 0) TILES[0] = st >> 8; }
        __syncthreads();
        if (wave == 0) {
            const int t = grp * 32 + (lane >> 1); const f32x4 rt = ROUTE[t]; const int e = __builtin_bit_cast(int, (lane & 1) ? rt[1] : rt[0]);
            int rank = 0; const unsigned long long ltmask = (1ull << lane) - 1ull;
            for (int q = 0; q < 32; ++q) { const unsigned long long m = __ballot(e == q); if (e == q) rank = __popcll(m & ltmask); }
            const int slot = BASE[e] + rank; SLOTL[lane] = slot; SLOT[grp * 64 + lane] = slot;
        }
        __syncthreads();
        for (int a = wave * 8; a < wave * 8 + 8; ++a) {
            const int t = grp * 32 + (a >> 1); const int slot = SLOTL[a];
            const u32x4* src = (const u32x4*)(HX2 + (size_t)t * DM); u32x4* dst = (u32x4*)(XS + (size_t)slot * DM);
#pragma unroll
            for (int j = 0; j < 2; ++j) dst[lane + 64 * j] = src[lane + 64 * j];
        }
        __syncthreads();
    }
}
__device__ __forceinline__ void p11_final(const Params& p, LAS unsigned char* lds) {
    const int tid = threadIdx.x, wave = tid >> 6, lane = tid & 63;
    LAS float* G2 = (LAS float*)lds;
    mod_reduce_to_lds(p, G2, 10240, 2048, false);
    __syncthreads();
    const bf16_t* YB = (const bf16_t*)(p.ws + WS_YB); const int* SLOT = (const int*)(p.ws + WS_CTL + CTL_SLOT); const f32x4* ROUTE = (const f32x4*)(p.ws + WS_CTL + CTL_ROUTE);
    const int gw = blockIdx.x * NWAVES + wave, NGW = gridDim.x * NWAVES;
    for (int t = gw; t < SEQ; t += NGW) {
        const int sa = SLOT[2 * t], sb = SLOT[2 * t + 1]; const f32x4 rt = ROUTE[t]; const float ga = rt[2], gb = rt[3];
        f32x4 y[8]; float ss = 0.f;
#pragma unroll
        for (int j = 0; j < 8; ++j) { const int col = 4 * (lane + 64 * j);
            const u32x2 wa = *(const u32x2*)(YB + (size_t)sa * DM + col), wb = *(const u32x2*)(YB + (size_t)sb * DM + col);
            const f32x4 ya = {bflo(wa.x), bfhi(wa.x), bflo(wa.y), bfhi(wa.y)}, yb = {bflo(wb.x), bfhi(wb.x), bflo(wb.y), bfhi(wb.y)};
            y[j] = ya * ga + yb * gb; ss += (y[j][0] * y[j][0] + y[j][1] * y[j][1]) + (y[j][2] * y[j][2] + y[j][3] * y[j][3]); }
        const float rstd = rsqrtf(wave_sum(ss) * (1.f / DM) + EPS);
#pragma unroll
        for (int j = 0; j < 8; ++j) { const int col = 4 * (lane + 64 * j);
            const f32x4 nw = *(const f32x4*)(p.norm_w + 3 * DM + col), g2 = *(const LAS f32x4*)(G2 + col);
            f32x4* op = (f32x4*)(p.out + (size_t)t * DM + col); *op = *op + g2 * (y[j] * rstd * nw); }
    }
}

#define XB_TMO      128
#define XB_XCNT(j)  (256  + 64 * (j))
#define XB_XSUB(j)  (1280 + 64 * (j))
#define XB_XGEN(j)  (2304 + 64 * (j))
#define XB_TOP      3328
#define XB_TOPGEN   3392
#define XCD_BAR_WORDS 3456
#define XB_SPIN_CAP (1u << 18)

__device__ __forceinline__ unsigned xb_ld(unsigned* p)              { return __hip_atomic_load(p, __ATOMIC_RELAXED, __HIP_MEMORY_SCOPE_AGENT); }
__device__ __forceinline__ unsigned xb_add(unsigned* p, unsigned v) { return __hip_atomic_fetch_add(p, v, __ATOMIC_RELAXED, __HIP_MEMORY_SCOPE_AGENT); }
__device__ __forceinline__ unsigned xb_xcc_id() { return (unsigned)__builtin_amdgcn_s_getreg((3 << 11) | 20) & 0xFu; }
#define XB_SPIN(cond, bar) do { unsigned _sp = 0; while (cond) { __builtin_amdgcn_s_sleep(1); \
    if ((++_sp & 255u) == 0u) { if (xb_ld(&(bar)[XB_TMO])) break; if (_sp > XB_SPIN_CAP) { atomicAdd(&(bar)[XB_TMO], 1u); break; } } } } while (0)

struct XcdBarrier {
    unsigned* bar; unsigned x;
    volatile LAS unsigned* st;
};

__device__ __forceinline__ XcdBarrier xcd_barrier_post(unsigned* bar, volatile LAS unsigned* st) {
    XcdBarrier b; b.bar = bar; b.x = xb_xcc_id(); b.st = st;
    if (threadIdx.x == 0) (void)xb_add(&bar[XB_XCNT(b.x)], 1u);
    return b;
}
__device__ __forceinline__ void xcd_barrier_complete(unsigned* bar, unsigned x, unsigned& nloc, unsigned& nx) {
    const unsigned G = gridDim.x * gridDim.y * gridDim.z;
    unsigned sum, cnt, mine, sp = 0u;
    for (;;) {
        sum = 0u; cnt = 0u; mine = 0u;
#pragma unroll
        for (unsigned j = 0; j < 16; ++j) { const unsigned c = xb_ld(&bar[XB_XCNT(j)]); sum += c; cnt += (c > 0u) ? 1u : 0u; mine = (j == x) ? c : mine; }
        if (sum == G) break;
        __builtin_amdgcn_s_sleep(1);
        if ((++sp & 255u) == 0u) { if (xb_ld(&bar[XB_TMO])) break; if (sp > XB_SPIN_CAP) { atomicAdd(&bar[XB_TMO], 1u); break; } }
    }
    nloc = mine > 0u ? mine : 1u; nx = cnt > 0u ? cnt : 1u;
}

__device__ __forceinline__ void xcd_barrier(const XcdBarrier& b) {
    asm volatile("s_waitcnt vmcnt(0)" ::: "memory");
    __syncthreads();
    if (threadIdx.x == 0) {
        unsigned* bar = b.bar;
        __builtin_amdgcn_s_waitcnt(0);
        unsigned nloc = b.st[0], nx = b.st[1];
        if (nloc == 0u) { xcd_barrier_complete(bar, b.x, nloc, nx); b.st[0] = nloc; b.st[1] = nx; }
        const unsigned old = xb_add(&bar[XB_XSUB(b.x)], 1u);
        const unsigned gen = old / nloc;
        if (old + 1u == (gen + 1u) * nloc) {
            __builtin_amdgcn_fence(__ATOMIC_RELEASE, "agent");
            asm volatile("s_waitcnt vmcnt(0)" ::: "memory");
            const unsigned og = xb_add(&bar[XB_TOP], 1u);
            const unsigned tg = og / nx;
            if (og + 1u == (tg + 1u) * nx) xb_add(&bar[XB_TOPGEN], 1u);
            else XB_SPIN(xb_ld(&bar[XB_TOPGEN]) == tg, bar);
            __builtin_amdgcn_fence(__ATOMIC_ACQUIRE, "agent");
            xb_add(&bar[XB_XGEN(b.x)], 1u);
            asm volatile("s_waitcnt vmcnt(0)" ::: "memory");
        } else {
            XB_SPIN(xb_ld(&bar[XB_XGEN(b.x)]) == gen, bar);
            __builtin_amdgcn_fence(__ATOMIC_ACQUIRE, "agent");
            asm volatile("s_waitcnt vmcnt(0)" ::: "memory");
        }
    }
    __syncthreads();
}

constexpr int NPHASE = 12;
__global__ void __launch_bounds__(NTHREADS, 2) fwd_kernel(Params p) {
    extern __shared__ __attribute__((aligned(16))) unsigned char lds_raw[];
    LAS unsigned char* lds = (LAS unsigned char*)lds_raw;
    cg::grid_group grid = cg::this_grid();
    const int lo = p.ph_lo, hi = p.ph_hi;
    volatile LAS unsigned* MISC = (volatile LAS unsigned*)(lds + MISC_OFF);
    if (threadIdx.x < 64) MISC[threadIdx.x] = 0u;
    __syncthreads();
    XcdBarrier bar; bar.bar = (unsigned*)(p.ws + WS_CTL + CTL_BAR); bar.x = 0; bar.st = nullptr;
    if (hi - lo > 1) bar = xcd_barrier_post((unsigned*)(p.ws + WS_CTL + CTL_BAR), MISC + 8);
    if (lo < 0) grid.sync();
    const int G = gridDim.x, bx = blockIdx.x;
    const int vcu = (G % 8 == 0) ? (bx % 8) * (G / 8) + bx / 8 : bx;
#ifndef PHM
#define PHM 0xfff
#endif
#define IN(k) (((PHM >> (k)) & 1) && lo <= (k) && (k) < hi)
#ifndef REPM
#define REPM 0
#endif
#define SEAM(k) do { if (IN(k) && IN((k) + 1)) xcd_barrier(bar); } while (0)
    if (IN(0)) for (int rep_ = 0; rep_ <= ((REPM >> 0) & 1); ++rep_) { if (rep_) xcd_barrier(bar); p0_prologue(p, lds); } SEAM(0);
    if (IN(1)) for (int rep_ = 0; rep_ <= ((REPM >> 1) & 1); ++rep_) { if (rep_) xcd_barrier(bar); p1_hrows(p, lds); } SEAM(1);
    if (IN(2)) for (int rep_ = 0; rep_ <= ((REPM >> 2) & 1); ++rep_) { if (rep_) xcd_barrier(bar);
        pg8::Gemm g{(const bf16_t*)(p.ws + WS_H), (const bf16_t*)(p.ws + WS_WTIN), MT, PW, DM, 0, 0}; pg8::StaticOrder S; S.init(MT, PW, G, bx);
        EpiProj E{p.ws};
        const bool convfirst = ((bx >> 3) & 1) == 0;
#pragma unroll 1
        for (int step = 0; step < 2; ++step) {
            if ((step == 0) == convfirst) p2_convert(p, lds, bx, G);
            else pg8::gemm_phase<EpiProj, pg8::StaticOrder, true, true>(lds, g, S, E);
            __syncthreads();
        }
    } SEAM(2);
    if (IN(3)) for (int rep_ = 0; rep_ <= ((REPM >> 3) & 1); ++rep_) { if (rep_) xcd_barrier(bar); p3_local(p, lds); } SEAM(3);
    if (IN(4)) for (int rep_ = 0; rep_ <= ((REPM >> 4) & 1); ++rep_) { if (rep_) xcd_barrier(bar); p4_scan(p); } SEAM(4);
    if (IN(5)) for (int rep_ = 0; rep_ <= ((REPM >> 5) & 1); ++rep_) { if (rep_) xcd_barrier(bar); p5_out(p, lds); } SEAM(5);
    if (IN(6)) for (int rep_ = 0; rep_ <= ((REPM >> 6) & 1); ++rep_) { if (rep_) xcd_barrier(bar);
        pg8::Gemm g{(const bf16_t*)(p.ws + WS_PREOUT), (const bf16_t*)(p.ws + WS_WTOUT), SEQ, DM, DM, 0, 0}; pg8::StaticOrder S; S.init(SEQ, DM, G, bx);
        EpiBf16P<false> E{(bf16_t*)(p.ws + WS_OUTX), DM};
        pg8::gemm_phase<EpiBf16P<false>, pg8::StaticOrder, true, true>(lds, g, S, E);
    } SEAM(6);
    if (IN(7)) for (int rep_ = 0; rep_ <= ((REPM >> 7) & 1); ++rep_) { if (rep_) xcd_barrier(bar); p7_norm_route(p, lds); } SEAM(7);
    if (IN(8)) for (int rep_ = 0; rep_ <= ((REPM >> 8) & 1); ++rep_) { if (rep_) xcd_barrier(bar); p8_slots(p, lds); } SEAM(8);
    if (IN(9)) for (int rep_ = 0; rep_ <= ((REPM >> 9) & 1); ++rep_) { if (rep_) xcd_barrier(bar);
        pg8::Gemm g{(const bf16_t*)(p.ws + WS_XS), (const bf16_t*)(p.ws + WS_WTGU), 0, 0, DM / 2, 0x7A7A7A7F, 0}; MoeOrder S{(const int*)(p.ws + WS_CTL + CTL_TILES), G, vcu};
        EpiGateUp E{(unsigned char*)(p.ws + WS_GACT)};
        pg8::gemm_phase<EpiGateUp, MoeOrder, true, true>(lds, g, S, E);
    } SEAM(9);
    if (IN(10)) for (int rep_ = 0; rep_ <= ((REPM >> 10) & 1); ++rep_) { if (rep_) xcd_barrier(bar);
        pg8::Gemm g{(const bf16_t*)(p.ws + WS_GACT), (const bf16_t*)(p.ws + WS_WTD), 0, 0, DE / 2, 0x7A7A7A7F, 0}; MoeOrder S{(const int*)(p.ws + WS_CTL + CTL_TILES), G, vcu};
        EpiBf16P<true> E{(bf16_t*)(p.ws + WS_YB), DM};
        pg8::gemm_phase<EpiBf16P<true>, MoeOrder, true, true>(lds, g, S, E);
    } SEAM(10);
    if (IN(11)) for (int rep_ = 0; rep_ <= ((REPM >> 11) & 1); ++rep_) { if (rep_) xcd_barrier(bar); p11_final(p, lds); }
#undef IN
#undef SEAM
}

#ifndef MK_ONE_LAUNCH
#define MK_ONE_LAUNCH 1
#endif
extern "C" void kernel_launch(void* const* d_in, const int* in_sizes, int n_in, void* d_out, int out_size, void* d_ws, size_t ws_size, hipStream_t stream) {
    static int grid = 0;
    if (grid == 0) {
        if (n_in != 20 || ws_size < WS_END) { fprintf(stderr, "kernel_launch: unexpected n_in %d or ws_size %zu (< %zu)\n", n_in, ws_size, (size_t)WS_END); grid = -1; return; }
        int dev = 0, cus = 0, per_cu = 0;
        if (hipGetDevice(&dev) != hipSuccess || hipDeviceGetAttribute(&cus, hipDeviceAttributeMultiprocessorCount, dev) != hipSuccess) { grid = -1; return; }
        if (hipFuncSetAttribute((const void*)fwd_kernel, hipFuncAttributeMaxDynamicSharedMemorySize, LDS_BYTES) != hipSuccess) { fprintf(stderr, "kernel_launch: hipFuncSetAttribute failed\n"); grid = -1; return; }
        if (hipOccupancyMaxActiveBlocksPerMultiprocessor(&per_cu, (const void*)fwd_kernel, NTHREADS, LDS_BYTES) != hipSuccess || per_cu < 1) { fprintf(stderr, "kernel_launch: occupancy query says %d blocks per CU\n", per_cu); (void)hipGetLastError(); grid = -1; return; }
        grid = cus;
    }
    if (grid < 0) return;
    Params p{};
    const float* const* in = (const float* const*)d_in;
    p.x = in[0]; p.c = in[1]; p.ctx = in[2]; p.c_ctx = in[3]; p.w_mod = in[4]; p.b_mod = in[5]; p.norm_w = in[6]; p.w_in = in[7]; p.hg_lb = in[8]; p.hg_nw = in[9];
    p.ret_dl = in[10]; p.ret_nw = in[11]; p.w_out = in[12]; p.rgw = in[13]; p.rgb = in[14]; p.rew = in[15]; p.reb = in[16]; p.w_gate = in[17]; p.w_up = in[18]; p.w_down = in[19];
    p.out = (float*)d_out; p.ws = (unsigned char*)d_ws;
#if MK_ONE_LAUNCH
    (void)hipMemsetAsync((char*)d_ws + WS_CTL + CTL_BAR, 0, XCD_BAR_WORDS * 4, stream);
    p.ph_lo = 0; p.ph_hi = NPHASE;
    void* args[] = {&p};
    hipError_t e = hipLaunchCooperativeKernel((const void*)fwd_kernel, dim3(grid), dim3(NTHREADS), args, LDS_BYTES, stream);
    if (e != hipSuccess) fprintf(stderr, "cooperative launch failed: %s (grid %d)\n", hipGetErrorString(e), grid);
#else
    for (int k = 0; k < NPHASE; ++k) { p.ph_lo = k; p.ph_hi = k + 1; hipLaunchKernelGGL(fwd_kernel, dim3(grid), dim3(NTHREADS), LDS_BYTES, stream, p); }
#endif
}
```
